# Optimizing an MI355X kernel written in HIP

```python
import jax, jax.numpy as jnp
from jax import lax
import numpy as np

D_MODEL = 2048
BATCH = 2
SEQ = 4096
DEPTH = 1

ATTN_HEAD_DIM = 64
ATTN_HEADS = D_MODEL // ATTN_HEAD_DIM
ATTN_KV_HEADS = ATTN_HEADS // 8
ATTN_GROUP = ATTN_HEADS // ATTN_KV_HEADS
WINDOW = 128
RET_HEADS = 8
RET_QK_DIM = D_MODEL // RET_HEADS
RET_V_DIM = D_MODEL // RET_HEADS
RET_CHUNK = 128
ROPE_BASE = 10000.0
N_GROUPS = 4
EXPERTS_PER_GROUP = 16
N_EXPERTS = N_GROUPS * EXPERTS_PER_GROUP
TOP_K = 2
EXPERT_DIM = D_MODEL // 2
MOE_BLOCK = 128
EPS = 1e-6

kernel_name = "hybrid_swa_retention_hmoe_block"


def rms_norm(x, gain):
    xf = x.astype(jnp.float32)
    y = xf * lax.rsqrt(jnp.mean(xf * xf, axis=-1, keepdims=True) + EPS)
    return (y * gain.astype(jnp.float32)).astype(x.dtype)


def modulate(h, shift, scale):
    return h * (1.0 + scale[:, None, :]) + shift[:, None, :]


def sliding_window_sink_attention(q, k, v, sinks):
    b, s, kvh, g, dh = q.shape
    nb = s // WINDOW
    qb = q.reshape(b, nb, WINDOW, kvh, g, dh)

    def band(t):
        tb = t.reshape(b, nb, WINDOW, kvh, dh)
        prev = jnp.concatenate([jnp.zeros_like(tb[:, :1]), tb[:, :-1]], axis=1)
        return jnp.concatenate([prev, tb], axis=2)

    kb, vb = band(k), band(v)
    scores = jnp.einsum('bnqkgd,bnskd->bnkgqs', qb, kb,
                        preferred_element_type=jnp.float32) * (dh ** -0.5)
    qi = jnp.arange(WINDOW)[:, None]
    sj = jnp.arange(2 * WINDOW)[None, :]
    in_band = (sj > qi) & (sj <= qi + WINDOW)
    has_prev = (jnp.arange(nb) > 0)[:, None, None] | (sj >= WINDOW)[None]
    valid = in_band[None] & has_prev
    scores = jnp.where(valid[None, :, None, None], scores, -jnp.inf)
    sink = sinks.astype(jnp.float32).reshape(kvh, g)[None, None, :, :, None, None]
    m = jnp.maximum(jnp.max(scores, axis=-1, keepdims=True), sink)
    p = jnp.exp(scores - m)
    denom = jnp.sum(p, axis=-1, keepdims=True) + jnp.exp(sink - m)
    probs = (p / denom).astype(v.dtype)
    out = jnp.einsum('bnkgqs,bnskd->bnqkgd', probs, vb)
    return out.reshape(b, s, kvh * g * dh)


def rotary(t, positions):
    half = t.shape[-1] // 2
    inv_freq = ROPE_BASE ** (-jnp.arange(half, dtype=jnp.float32) / half)
    ang = positions.astype(jnp.float32)[..., None] * inv_freq
    cos = jnp.cos(ang)[:, :, None, :]
    sin = jnp.sin(ang)[:, :, None, :]
    t1, t2 = t[..., :half], t[..., half:]
    return jnp.concatenate([t1 * cos - t2 * sin, t1 * sin + t2 * cos], axis=-1)


def chunkwise_retention(q, k, v):
    b, s, h, dk = q.shape
    dv = v.shape[-1]
    nc = s // RET_CHUNK
    log_gamma = jnp.log1p(-(2.0 ** (-5.0 - jnp.arange(h, dtype=jnp.float32))))
    idx = jnp.arange(RET_CHUNK, dtype=jnp.float32)
    diff = idx[:, None] - idx[None, :]
    decay_intra = jnp.where(diff >= 0,
                            jnp.exp(jnp.maximum(diff, 0.0) * log_gamma[:, None, None]), 0.0)
    decay_q = jnp.exp((idx + 1.0) * log_gamma[:, None])
    decay_k = jnp.exp((RET_CHUNK - 1.0 - idx) * log_gamma[:, None])
    decay_chunk = jnp.exp(RET_CHUNK * log_gamma)

    def to_chunks(t):
        return t.reshape(b, nc, RET_CHUNK, h, -1).transpose(1, 0, 3, 2, 4)

    def step(state, qkv):
        qc, kc, vc = qkv
        intra = jnp.einsum('bhcd,bhed->bhce', qc, kc) * decay_intra
        o = (jnp.einsum('bhce,bhef->bhcf', intra, vc)
             + jnp.einsum('bhcd,bhdf->bhcf', qc, state) * decay_q[None, :, :, None])
        state = (state * decay_chunk[None, :, None, None]
                 + jnp.einsum('bhcd,bhcf->bhdf', kc * decay_k[None, :, :, None], vc))
        return state, o

    state0 = jnp.zeros((b, h, dk, dv), jnp.float32)
    _, o = lax.scan(step, state0, (to_chunks(q), to_chunks(k), to_chunks(v)))
    return o.transpose(1, 0, 3, 2, 4).reshape(b, s, h, dv)


def token_mixers(h, positions, w_in, attn_sinks, ret_norm_gain, w_branch_attn, w_branch_ret, w_out):
    b, s, _ = h.shape
    widths = [ATTN_HEADS * ATTN_HEAD_DIM, ATTN_KV_HEADS * ATTN_HEAD_DIM, ATTN_KV_HEADS * ATTN_HEAD_DIM,
              RET_HEADS * RET_QK_DIM, RET_HEADS * RET_QK_DIM, RET_HEADS * RET_V_DIM, RET_HEADS * RET_V_DIM,
              D_MODEL, D_MODEL]
    splits = [int(v) for v in np.cumsum(widths)[:-1]]
    proj = h @ w_in
    q_a, k_a, v_a, q_r, k_r, v_r, g_r, gate_a, gate_r = jnp.split(proj, splits, axis=-1)

    attn = sliding_window_sink_attention(
        q_a.reshape(b, s, ATTN_KV_HEADS, ATTN_GROUP, ATTN_HEAD_DIM),
        k_a.reshape(b, s, ATTN_KV_HEADS, ATTN_HEAD_DIM),
        v_a.reshape(b, s, ATTN_KV_HEADS, ATTN_HEAD_DIM),
        attn_sinks)

    qr = rotary(q_r.reshape(b, s, RET_HEADS, RET_QK_DIM).astype(jnp.float32), positions)
    kr = rotary(k_r.reshape(b, s, RET_HEADS, RET_QK_DIM).astype(jnp.float32), positions) * (RET_QK_DIM ** -0.5)
    vr = v_r.reshape(b, s, RET_HEADS, RET_V_DIM).astype(jnp.float32)
    ret = chunkwise_retention(qr, kr, vr)
    ret = ret * lax.rsqrt(jnp.mean(ret * ret, axis=-1, keepdims=True) + EPS)
    ret = ret * ret_norm_gain.astype(jnp.float32).reshape(RET_HEADS, RET_V_DIM)
    ret = (jax.nn.silu(g_r.astype(jnp.float32)) * ret.reshape(b, s, -1)).astype(h.dtype)

    merged = (jax.nn.sigmoid(gate_a) * (attn @ w_branch_attn)
              + jax.nn.sigmoid(gate_r) * (ret @ w_branch_ret))
    return merged @ w_out


def hierarchical_moe(h, w_router_group, b_router_group, w_router_expert, b_router_expert,
                     w_expert_gate, w_expert_up, w_expert_down):
    b, s, d = h.shape
    t = b * s
    hf = h.reshape(t, d)
    g_logits = (hf @ w_router_group).astype(jnp.float32) + b_router_group.astype(jnp.float32)
    g_prob = jax.nn.softmax(g_logits, axis=-1)
    g_sel = jnp.argmax(g_logits, axis=-1).astype(jnp.int32)
    g_w = jnp.take_along_axis(g_prob, g_sel[:, None], axis=1)
    e_logits = ((hf @ w_router_expert).astype(jnp.float32)
                + b_router_expert.astype(jnp.float32)).reshape(t, N_GROUPS, EXPERTS_PER_GROUP)
    e_logits = jnp.take_along_axis(e_logits, g_sel[:, None, None], axis=1)[:, 0]
    top_v, top_i = lax.top_k(e_logits, TOP_K)
    weights = (jax.nn.softmax(top_v, axis=-1) * g_w).reshape(-1)
    expert_ids = (g_sel[:, None] * EXPERTS_PER_GROUP + top_i).reshape(-1).astype(jnp.int32)
    token_ids = jnp.repeat(jnp.arange(t, dtype=jnp.int32), TOP_K)

    n_assign = t * TOP_K
    n_pad = -(-(n_assign + N_EXPERTS * (MOE_BLOCK - 1)) // MOE_BLOCK) * MOE_BLOCK
    n_blocks = n_pad // MOE_BLOCK
    order = jnp.argsort(expert_ids)
    sorted_e = expert_ids[order]
    counts = jnp.bincount(expert_ids, length=N_EXPERTS)
    padded = (counts + MOE_BLOCK - 1) // MOE_BLOCK * MOE_BLOCK
    start = jnp.cumsum(counts) - counts
    pad_end = jnp.cumsum(padded)
    pad_start = pad_end - padded
    dest = pad_start[sorted_e] + jnp.arange(n_assign, dtype=jnp.int32) - start[sorted_e]
    row_token = jnp.full((n_pad,), t, jnp.int32).at[dest].set(token_ids[order])
    row_weight = jnp.zeros((n_pad,), jnp.float32).at[dest].set(weights[order])
    block_expert = jnp.minimum(
        jnp.searchsorted(pad_end, jnp.arange(n_blocks, dtype=jnp.int32) * MOE_BLOCK, side='right'),
        N_EXPERTS - 1).astype(jnp.int32)
    x_rows = jnp.concatenate([hf, jnp.zeros((1, d), hf.dtype)], axis=0)[row_token]
    x_rows = x_rows.reshape(n_blocks, MOE_BLOCK, d)

    def expert_block(args):
        xb, e = args
        return (jax.nn.silu(xb @ w_expert_gate[e]) * (xb @ w_expert_up[e])) @ w_expert_down[e]

    y = lax.map(expert_block, (x_rows, block_expert)).reshape(n_pad, d)
    out = jnp.zeros((t + 1, d), h.dtype).at[row_token].add(y * row_weight[:, None].astype(y.dtype))
    return out[:t].reshape(b, s, d)


def setup_inputs(seed: int = 0) -> dict:
    key = jax.random.key(seed)
    ks = jax.random.split(key, 24)
    f32 = jnp.float32
    d = D_MODEL
    p_in = (ATTN_HEADS + 2 * ATTN_KV_HEADS) * ATTN_HEAD_DIM + RET_HEADS * (2 * RET_QK_DIM + 2 * RET_V_DIM) + 2 * d
    attn_w = ATTN_HEADS * ATTN_HEAD_DIM
    ret_w = RET_HEADS * RET_V_DIM

    def nrm(k, shape, scale):
        return jax.random.normal(k, shape, f32) * scale

    offset = jax.random.randint(ks[2], (BATCH, 1), 0, 1024, dtype=jnp.int32)
    positions = (offset + jnp.arange(SEQ, dtype=jnp.int32)[None, :]).astype(jnp.int32)
    return {
        "x": nrm(ks[0], (BATCH, SEQ, d), 1.0),
        "c": nrm(ks[1], (BATCH, d), 1.0),
        "positions": positions,
        "norm1_gain": 1.0 + nrm(ks[3], (DEPTH, d), 0.05),
        "norm2_gain": 1.0 + nrm(ks[4], (DEPTH, d), 0.05),
        "final_norm_gain": 1.0 + nrm(ks[5], (d,), 0.05),
        "w_ada": nrm(ks[6], (DEPTH, d, 6 * d), 0.5 * d ** -0.5),
        "b_ada": nrm(ks[7], (DEPTH, 6 * d), 0.02),
        "w_in": nrm(ks[8], (DEPTH, d, p_in), d ** -0.5),
        "attn_sinks": nrm(ks[9], (DEPTH, ATTN_HEADS), 1.0),
        "ret_norm_gain": 1.0 + nrm(ks[10], (DEPTH, ret_w), 0.05),
        "w_branch_attn": nrm(ks[11], (DEPTH, attn_w, d), attn_w ** -0.5),
        "w_branch_ret": nrm(ks[12], (DEPTH, ret_w, d), ret_w ** -0.5),
        "w_out": nrm(ks[13], (DEPTH, d, d), d ** -0.5),
        "w_router_group": nrm(ks[14], (DEPTH, d, N_GROUPS), d ** -0.5),
        "b_router_group": nrm(ks[15], (DEPTH, N_GROUPS), 0.01),
        "w_router_expert": nrm(ks[16], (DEPTH, d, N_EXPERTS), d ** -0.5),
        "b_router_expert": nrm(ks[17], (DEPTH, N_EXPERTS), 0.01),
        "w_expert_gate": nrm(ks[18], (DEPTH, N_EXPERTS, d, EXPERT_DIM), d ** -0.5),
        "w_expert_up": nrm(ks[19], (DEPTH, N_EXPERTS, d, EXPERT_DIM), d ** -0.5),
        "w_expert_down": nrm(ks[20], (DEPTH, N_EXPERTS, EXPERT_DIM, d), EXPERT_DIM ** -0.5),
    }


def reference(x, c, positions, norm1_gain, norm2_gain, final_norm_gain, w_ada, b_ada, w_in,
              attn_sinks, ret_norm_gain, w_branch_attn, w_branch_ret, w_out,
              w_router_group, b_router_group, w_router_expert, b_router_expert,
              w_expert_gate, w_expert_up, w_expert_down):
    for layer in range(DEPTH):
        mod = jax.nn.silu(c) @ w_ada[layer] + b_ada[layer]
        shift1, scale1, gate1, shift2, scale2, gate2 = jnp.split(mod, 6, axis=-1)
        h = modulate(rms_norm(x, norm1_gain[layer]), shift1, scale1)
        mix = token_mixers(h, positions, w_in[layer], attn_sinks[layer], ret_norm_gain[layer],
                           w_branch_attn[layer], w_branch_ret[layer], w_out[layer])
        x = x + gate1[:, None, :] * mix
        h2 = modulate(rms_norm(x, norm2_gain[layer]), shift2, scale2)
        ffn = hierarchical_moe(h2, w_router_group[layer], b_router_group[layer],
                               w_router_expert[layer], b_router_expert[layer],
                               w_expert_gate[layer], w_expert_up[layer], w_expert_down[layer])
        x = x + gate2[:, None, :] * ffn
    return rms_norm(x, final_norm_gain)
```

```cpp
#include <hip/hip_runtime.h>
#include <cstdio>
#include <cstdint>
#include <cmath>
namespace pg8 {
#define PG8_LAS __attribute__((address_space(3)))
typedef unsigned short bf16_t;
typedef short bf16x8 __attribute__((ext_vector_type(8)));
typedef float f32x4 __attribute__((ext_vector_type(4)));
typedef unsigned u32x4 __attribute__((ext_vector_type(4)));
constexpr int BM = 256, BK = 64, HALF = 128, HTB = HALF * BK * 2  , STAGE_BYTES = 8 * HTB, NXCD = 8, WGM = 8;

__host__ __device__ __forceinline__ int lds_byte(int r, int c) { const int st = (r >> 4) * 2 + (c >> 5), rr = r & 15, cc = c & 31, ob = rr * 64 + cc * 2; return st * 1024 + (ob ^ (((ob >> 9) & 1) << 5)); }
__host__ __device__ __forceinline__ void stage_rc(int b, int& R, int& C) { const int st = b / 1024, sb = b % 1024, swz = sb ^ (((sb >> 9) & 1) << 5); R = (st >> 1) * 16 + swz / 64; C = (st & 1) * 32 + (swz % 64) / 2; }
__host__ __device__ __forceinline__ int perm32(int rho) { const int n = rho >> 4, i = rho & 15; return 8 * (i >> 2) + 4 * n + (i & 3); }

struct Unit { int pm, pn; };
struct Gemm { const bf16_t* A; const bf16_t* Bt; int M, N, K; };

struct StaticOrder {
    int nM, nN, nwg, G, c;
    __host__ __device__ void init(int M, int N, int G_, int c_) { nM = M / BM; nN = N / BM; nwg = nM * nN; G = G_; c = c_; }
    __host__ __device__ bool next(int i, Unit& u) const {
        const long L = (long)i * G + c; if (L >= nwg) return false;
        int wgid = (int)L; { const int q = nwg / NXCD, r = nwg % NXCD, xcd = wgid % NXCD, off = wgid / NXCD; wgid = (xcd < r ? xcd * (q + 1) : r * (q + 1) + (xcd - r) * q) + off; }
        const int nig = WGM * nN, gid = wgid / nig, fm = gid * WGM, gsz = (nM - fm) < WGM ? (nM - fm) : WGM;
        u.pm = fm + ((wgid % nig) % gsz); u.pn = (wgid % nig) / gsz; return true;
    }
    __device__ __forceinline__ void a_ready(const Unit&) const {}
    __device__ __forceinline__ void done(const Unit&) const {}
};

__device__ __forceinline__ unsigned cvt_pk_bf16(float lo, float hi) { unsigned r; asm volatile("v_cvt_pk_bf16_f32 %0, %1, %2" : "=v"(r) : "v"(lo), "v"(hi)); return r; }
template <class Epi, class Sched, bool ALIGN_EPI = false, bool SP2 = false>
__device__ __forceinline__ void gemm_phase(PG8_LAS unsigned char* lds, const Gemm g, const Sched& S, const Epi& E) {
    const int tid = threadIdx.x, wid = __builtin_amdgcn_readfirstlane(tid >> 6), lane = tid & 63, wr = wid >> 2, wc = wid & 3, fr = lane & 15, fq = lane >> 4;
    const int K = g.K, nt = K / BK;
    unsigned voffA[2], voffB[2];
#pragma unroll
    for (int i = 0; i < 2; ++i) { int R, C; stage_rc(tid * 16 + i * 8192, R, C); const int Rb = Epi::PERM ? ((R & ~31) + perm32(R & 31)) : R;
        voffA[i] = (unsigned)(R * K + C) * 2u; voffB[i] = (unsigned)(Rb * K + C) * 2u; }
    const size_t kstep = (size_t)(BK * 2);
    const size_t hstep = (size_t)HALF * K * 2;
    const size_t tstep = 2 * hstep;
    const unsigned ldsw = (unsigned)wid * 1024u;
    const int aoff = lds_byte(wr * 64 + fr, fq * 8), boff = lds_byte(wc * 32 + fr, fq * 8);
#define PG8_SA(b, h) (((b) * 2 + (h)) * HTB)
#define PG8_SB(b, h) ((4 + (b) * 2 + (h)) * HTB)
#define PG8_STAGE(bufoff, gbase, voff) do { _Pragma("unroll") for (int _i = 0; _i < 2; ++_i) \
        __builtin_amdgcn_global_load_lds((const unsigned*)((const char*)(gbase) + (voff)[_i]), (PG8_LAS unsigned*)(lds + (bufoff) + ldsw + _i * 8192), 16, 0, 0); } while (0)
#define PG8_LDA(dst, b, h) do { _Pragma("unroll") for (int m = 0; m < 4; ++m) _Pragma("unroll") for (int k = 0; k < 2; ++k) dst[m][k] = *(const PG8_LAS bf16x8*)(lds + PG8_SA(b, h) + aoff + m * 2048 + k * 1024); } while (0)
#define PG8_LDB(dst, b, h) do { _Pragma("unroll") for (int n = 0; n < 2; ++n) _Pragma("unroll") for (int k = 0; k < 2; ++k) dst[n][k] = *(const PG8_LAS bf16x8*)(lds + PG8_SB(b, h) + boff + n * 2048 + k * 1024); } while (0)
#define PG8_MMA(ai, bj, At, Bt) do { __builtin_amdgcn_s_setprio(1); _Pragma("unroll") for (int m = 0; m < 4; ++m) _Pragma("unroll") for (int n = 0; n < 2; ++n) _Pragma("unroll") for (int k = 0; k < 2; ++k) \
        acc[ai][bj][m][n] = __builtin_amdgcn_mfma_f32_16x16x32_bf16(Bt[n][k], At[m][k], acc[ai][bj][m][n], 0, 0, 0); __builtin_amdgcn_s_setprio(0); } while (0)
#define PG8_WAIT_V(n) asm volatile("s_waitcnt vmcnt(" #n ")" ::: "memory")
#define PG8_WAIT_L(n) asm volatile("s_waitcnt lgkmcnt(" #n ")" ::: "memory")
#define PG8_BAR __builtin_amdgcn_s_barrier()
#define PG8_SCHED __builtin_amdgcn_sched_barrier(0)
    Unit cur, nxt; int ui = 0;
    if (!S.next(0, cur)) return;
    f32x4 acc[2][2][4][2];
#pragma unroll
    for (int a = 0; a < 2; ++a)
#pragma unroll
        for (int b = 0; b < 2; ++b)
#pragma unroll
            for (int m = 0; m < 4; ++m)
#pragma unroll
                for (int n = 0; n < 2; ++n) acc[a][b][m][n] = (f32x4){0.f, 0.f, 0.f, 0.f};
    bf16x8 At[4][2], B0[2][2], B1[2][2];
    const char* cA = (const char*)g.A + (size_t)cur.pm * tstep; const char* cB = (const char*)g.Bt + (size_t)cur.pn * tstep;
    S.a_ready(cur);
    if constexpr (SP2) {
        PG8_STAGE(PG8_SB(0, 0), cB, voffB); PG8_STAGE(PG8_SB(0, 1), cB + hstep, voffB); PG8_STAGE(PG8_SA(0, 0), cA, voffA); PG8_STAGE(PG8_SA(0, 1), cA + hstep, voffA);
        if (wr == 1) PG8_BAR;
        PG8_WAIT_V(2); PG8_BAR;
        PG8_STAGE(PG8_SB(1, 0), cB + kstep, voffB); PG8_STAGE(PG8_SA(1, 0), cA + kstep, voffA); PG8_STAGE(PG8_SB(1, 1), cB + hstep + kstep, voffB);
        PG8_WAIT_V(6); PG8_BAR;
    } else {
        PG8_STAGE(PG8_SB(0, 0), cB, voffB); PG8_STAGE(PG8_SA(0, 0), cA, voffA); PG8_STAGE(PG8_SB(0, 1), cB + hstep, voffB); PG8_STAGE(PG8_SA(0, 1), cA + hstep, voffA);
        if (wr == 1) PG8_BAR;
        PG8_WAIT_V(4); PG8_BAR;
        PG8_STAGE(PG8_SB(1, 0), cB + kstep, voffB); PG8_STAGE(PG8_SA(1, 0), cA + kstep, voffA); PG8_STAGE(PG8_SB(1, 1), cB + hstep + kstep, voffB);
        PG8_WAIT_V(6); PG8_BAR;
    }
    for (;;) {
        const bool has_next = S.next(ui + 1, nxt);
        const char* nA = has_next ? (const char*)g.A + (size_t)nxt.pm * tstep : cA; const char* nB = has_next ? (const char*)g.Bt + (size_t)nxt.pn * tstep : cB;
        for (int t = 0; t < nt; t += 2) {
            const bool last = (t == nt - 2);
            const char* a1 = cA + (size_t)(t + 1) * kstep;
            const char* a2 = last ? nA : cA + (size_t)(t + 2) * kstep; const char* b2 = last ? nB : cB + (size_t)(t + 2) * kstep;
            const char* a3 = a2 + kstep; const char* b3 = b2 + kstep;
            if (last && has_next) S.a_ready(nxt);
            if constexpr (SP2) {
            PG8_LDB(B0, 0, 0); PG8_LDB(B1, 0, 1); PG8_SCHED; PG8_LDA(At, 0, 0); PG8_STAGE(PG8_SA(1, 1), a1 + hstep, voffA);
            PG8_WAIT_V(8); PG8_WAIT_L(0); PG8_BAR; PG8_MMA(0, 0, At, B0); PG8_MMA(0, 1, At, B1); PG8_BAR; PG8_SCHED;
            PG8_LDA(At, 0, 1); PG8_STAGE(PG8_SB(0, 0), b2, voffB); PG8_STAGE(PG8_SB(0, 1), b2 + hstep, voffB); PG8_STAGE(PG8_SA(0, 0), a2, voffA);
            PG8_WAIT_V(8); PG8_WAIT_L(0); PG8_BAR; PG8_MMA(1, 0, At, B0); PG8_MMA(1, 1, At, B1); PG8_BAR; PG8_SCHED;
            PG8_LDB(B0, 1, 0); PG8_LDB(B1, 1, 1); PG8_SCHED; PG8_LDA(At, 1, 0); PG8_STAGE(PG8_SA(0, 1), a2 + hstep, voffA);
            PG8_WAIT_V(8); PG8_WAIT_L(0); PG8_BAR; PG8_MMA(0, 0, At, B0); PG8_MMA(0, 1, At, B1); PG8_BAR; PG8_SCHED;
            PG8_LDA(At, 1, 1); PG8_STAGE(PG8_SB(1, 0), b3, voffB); PG8_STAGE(PG8_SB(1, 1), b3 + hstep, voffB); PG8_STAGE(PG8_SA(1, 0), a3, voffA);
            PG8_WAIT_V(8); PG8_WAIT_L(0); PG8_BAR; PG8_MMA(1, 0, At, B0); PG8_MMA(1, 1, At, B1); PG8_BAR; PG8_SCHED;
            } else {
            PG8_LDB(B0, 0, 0); PG8_SCHED; PG8_LDA(At, 0, 0); PG8_STAGE(PG8_SA(1, 1), a1 + hstep, voffA);
            PG8_WAIT_L(8); PG8_BAR; PG8_WAIT_L(0); PG8_MMA(0, 0, At, B0); PG8_BAR; PG8_SCHED;
            PG8_LDB(B1, 0, 1); PG8_STAGE(PG8_SB(0, 0), b2, voffB);
            PG8_BAR; PG8_WAIT_L(0); PG8_MMA(0, 1, At, B1); PG8_BAR;
            PG8_LDA(At, 0, 1); PG8_STAGE(PG8_SA(0, 0), a2, voffA);
            PG8_BAR; PG8_WAIT_L(0); PG8_MMA(1, 0, At, B0); PG8_BAR; PG8_SCHED;
            PG8_STAGE(PG8_SB(0, 1), b2 + hstep, voffB);
            PG8_WAIT_V(6); PG8_BAR; PG8_MMA(1, 1, At, B1); PG8_BAR;
            PG8_LDB(B0, 1, 0); PG8_SCHED; PG8_LDA(At, 1, 0); PG8_STAGE(PG8_SA(0, 1), a2 + hstep, voffA);
            PG8_WAIT_L(8); PG8_BAR; PG8_WAIT_L(0); PG8_MMA(0, 0, At, B0); PG8_BAR; PG8_SCHED;
            PG8_LDB(B1, 1, 1); PG8_STAGE(PG8_SB(1, 0), b3, voffB);
            PG8_BAR; PG8_WAIT_L(0); PG8_MMA(0, 1, At, B1); PG8_BAR;
            PG8_LDA(At, 1, 1); PG8_STAGE(PG8_SA(1, 0), a3, voffA);
            PG8_BAR; PG8_WAIT_L(0); PG8_MMA(1, 0, At, B0); PG8_BAR; PG8_SCHED;
            PG8_STAGE(PG8_SB(1, 1), b3 + hstep, voffB);
            PG8_WAIT_V(6); PG8_BAR; PG8_MMA(1, 1, At, B1); PG8_BAR;
            }
        }
        if constexpr (ALIGN_EPI) { if (wr == 0) PG8_BAR; }
        if constexpr (!Epi::AFTER_DRAIN) { E(acc, cur, wr, wc, fr, fq); S.done(cur); }
        if (!has_next) break;
#pragma unroll
        for (int a = 0; a < 2; ++a)
#pragma unroll
            for (int b = 0; b < 2; ++b)
#pragma unroll
                for (int m = 0; m < 4; ++m)
#pragma unroll
                    for (int n = 0; n < 2; ++n) acc[a][b][m][n] = (f32x4){0.f, 0.f, 0.f, 0.f};
        cur = nxt; cA = nA; cB = nB; ++ui;
        if constexpr (ALIGN_EPI) { if (wr == 1) PG8_BAR; }
    }
    PG8_WAIT_V(0);
    if constexpr (!ALIGN_EPI) { if (wr == 0) PG8_BAR; }
    PG8_BAR;
    if constexpr (Epi::AFTER_DRAIN) { E.fused(acc, cur, wr, wc, fr, fq, lds, wid, lane); S.done(cur); }
#undef PG8_SA
#undef PG8_SB
#undef PG8_STAGE
#undef PG8_LDA
#undef PG8_LDB
#undef PG8_MMA
#undef PG8_WAIT_V
#undef PG8_WAIT_L
#undef PG8_BAR
#undef PG8_SCHED
}
}

constexpr int NWAVES = 8, NTHR = 512;
constexpr int BATCH = 2, SEQ = 4096, T = BATCH * SEQ, D = 2048;
constexpr int NPROJ = 14848;
constexpr int C_QA = 0, C_KA = 2048, C_VA = 2304, C_QR = 2560, C_KR = 4608, C_VR = 6656, C_GR = 8704, C_GA = 10752, C_GT = 12800;
constexpr int NEXP = 64, EDIM = 1024;
constexpr float EPS = 1e-6f;
constexpr float LOG2E = 1.4426950408889634f;
constexpr float QA_SCALE = 0.125f * LOG2E;

constexpr size_t MiB = 1u << 20;
constexpr size_t WS_CTL = 0, CTL_ZERO_BYTES = 1 * MiB;
constexpr size_t WS_MOD = 1 * MiB;
constexpr size_t WS_ROPE = 2 * MiB;
constexpr size_t WS_WIN = 10 * MiB;
constexpr size_t WS_WBA = 68 * MiB, WS_WBR = 76 * MiB, WS_WOUT = 84 * MiB;
constexpr size_t WS_ROUTE = 92 * MiB;
constexpr size_t WS_WRT = 94 * MiB;
constexpr size_t WS_H = 96 * MiB;
constexpr size_t WS_X1 = 128 * MiB;
constexpr size_t WS_P = 192 * MiB;
constexpr size_t WS_VTA = 424 * MiB;
constexpr size_t WS_VTR = 428 * MiB;
constexpr size_t WS_KRT = 460 * MiB;
constexpr size_t WS_SC = 492 * MiB;
constexpr size_t WS_ST = 620 * MiB;
constexpr size_t WS_ATTN = 684 * MiB;
constexpr size_t WS_RET = 716 * MiB;
constexpr size_t WS_M1 = 748 * MiB;
constexpr size_t WS_MERGED = 812 * MiB;
constexpr size_t WS_XG = 192 * MiB;
constexpr size_t WS_HB = 320 * MiB;
constexpr size_t WS_Y = 384 * MiB;
constexpr size_t WS_WGU = 848 * MiB;
constexpr size_t WS_WD = 1360 * MiB;
constexpr size_t WS_END = 1616 * MiB;

constexpr int CW_TMO = 0, CW_BAR = 4096, CW_CNT = 16384;

constexpr int RING_BYTES = 131072;
constexpr int MISC_OFF = RING_BYTES;
constexpr int MISC_BYTES = 16384;
constexpr int LDS_BYTES = RING_BYTES + MISC_BYTES;

#define GAS __attribute__((address_space(1)))
#define LAS __attribute__((address_space(3)))
typedef unsigned short bf16;
typedef unsigned v4u __attribute__((ext_vector_type(4)));
typedef unsigned v2u __attribute__((ext_vector_type(2)));
typedef float f32x4 __attribute__((ext_vector_type(4)));
typedef short bf16x8 __attribute__((ext_vector_type(8)));
typedef GAS unsigned gu32;
#define RLX_AGENT __ATOMIC_RELAXED, __HIP_MEMORY_SCOPE_AGENT
#define LDS_WAIT() asm volatile("s_waitcnt lgkmcnt(0)" ::: "memory")
#define VM_WAIT() asm volatile("s_waitcnt vmcnt(0)" ::: "memory")
__device__ __forceinline__ unsigned f2bf(float f) { unsigned u = __builtin_bit_cast(unsigned, f); return (u + 0x7fffu + ((u >> 16) & 1u)) >> 16; }
__device__ __forceinline__ unsigned pk2(float lo, float hi) { return f2bf(lo) | (f2bf(hi) << 16); }
__device__ __forceinline__ float bf2f(unsigned b) { return __builtin_bit_cast(float, b << 16); }
__device__ __forceinline__ float wave_sum(float v) {
#pragma unroll
    for (int o = 1; o < 64; o <<= 1) v += __shfl_xor(v, o);
    return v;
}
__device__ __forceinline__ float sum16(float v) {
#pragma unroll
    for (int o = 1; o < 16; o <<= 1) v += __shfl_xor(v, o);
    return v;
}
__device__ __forceinline__ float max16(float v) {
#pragma unroll
    for (int o = 1; o < 16; o <<= 1) v = fmaxf(v, __shfl_xor(v, o));
    return v;
}
__device__ __forceinline__ float sigmoidf_(float x) { return 1.0f / (1.0f + __expf(-x)); }
__device__ __forceinline__ float siluf_(float x) { return x / (1.0f + __expf(-x)); }

#define XB_TMO      128
#define XB_XCNT(j)  (256  + 64 * (j))
#define XB_XSUB(j)  (1280 + 64 * (j))
#define XB_XGEN(j)  (2304 + 64 * (j))
#define XB_TOP      3328
#define XB_TOPGEN   3392
#define XCD_BAR_WORDS 3456
#define XB_SPIN_CAP (1u << 18)

__device__ __forceinline__ unsigned xb_ld(unsigned* p)              { return __hip_atomic_load(p, __ATOMIC_RELAXED, __HIP_MEMORY_SCOPE_AGENT); }
__device__ __forceinline__ unsigned xb_add(unsigned* p, unsigned v) { return __hip_atomic_fetch_add(p, v, __ATOMIC_RELAXED, __HIP_MEMORY_SCOPE_AGENT); }
__device__ __forceinline__ unsigned xb_xcc_id() { return (unsigned)__builtin_amdgcn_s_getreg((3 << 11) | 20) & 0xFu; }
#define XB_SPIN(cond, bar) do { unsigned _sp = 0; while (cond) { __builtin_amdgcn_s_sleep(1); \
    if ((++_sp & 255u) == 0u) { if (xb_ld(&(bar)[XB_TMO])) break; if (_sp > XB_SPIN_CAP) { atomicAdd(&(bar)[XB_TMO], 1u); break; } } } } while (0)

struct XcdBarrier {
    unsigned* bar; unsigned x;
    volatile LAS unsigned* st;
};

__device__ __forceinline__ XcdBarrier xcd_barrier_post(unsigned* bar, volatile LAS unsigned* st) {
    XcdBarrier b; b.bar = bar; b.x = xb_xcc_id(); b.st = st;
    if (threadIdx.x == 0) (void)xb_add(&bar[XB_XCNT(b.x)], 1u);
    return b;
}
__device__ __forceinline__ void xcd_barrier_complete(unsigned* bar, unsigned x, unsigned& nloc, unsigned& nx) {
    const unsigned G = gridDim.x * gridDim.y * gridDim.z;
    unsigned sum, cnt, mine, sp = 0u;
    for (;;) {
        sum = 0u; cnt = 0u; mine = 0u;
#pragma unroll
        for (unsigned j = 0; j < 16; ++j) { const unsigned c = xb_ld(&bar[XB_XCNT(j)]); sum += c; cnt += (c > 0u) ? 1u : 0u; mine = (j == x) ? c : mine; }
        if (sum == G) break;
        __builtin_amdgcn_s_sleep(1);
        if ((++sp & 255u) == 0u) { if (xb_ld(&bar[XB_TMO])) break; if (sp > XB_SPIN_CAP) { atomicAdd(&bar[XB_TMO], 1u); break; } }
    }
    nloc = mine > 0u ? mine : 1u; nx = cnt > 0u ? cnt : 1u;
}

__device__ __forceinline__ void xcd_barrier(const XcdBarrier& b) {
    asm volatile("s_waitcnt vmcnt(0)" ::: "memory");
    __syncthreads();
    if (threadIdx.x == 0) {
        unsigned* bar = b.bar;
        __builtin_amdgcn_s_waitcnt(0);
        unsigned nloc = b.st[0], nx = b.st[1];
        if (nloc == 0u) { xcd_barrier_complete(bar, b.x, nloc, nx); b.st[0] = nloc; b.st[1] = nx; }
        const unsigned old = xb_add(&bar[XB_XSUB(b.x)], 1u);
        const unsigned gen = old / nloc;
        if (old + 1u == (gen + 1u) * nloc) {
            __builtin_amdgcn_fence(__ATOMIC_RELEASE, "agent");
            asm volatile("s_waitcnt vmcnt(0)" ::: "memory");
            const unsigned og = xb_add(&bar[XB_TOP], 1u);
            const unsigned tg = og / nx;
            if (og + 1u == (tg + 1u) * nx) xb_add(&bar[XB_TOPGEN], 1u);
            else XB_SPIN(xb_ld(&bar[XB_TOPGEN]) == tg, bar);
            __builtin_amdgcn_fence(__ATOMIC_ACQUIRE, "agent");
            xb_add(&bar[XB_XGEN(b.x)], 1u);
            asm volatile("s_waitcnt vmcnt(0)" ::: "memory");
        } else {
            XB_SPIN(xb_ld(&bar[XB_XGEN(b.x)]) == gen, bar);
            __builtin_amdgcn_fence(__ATOMIC_ACQUIRE, "agent");
            asm volatile("s_waitcnt vmcnt(0)" ::: "memory");
        }
    }
    __syncthreads();
}


struct Args { const void* in[21]; float* out; unsigned char* ws; int ph_lo, ph_hi; };

__device__ __forceinline__ f32x4 mma16(bf16x8 a, bf16x8 b, f32x4 c) { return __builtin_amdgcn_mfma_f32_16x16x32_bf16(a, b, c, 0, 0, 0); }
__device__ __forceinline__ bf16x8 ldg8(const bf16* p) { return *(const GAS bf16x8*)p; }

namespace pg8 {
struct EpiProj {
    static constexpr bool PERM = true, AFTER_DRAIN = false;
    bf16* P; bf16* Vta; bf16* Vtr; bf16* Krt; const float* cosT; const float* sinT;
    __device__ __forceinline__ void operator()(const f32x4 (&acc)[2][2][4][2], const Unit& u, int wr, int wc, int fr, int fq) const {
        const int pn = u.pn;
        const int row0 = u.pm * BM + wr * 64 + fr;
        const int cl = wc * 32 + 8 * fq;
        if (pn == 9 || (pn >= 26 && pn < 34)) {
            bf16* base; int chan0, nchan;
            if (pn == 9) { base = Vta; chan0 = 0; nchan = 256; } else { base = Vtr; chan0 = (pn - 26) * 256; nchan = 2048; }
#pragma unroll
            for (int ai = 0; ai < 2; ++ai)
#pragma unroll
                for (int m = 0; m < 4; ++m) {
                    const int row = row0 + ai * HALF + m * 16; const int b = row >> 12, s = row & 4095;
                    bf16* colp = base + ((size_t)(b * nchan + chan0 + cl) * 4096 + s);
#pragma unroll
                    for (int bj = 0; bj < 2; ++bj)
#pragma unroll
                        for (int n = 0; n < 2; ++n)
#pragma unroll
                            for (int i = 0; i < 4; ++i) colp[(size_t)(bj * HALF + 4 * n + i) * 4096] = (bf16)f2bf(acc[ai][bj][m][n][i]);
                }
            return;
        }
        const bool rot = (pn >= 10 && pn < 26);
        const bool isk = (pn >= 18 && pn < 26);
        float lg2 = 0.f;
        if (isk) { const int h = pn - 18; lg2 = log1pf(-exp2f(-5.0f - (float)h)) * LOG2E; }
#pragma unroll
        for (int ai = 0; ai < 2; ++ai)
#pragma unroll
            for (int m = 0; m < 4; ++m) {
                const int row = row0 + ai * HALF + m * 16;
                f32x4 v[2][2];
#pragma unroll
                for (int bj = 0; bj < 2; ++bj)
#pragma unroll
                    for (int n = 0; n < 2; ++n) v[bj][n] = acc[ai][bj][m][n];
                if (rot) {
                    const float* cp = cosT + (size_t)row * 128 + cl; const float* sp = sinT + (size_t)row * 128 + cl;
#pragma unroll
                    for (int n = 0; n < 2; ++n) {
                        const f32x4 c = *(const f32x4*)(cp + 4 * n), s = *(const f32x4*)(sp + 4 * n);
                        const f32x4 t1 = v[0][n], t2 = v[1][n];
                        v[0][n] = t1 * c - t2 * s; v[1][n] = t1 * s + t2 * c;
                    }
                    if (isk) {
#pragma unroll
                        for (int n = 0; n < 2; ++n) { v[0][n] = v[0][n] * 0.0625f; v[1][n] = v[1][n] * 0.0625f; }
                    }
                } else if (pn < 8) {
#pragma unroll
                    for (int bj = 0; bj < 2; ++bj)
#pragma unroll
                        for (int n = 0; n < 2; ++n) v[bj][n] = v[bj][n] * QA_SCALE;
                } else if (pn >= 34 && pn < 42) {
#pragma unroll
                    for (int bj = 0; bj < 2; ++bj)
#pragma unroll
                        for (int n = 0; n < 2; ++n)
#pragma unroll
                            for (int i = 0; i < 4; ++i) v[bj][n][i] = siluf_(v[bj][n][i]);
                } else if (pn >= 42) {
#pragma unroll
                    for (int bj = 0; bj < 2; ++bj)
#pragma unroll
                        for (int n = 0; n < 2; ++n)
#pragma unroll
                            for (int i = 0; i < 4; ++i) v[bj][n][i] = sigmoidf_(v[bj][n][i]);
                }
                bf16* rowp = P + (size_t)row * NPROJ + pn * BM + cl;
#pragma unroll
                for (int bj = 0; bj < 2; ++bj) {
                    u32x4 w; w.x = cvt_pk_bf16(v[bj][0][0], v[bj][0][1]); w.y = cvt_pk_bf16(v[bj][0][2], v[bj][0][3]); w.z = cvt_pk_bf16(v[bj][1][0], v[bj][1][1]); w.w = cvt_pk_bf16(v[bj][1][2], v[bj][1][3]);
                    *(u32x4*)(rowp + bj * HALF) = w;
                }
                if (isk) {
                    const int b = row >> 12, s = row & 4095;
                    const float dk = exp2f((float)(127 - (s & 127)) * lg2);
                    bf16* colp = Krt + ((size_t)(b * 2048 + (pn - 18) * 256 + cl) * 4096 + s);
#pragma unroll
                    for (int bj = 0; bj < 2; ++bj)
#pragma unroll
                        for (int n = 0; n < 2; ++n)
#pragma unroll
                            for (int i = 0; i < 4; ++i) colp[(size_t)(bj * HALF + 4 * n + i) * 4096] = (bf16)f2bf(v[bj][n][i] * dk);
                }
            }
    }
};
struct EpiBranchA {
    static constexpr bool PERM = true, AFTER_DRAIN = false;
    const bf16* P; float* M1;
    __device__ __forceinline__ void operator()(const f32x4 (&acc)[2][2][4][2], const Unit& u, int wr, int wc, int fr, int fq) const {
        const int row0 = u.pm * BM + wr * 64 + fr, col0 = u.pn * BM + wc * 32 + 8 * fq;
#pragma unroll
        for (int ai = 0; ai < 2; ++ai)
#pragma unroll
            for (int m = 0; m < 4; ++m) { const int row = row0 + ai * HALF + m * 16;
#pragma unroll
                for (int bj = 0; bj < 2; ++bj) { const int col = col0 + bj * HALF;
                    const u32x4 g = *(const u32x4*)(P + (size_t)row * NPROJ + C_GA + col);
                    f32x4 o0, o1;
                    o0[0] = bf2f(g.x & 0xffffu) * acc[ai][bj][m][0][0]; o0[1] = bf2f(g.x >> 16) * acc[ai][bj][m][0][1]; o0[2] = bf2f(g.y & 0xffffu) * acc[ai][bj][m][0][2]; o0[3] = bf2f(g.y >> 16) * acc[ai][bj][m][0][3];
                    o1[0] = bf2f(g.z & 0xffffu) * acc[ai][bj][m][1][0]; o1[1] = bf2f(g.z >> 16) * acc[ai][bj][m][1][1]; o1[2] = bf2f(g.w & 0xffffu) * acc[ai][bj][m][1][2]; o1[3] = bf2f(g.w >> 16) * acc[ai][bj][m][1][3];
                    float* op = M1 + (size_t)row * D + col; *(f32x4*)op = o0; *(f32x4*)(op + 4) = o1; } }
    }
};
struct EpiBranchR {
    static constexpr bool PERM = true, AFTER_DRAIN = false;
    const bf16* P; const float* M1; bf16* MG;
    __device__ __forceinline__ void operator()(const f32x4 (&acc)[2][2][4][2], const Unit& u, int wr, int wc, int fr, int fq) const {
        const int row0 = u.pm * BM + wr * 64 + fr, col0 = u.pn * BM + wc * 32 + 8 * fq;
#pragma unroll
        for (int ai = 0; ai < 2; ++ai)
#pragma unroll
            for (int m = 0; m < 4; ++m) { const int row = row0 + ai * HALF + m * 16;
#pragma unroll
                for (int bj = 0; bj < 2; ++bj) { const int col = col0 + bj * HALF;
                    const u32x4 g = *(const u32x4*)(P + (size_t)row * NPROJ + C_GT + col);
                    const float* ip = M1 + (size_t)row * D + col; const f32x4 a0 = *(const f32x4*)ip, a1 = *(const f32x4*)(ip + 4);
                    f32x4 o0, o1;
                    o0[0] = a0[0] + bf2f(g.x & 0xffffu) * acc[ai][bj][m][0][0]; o0[1] = a0[1] + bf2f(g.x >> 16) * acc[ai][bj][m][0][1]; o0[2] = a0[2] + bf2f(g.y & 0xffffu) * acc[ai][bj][m][0][2]; o0[3] = a0[3] + bf2f(g.y >> 16) * acc[ai][bj][m][0][3];
                    o1[0] = a1[0] + bf2f(g.z & 0xffffu) * acc[ai][bj][m][1][0]; o1[1] = a1[1] + bf2f(g.z >> 16) * acc[ai][bj][m][1][1]; o1[2] = a1[2] + bf2f(g.w & 0xffffu) * acc[ai][bj][m][1][2]; o1[3] = a1[3] + bf2f(g.w >> 16) * acc[ai][bj][m][1][3];
                    u32x4 w; w.x = cvt_pk_bf16(o0[0], o0[1]); w.y = cvt_pk_bf16(o0[2], o0[3]); w.z = cvt_pk_bf16(o1[0], o1[1]); w.w = cvt_pk_bf16(o1[2], o1[3]);
                    *(u32x4*)(MG + (size_t)row * D + col) = w; } }
    }
};
struct EpiOut {
    static constexpr bool PERM = false, AFTER_DRAIN = false;
    const float* x; const float* gate1; float* X1;
    __device__ __forceinline__ void operator()(const f32x4 (&acc)[2][2][4][2], const Unit& u, int wr, int wc, int fr, int fq) const {
        const int row0 = u.pm * BM + wr * 64 + fr, col0 = u.pn * BM + wc * 32 + 4 * fq;
        const int b = (u.pm * BM) >> 12;
        f32x4 gv[2][2];
#pragma unroll
        for (int bj = 0; bj < 2; ++bj)
#pragma unroll
            for (int n = 0; n < 2; ++n) gv[bj][n] = *(const f32x4*)(gate1 + (size_t)b * 12288 + col0 + bj * HALF + n * 16);
#pragma unroll
        for (int ai = 0; ai < 2; ++ai)
#pragma unroll
            for (int m = 0; m < 4; ++m) { const size_t off = (size_t)(row0 + ai * HALF + m * 16) * D + col0;
#pragma unroll
                for (int bj = 0; bj < 2; ++bj)
#pragma unroll
                    for (int n = 0; n < 2; ++n) { const f32x4 xv = *(const f32x4*)(x + off + bj * HALF + n * 16);
                        *(f32x4*)(X1 + off + bj * HALF + n * 16) = xv + gv[bj][n] * acc[ai][bj][m][n]; } }
    }
};
struct EpiFfn1 {
    static constexpr bool PERM = true, AFTER_DRAIN = false;
    bf16* HB;
    __device__ __forceinline__ void operator()(const f32x4 (&acc)[2][2][4][2], const Unit& u, int wr, int wc, int fr, int fq) const {
        const int row0 = u.pm * BM + wr * 64 + fr, col0 = (u.pn & 7) * 128 + wc * 32 + 8 * fq;
#pragma unroll
        for (int ai = 0; ai < 2; ++ai)
#pragma unroll
            for (int m = 0; m < 4; ++m) { const int row = row0 + ai * HALF + m * 16;
                float h[8];
#pragma unroll
                for (int n = 0; n < 2; ++n)
#pragma unroll
                    for (int i = 0; i < 4; ++i) h[4 * n + i] = siluf_(acc[ai][0][m][n][i]) * acc[ai][1][m][n][i];
                u32x4 w; w.x = cvt_pk_bf16(h[0], h[1]); w.y = cvt_pk_bf16(h[2], h[3]); w.z = cvt_pk_bf16(h[4], h[5]); w.w = cvt_pk_bf16(h[6], h[7]);
                *(u32x4*)(HB + (size_t)row * EDIM + col0) = w; }
    }
};
struct EpiFfn2 {
    static constexpr bool PERM = true, AFTER_DRAIN = false;
    bf16* Y;
    __device__ __forceinline__ void operator()(const f32x4 (&acc)[2][2][4][2], const Unit& u, int wr, int wc, int fr, int fq) const {
        const int row0 = u.pm * BM + wr * 64 + fr, col0 = (u.pn & 7) * BM + wc * 32 + 8 * fq;
#pragma unroll
        for (int ai = 0; ai < 2; ++ai)
#pragma unroll
            for (int m = 0; m < 4; ++m) { const int row = row0 + ai * HALF + m * 16;
#pragma unroll
                for (int bj = 0; bj < 2; ++bj) {
                    u32x4 w; w.x = cvt_pk_bf16(acc[ai][bj][m][0][0], acc[ai][bj][m][0][1]); w.y = cvt_pk_bf16(acc[ai][bj][m][0][2], acc[ai][bj][m][0][3]);
                    w.z = cvt_pk_bf16(acc[ai][bj][m][1][0], acc[ai][bj][m][1][1]); w.w = cvt_pk_bf16(acc[ai][bj][m][1][2], acc[ai][bj][m][1][3]);
                    *(u32x4*)(Y + (size_t)row * D + col0 + bj * HALF) = w; } }
    }
};
struct MoeOrder {
    const LAS int* blk_e; int nblk, NT, G, c;
    __device__ __forceinline__ bool next(int i, Unit& u) const {
        const int L = i * G + c; if (L >= nblk * NT) return false;
        const int blk = L / NT, j = L - blk * NT; u.pm = blk; u.pn = blk_e[blk] * NT + j; return true;
    }
    __device__ __forceinline__ void a_ready(const Unit&) const {}
    __device__ __forceinline__ void done(const Unit&) const {}
};
}

__device__ __forceinline__ void transpose_item(const float* W, int K, int N, int k0, int n0, bf16* dst  , LAS float* scr, int lane) {
#pragma unroll 8
    for (int i = 0; i < 32; ++i) { const int kk = 2 * i + (lane >> 5); scr[kk * 33 + (lane & 31)] = W[(size_t)(k0 + kk) * N + n0 + (lane & 31)]; }
    LDS_WAIT();
    const int c = lane & 7;
#pragma unroll
    for (int j = 0; j < 4; ++j) { const int n = (lane >> 3) + 8 * j; const LAS float* s = scr + (8 * c) * 33 + n;
        v4u o; o.x = pk2(s[0 * 33], s[1 * 33]); o.y = pk2(s[2 * 33], s[3 * 33]); o.z = pk2(s[4 * 33], s[5 * 33]); o.w = pk2(s[6 * 33], s[7 * 33]);
        *(GAS v4u*)(dst + (size_t)n * K + k0 + 8 * c) = o; }
    LDS_WAIT();
}

__global__ void __launch_bounds__(NTHR, 2) fwd_kernel(Args args) {
    extern __shared__ __attribute__((aligned(16))) unsigned char lds_raw[];
    LAS unsigned char* lds = (LAS unsigned char*)lds_raw;
    volatile LAS unsigned* MISC = (volatile LAS unsigned*)(lds + MISC_OFF);
    const int tid = threadIdx.x, lane = tid & 63, wave = __builtin_amdgcn_readfirstlane(tid >> 6);
    const int G = gridDim.x, bid = blockIdx.x;
    unsigned char* ws = args.ws;
    gu32* ctl = (gu32*)(ws + WS_CTL);
    const int lo = args.ph_lo, hi = args.ph_hi;

    const float* x = (const float*)args.in[0];
    const float* cvec = (const float*)args.in[1];
    const int* positions = (const int*)args.in[2];
    const float* norm1_gain = (const float*)args.in[3];
    const float* norm2_gain = (const float*)args.in[4];
    const float* final_gain = (const float*)args.in[5];
    const float* w_ada = (const float*)args.in[6];
    const float* b_ada = (const float*)args.in[7];
    const float* w_in = (const float*)args.in[8];
    const float* attn_sinks = (const float*)args.in[9];
    const float* ret_gain = (const float*)args.in[10];
    const float* w_ba = (const float*)args.in[11];
    const float* w_br = (const float*)args.in[12];
    const float* w_out = (const float*)args.in[13];
    const float* w_rg = (const float*)args.in[14];
    const float* b_rg = (const float*)args.in[15];
    const float* w_re = (const float*)args.in[16];
    const float* b_re = (const float*)args.in[17];
    const float* w_eg = (const float*)args.in[18];
    const float* w_eu = (const float*)args.in[19];
    const float* w_ed = (const float*)args.in[20];

    float* mod = (float*)(ws + WS_MOD);
    float* cosT = (float*)(ws + WS_ROPE); float* sinT = cosT + (size_t)T * 128;
    bf16* Win_t = (bf16*)(ws + WS_WIN); bf16* Wba_t = (bf16*)(ws + WS_WBA); bf16* Wbr_t = (bf16*)(ws + WS_WBR); bf16* Wout_t = (bf16*)(ws + WS_WOUT);
    bf16* Wrt = (bf16*)(ws + WS_WRT);
    bf16* Hb = (bf16*)(ws + WS_H);
    float* X1 = (float*)(ws + WS_X1);
    bf16* P = (bf16*)(ws + WS_P);
    bf16* Vta = (bf16*)(ws + WS_VTA); bf16* Vtr = (bf16*)(ws + WS_VTR); bf16* Krt = (bf16*)(ws + WS_KRT);
    float* SC = (float*)(ws + WS_SC); bf16* ST = (bf16*)(ws + WS_ST);
    bf16* ATT = (bf16*)(ws + WS_ATTN); bf16* RET = (bf16*)(ws + WS_RET);
    float* M1 = (float*)(ws + WS_M1); bf16* MG = (bf16*)(ws + WS_MERGED);
    bf16* XG = (bf16*)(ws + WS_XG); bf16* HB = (bf16*)(ws + WS_HB); bf16* YB = (bf16*)(ws + WS_Y);
    bf16* WGU = (bf16*)(ws + WS_WGU); bf16* WDt = (bf16*)(ws + WS_WD);
    int* route = (int*)(ws + WS_ROUTE);
    gu32* ecnt = ctl + CW_CNT;

    for (int u = tid; u < MISC_BYTES / 4; u += NTHR) ((LAS unsigned*)(lds + MISC_OFF))[u] = 0u;
    __syncthreads();
    XcdBarrier bar = xcd_barrier_post((unsigned*)(ctl + CW_BAR), MISC + 8);

#define IN(k) (lo <= (k) && (k) < hi)
#define SEAM(k) do { if (IN(k) && IN((k) + 1)) xcd_barrier(bar); } while (0)

    if (IN(0)) {
        {
            LAS float* sc = (LAS float*)lds;
            LAS float* red = (LAS float*)(lds + 16384);
            bool have = false;
            for (int it = bid; it < 192; it += G) {
                if (!have) { for (int i = tid; i < 2 * D; i += NTHR) sc[i] = siluf_(cvec[i]); have = true; __syncthreads(); }
                const int n0 = it * 64, cg = tid & 15, rg = tid >> 4;
                f32x4 a0 = {0.f, 0.f, 0.f, 0.f}, a1 = {0.f, 0.f, 0.f, 0.f};
                for (int k = rg; k < D; k += 32) { const f32x4 w = *(const GAS f32x4*)(w_ada + (size_t)k * 12288 + n0 + 4 * cg); a0 += w * sc[k]; a1 += w * sc[D + k]; }
#pragma unroll
                for (int i = 0; i < 4; ++i) { red[tid * 8 + i] = a0[i]; red[tid * 8 + 4 + i] = a1[i]; }
                __syncthreads();
                if (tid < 128) { const int b = tid >> 6, col = tid & 63, cgi = col >> 2, ci = col & 3; float s = 0.f;
                    for (int r = 0; r < 32; ++r) s += red[(r * 16 + cgi) * 8 + b * 4 + ci];
                    mod[b * 12288 + n0 + col] = s + b_ada[n0 + col]; }
                __syncthreads();
            }
            __syncthreads();
        }
        for (int i = bid * NTHR + tid; i < T * 128; i += G * NTHR) {
            const int tok = i >> 7, f = i & 127;
            const double inv = exp2(-(double)f * (13.287712379549449 / 128.0));
            double rv = (double)positions[tok] * inv * 0.15915494309189535;
            rv -= floor(rv);
            const float rf = (float)rv;
            cosT[i] = __builtin_amdgcn_cosf(rf); sinT[i] = __builtin_amdgcn_sinf(rf);
        }
        for (int i = bid * NTHR + tid; i < 80 * D; i += G * NTHR) {
            const int n = i >> 11, k = i & 2047; float v = 0.f;
            if (n < 64) v = w_re[(size_t)k * 64 + n]; else if (n < 68) v = w_rg[(size_t)k * 4 + (n - 64)];
            Wrt[i] = (bf16)f2bf(v);
        }
        {
            LAS float* scr = (LAS float*)(lds + 32768 + wave * 8704);
            const int gw = bid * NWAVES + wave, NGW = G * NWAVES;
            constexpr int I_IN = 32 * (NPROJ / 32), I_SQ = 32 * 64, I_EGU = 32 * 32, I_ED = 16 * 64;
            constexpr int NIT = I_IN + 3 * I_SQ + NEXP * (2 * I_EGU + I_ED);
            for (int it = gw; it < NIT; it += NGW) {
                int r = it;
                if (r < I_IN) { const int nb = NPROJ / 32, kb = r / nb, n0 = (r % nb) * 32; transpose_item(w_in, D, NPROJ, kb * 64, n0, Win_t + (size_t)n0 * D, scr, lane); continue; } r -= I_IN;
                if (r < 3 * I_SQ) { const int w = r / I_SQ; r -= w * I_SQ; const int kb = r / 64, n0 = (r % 64) * 32;
                    const float* src = w == 0 ? w_ba : (w == 1 ? w_br : w_out); bf16* dst = w == 0 ? Wba_t : (w == 1 ? Wbr_t : Wout_t);
                    transpose_item(src, D, D, kb * 64, n0, dst + (size_t)n0 * D, scr, lane); continue; } r -= 3 * I_SQ;
                const int e = r / (2 * I_EGU + I_ED); r -= e * (2 * I_EGU + I_ED);
                if (r < 2 * I_EGU) { const int up = r / I_EGU; r -= up * I_EGU; const int kb = r / 32, n0 = (r % 32) * 32;
                    const float* src = (up ? w_eu : w_eg) + (size_t)e * D * EDIM;
                    bf16* dst = WGU + (size_t)((e * 8 + (n0 >> 7)) * 256 + up * 128 + (n0 & 127)) * D;
                    transpose_item(src, D, EDIM, kb * 64, n0, dst, scr, lane); continue; } r -= 2 * I_EGU;
                { const int kb = r / 64, n0 = (r % 64) * 32; const float* src = w_ed + (size_t)e * EDIM * D;
                    transpose_item(src, EDIM, D, kb * 64, n0, WDt + (size_t)(e * 2048 + n0) * EDIM, scr, lane); }
            }
        }
    }
    SEAM(0);

    if (IN(1)) {
        const int gw = bid * NWAVES + wave, NGW = G * NWAVES;
        for (int row = gw; row < T; row += NGW) {
            const int b = row >> 12;
            const GAS f32x4* xr = (const GAS f32x4*)(x + (size_t)row * D) + lane;
            f32x4 v[8]; float ss = 0.f;
#pragma unroll
            for (int j = 0; j < 8; ++j) { v[j] = xr[64 * j]; ss += (v[j].x * v[j].x + v[j].y * v[j].y) + (v[j].z * v[j].z + v[j].w * v[j].w); }
            const float r = 1.0f / sqrtf(wave_sum(ss) * (1.0f / D) + EPS);
            GAS v2u* o8 = (GAS v2u*)(Hb + (size_t)row * D) + lane;
#pragma unroll
            for (int j = 0; j < 8; ++j) { const int k = 4 * lane + 256 * j;
                const f32x4 g = *(const GAS f32x4*)(norm1_gain + k), sh = *(const GAS f32x4*)(mod + b * 12288 + k), scl = *(const GAS f32x4*)(mod + b * 12288 + 2048 + k);
                const f32x4 hv = v[j] * r * g * (scl + 1.0f) + sh;
                v2u o; o.x = pk2(hv.x, hv.y); o.y = pk2(hv.z, hv.w); o8[64 * j] = o; }
        }
    }
    SEAM(1);

    if (IN(2)) {
        pg8::Gemm g{Hb, Win_t, T, NPROJ, D}; pg8::StaticOrder S; S.init(T, NPROJ, G, bid);
        pg8::EpiProj E{P, Vta, Vtr, Krt, cosT, sinT};
        pg8::gemm_phase<pg8::EpiProj, pg8::StaticOrder, true, true>(lds, g, S, E);
    }
    SEAM(2);

    if (IN(3)) {
        const int r16 = lane & 15, q4 = lane >> 4;
        for (int unit = bid; unit < 256 + 512; unit += G) {
            if (unit < 256) {
                const int b = unit >> 7, kvh = (unit >> 5) & 3, nb = unit & 31, head = kvh * 8 + wave;
                const float sink2 = attn_sinks[head] * LOG2E;
                const int tq0 = nb * 128, ks = (nb - 1) * 128;
                const bf16* Qb = P + (size_t)(b * SEQ + tq0) * NPROJ + C_QA + head * 64;
                const bf16* Kb = P + (size_t)(b * SEQ) * NPROJ + C_KA + kvh * 64;
                const bf16* Vb = Vta + (size_t)(b * 256 + kvh * 64) * 4096;
                LAS bf16* Pl = (LAS bf16*)(lds + wave * 5376);
                for (int t = 0; t < 8; ++t) {
                    bf16x8 qa[2];
#pragma unroll
                    for (int s = 0; s < 2; ++s) qa[s] = ldg8(Qb + (size_t)(16 * t + r16) * NPROJ + 32 * s + 8 * q4);
                    f32x4 sc[10];
#pragma unroll
                    for (int n = 0; n < 10; ++n) {
                        const int kb = (t + n) < 16 ? (t + n) : 15;
                        int tk = ks + 16 * kb + r16; tk = tk < 0 ? 0 : tk;
                        f32x4 a = {0.f, 0.f, 0.f, 0.f};
#pragma unroll
                        for (int s = 0; s < 2; ++s) a = mma16(qa[s], ldg8(Kb + (size_t)tk * NPROJ + 32 * s + 8 * q4), a);
                        sc[n] = a;
                    }
                    float mx[4], sm[4];
#pragma unroll
                    for (int reg = 0; reg < 4; ++reg) {
                        const int tq = tq0 + 16 * t + 4 * q4 + reg; float m = -INFINITY;
#pragma unroll
                        for (int n = 0; n < 10; ++n) { const int tk = ks + 16 * (t + n) + r16; const bool ok = (t + n < 16) && (tk >= 0) && (tk <= tq) && (tk + 128 > tq);
                            sc[n][reg] = ok ? sc[n][reg] : -INFINITY; m = fmaxf(m, sc[n][reg]); }
                        m = fmaxf(max16(m), sink2); mx[reg] = m; float s = 0.f;
#pragma unroll
                        for (int n = 0; n < 10; ++n) { const float p = exp2f(sc[n][reg] - m); sc[n][reg] = p; s += p; }
                        sm[reg] = 1.0f / (sum16(s) + exp2f(sink2 - m));
                    }
#pragma unroll
                    for (int n = 0; n < 10; ++n)
#pragma unroll
                        for (int reg = 0; reg < 4; ++reg) Pl[(4 * q4 + reg) * 168 + 16 * n + r16] = (bf16)f2bf(sc[n][reg] * sm[reg]);
                    LDS_WAIT();
                    f32x4 o[4];
#pragma unroll
                    for (int nd = 0; nd < 4; ++nd) o[nd] = (f32x4){0.f, 0.f, 0.f, 0.f};
#pragma unroll
                    for (int s = 0; s < 5; ++s) {
                        const bf16x8 pa = *(const LAS bf16x8*)(Pl + r16 * 168 + 32 * s + 8 * q4);
                        const int n = 2 * s + (q4 >> 1); const int kb = (t + n) < 16 ? (t + n) : 15;
                        int tk0 = ks + 16 * kb + 8 * (q4 & 1); tk0 = tk0 < 0 ? 0 : tk0;
#pragma unroll
                        for (int nd = 0; nd < 4; ++nd) o[nd] = mma16(pa, ldg8(Vb + (size_t)(16 * nd + r16) * 4096 + tk0), o[nd]);
                    }
#pragma unroll
                    for (int nd = 0; nd < 4; ++nd)
#pragma unroll
                        for (int reg = 0; reg < 4; ++reg) ATT[(size_t)(b * SEQ + tq0 + 16 * t + 4 * q4 + reg) * D + head * 64 + 16 * nd + r16] = (bf16)f2bf(o[nd][reg]);
                    LDS_WAIT();
                }
            } else {
                const int u = unit - 256, bh = u >> 5, c = u & 31, b = bh >> 3, h = bh & 7;
                const bf16* Ab = Vtr + (size_t)(b * 2048 + h * 256 + 32 * wave) * 4096 + c * 128;
                const bf16* Bb = Krt + (size_t)(b * 2048 + h * 256) * 4096 + c * 128;
#pragma unroll 1
                for (int nh = 0; nh < 2; ++nh) {
                    f32x4 acc[2][8];
#pragma unroll
                    for (int m = 0; m < 2; ++m)
#pragma unroll
                        for (int n = 0; n < 8; ++n) acc[m][n] = (f32x4){0.f, 0.f, 0.f, 0.f};
#pragma unroll 1
                    for (int s = 0; s < 4; ++s) {
                        bf16x8 a[2];
#pragma unroll
                        for (int m = 0; m < 2; ++m) a[m] = ldg8(Ab + (size_t)(16 * m + r16) * 4096 + 32 * s + 8 * q4);
#pragma unroll
                        for (int n = 0; n < 8; ++n) { const bf16x8 bb = ldg8(Bb + (size_t)(128 * nh + 16 * n + r16) * 4096 + 32 * s + 8 * q4);
                            acc[0][n] = mma16(a[0], bb, acc[0][n]); acc[1][n] = mma16(a[1], bb, acc[1][n]); }
                    }
                    float* out = SC + (size_t)u * 65536;
#pragma unroll
                    for (int m = 0; m < 2; ++m)
#pragma unroll
                        for (int n = 0; n < 8; ++n)
#pragma unroll
                            for (int reg = 0; reg < 4; ++reg) out[(size_t)(32 * wave + 16 * m + 4 * q4 + reg) * 256 + 128 * nh + 16 * n + r16] = acc[m][n][reg];
                }
            }
        }
    }
    SEAM(3);

    if (IN(4)) {
        for (int i = bid * NTHR + tid; i < 16 * 16384; i += G * NTHR) {
            const int bh = i >> 14, e4 = i & 16383, h = bh & 7;
            const float dc = expf(128.0f * log1pf(-exp2f(-5.0f - (float)h)));
            f32x4 st = {0.f, 0.f, 0.f, 0.f};
            for (int c = 0; c < 32; ++c) {
                const size_t off = (size_t)(bh * 32 + c) * 65536 + 4 * e4;
                v2u o; o.x = pk2(st.x, st.y); o.y = pk2(st.z, st.w); *(GAS v2u*)(ST + off) = o;
                const f32x4 s = *(const GAS f32x4*)(SC + off);
                st = st * dc + s;
            }
        }
    }
    SEAM(4);

    if (IN(5)) {
        const int r16 = lane & 15, q4 = lane >> 4;
        for (int u = bid; u < 512; u += G) {
            const int bh = u >> 5, c = u & 31, b = bh >> 3, h = bh & 7;
            const float lg2 = log1pf(-exp2f(-5.0f - (float)h)) * LOG2E;
            const int tok0 = b * SEQ + c * 128;
            const bf16* Qb = P + (size_t)(tok0 + 16 * wave) * NPROJ + C_QR + h * 256;
            const bf16* Kb = P + (size_t)tok0 * NPROJ + C_KR + h * 256;
            const bf16* Vb = Vtr + (size_t)(b * 2048 + h * 256) * 4096 + c * 128;
            const bf16* Sb = ST + (size_t)u * 65536;
            LAS bf16* Il = (LAS bf16*)(lds + wave * 4352);
            bf16x8 qa[8];
#pragma unroll
            for (int s = 0; s < 8; ++s) qa[s] = ldg8(Qb + (size_t)r16 * NPROJ + 32 * s + 8 * q4);
#pragma unroll
            for (int n = 0; n < 8; ++n) {
                f32x4 a = {0.f, 0.f, 0.f, 0.f};
                if (n <= wave) {
#pragma unroll
                    for (int s = 0; s < 8; ++s) a = mma16(qa[s], ldg8(Kb + (size_t)(16 * n + r16) * NPROJ + 32 * s + 8 * q4), a);
                }
#pragma unroll
                for (int reg = 0; reg < 4; ++reg) { const int qi = 16 * wave + 4 * q4 + reg, ki = 16 * n + r16; const int df = qi - ki;
                    const float v = df >= 0 ? a[reg] * exp2f((float)df * lg2) : 0.f;
                    Il[(4 * q4 + reg) * 136 + ki] = (bf16)f2bf(v); }
            }
            LDS_WAIT();
            bf16x8 ia[4];
#pragma unroll
            for (int s = 0; s < 4; ++s) ia[s] = *(const LAS bf16x8*)(Il + r16 * 136 + 32 * s + 8 * q4);
            float dq[4];
#pragma unroll
            for (int reg = 0; reg < 4; ++reg) dq[reg] = exp2f((float)(16 * wave + 4 * q4 + reg + 1) * lg2);
            f32x4 O[16]; float ss[4] = {0.f, 0.f, 0.f, 0.f};
#pragma unroll
            for (int nd = 0; nd < 16; ++nd) {
                f32x4 t2 = {0.f, 0.f, 0.f, 0.f}, t1 = {0.f, 0.f, 0.f, 0.f};
#pragma unroll
                for (int s = 0; s < 8; ++s) t2 = mma16(qa[s], ldg8(Sb + (size_t)(16 * nd + r16) * 256 + 32 * s + 8 * q4), t2);
#pragma unroll
                for (int s = 0; s < 4; ++s) t1 = mma16(ia[s], ldg8(Vb + (size_t)(16 * nd + r16) * 4096 + 32 * s + 8 * q4), t1);
#pragma unroll
                for (int reg = 0; reg < 4; ++reg) { const float v = t1[reg] + dq[reg] * t2[reg]; O[nd][reg] = v; ss[reg] += v * v; }
            }
            float rs[4];
#pragma unroll
            for (int reg = 0; reg < 4; ++reg) rs[reg] = 1.0f / sqrtf(sum16(ss[reg]) * (1.0f / 256.0f) + EPS);
#pragma unroll
            for (int nd = 0; nd < 16; ++nd) { const int ch = h * 256 + 16 * nd + r16; const float gn = ret_gain[ch];
#pragma unroll
                for (int reg = 0; reg < 4; ++reg) { const size_t tok = (size_t)(tok0 + 16 * wave + 4 * q4 + reg);
                    const float sg = bf2f(P[tok * NPROJ + C_GR + ch]);
                    RET[tok * D + ch] = (bf16)f2bf(O[nd][reg] * rs[reg] * gn * sg); } }
            LDS_WAIT();
        }
    }
    SEAM(5);

    if (IN(6)) {
        { pg8::Gemm g{ATT, Wba_t, T, D, D}; pg8::StaticOrder S; S.init(T, D, G, bid); pg8::EpiBranchA E{P, M1};
          pg8::gemm_phase<pg8::EpiBranchA, pg8::StaticOrder, true, true>(lds, g, S, E); }
        VM_WAIT(); __syncthreads();
        { pg8::Gemm g{RET, Wbr_t, T, D, D}; pg8::StaticOrder S; S.init(T, D, G, bid); pg8::EpiBranchR E{P, M1, MG};
          pg8::gemm_phase<pg8::EpiBranchR, pg8::StaticOrder, true, true>(lds, g, S, E); }
    }
    SEAM(6);

    if (IN(7)) {
        pg8::Gemm g{MG, Wout_t, T, D, D}; pg8::StaticOrder S; S.init(T, D, G, bid); pg8::EpiOut E{x, mod + 2 * 2048, X1};
        pg8::gemm_phase<pg8::EpiOut, pg8::StaticOrder, true, true>(lds, g, S, E);
    }
    SEAM(7);

    if (IN(8)) {
        const int r16 = lane & 15, q4 = lane >> 4;
        LAS bf16* Al = (LAS bf16*)lds;
        LAS float* Lg = (LAS float*)(lds + MISC_OFF + 1024);
        for (int t0 = bid * 32; t0 < T; t0 += G * 32) {
            for (int rr = 0; rr < 4; ++rr) {
                const int lrow = 4 * wave + rr, row = t0 + lrow, b = row >> 12;
                const GAS f32x4* xr = (const GAS f32x4*)(X1 + (size_t)row * D) + lane;
                f32x4 v[8]; float ss = 0.f;
#pragma unroll
                for (int j = 0; j < 8; ++j) { v[j] = xr[64 * j]; ss += (v[j].x * v[j].x + v[j].y * v[j].y) + (v[j].z * v[j].z + v[j].w * v[j].w); }
                const float r = 1.0f / sqrtf(wave_sum(ss) * (1.0f / D) + EPS);
                GAS v2u* o8 = (GAS v2u*)(Hb + (size_t)row * D) + lane;
#pragma unroll
                for (int j = 0; j < 8; ++j) { const int k = 4 * lane + 256 * j;
                    const f32x4 g = *(const GAS f32x4*)(norm2_gain + k), sh = *(const GAS f32x4*)(mod + b * 12288 + 3 * 2048 + k), scl = *(const GAS f32x4*)(mod + b * 12288 + 4 * 2048 + k);
                    const f32x4 hv = v[j] * r * g * (scl + 1.0f) + sh;
                    v2u o; o.x = pk2(hv.x, hv.y); o.y = pk2(hv.z, hv.w); o8[64 * j] = o;
                    *(LAS v2u*)(Al + lrow * 2048 + k) = o; }
            }
            __syncthreads();
            if (wave < 5) {
                f32x4 a0 = {0.f, 0.f, 0.f, 0.f}, a1 = {0.f, 0.f, 0.f, 0.f};
                const bf16* Bb = Wrt + (size_t)(16 * wave + r16) * D + 8 * q4;
                for (int s = 0; s < 64; ++s) {
                    const bf16x8 bb = ldg8(Bb + 32 * s);
                    const bf16x8 x0 = *(const LAS bf16x8*)(Al + r16 * 2048 + 32 * s + 8 * q4), x1v = *(const LAS bf16x8*)(Al + (16 + r16) * 2048 + 32 * s + 8 * q4);
                    a0 = mma16(x0, bb, a0); a1 = mma16(x1v, bb, a1);
                }
#pragma unroll
                for (int reg = 0; reg < 4; ++reg) { Lg[(4 * q4 + reg) * 80 + 16 * wave + r16] = a0[reg]; Lg[(16 + 4 * q4 + reg) * 80 + 16 * wave + r16] = a1[reg]; }
            }
            __syncthreads();
            if (tid < 32) {
                const int row = t0 + tid; const LAS float* L = Lg + tid * 80;
                float gl[4]; int gs = 0;
#pragma unroll
                for (int j = 0; j < 4; ++j) gl[j] = L[64 + j] + b_rg[j];
#pragma unroll
                for (int j = 1; j < 4; ++j) if (gl[j] > gl[gs]) gs = j;
                float den = 0.f;
#pragma unroll
                for (int j = 0; j < 4; ++j) den += expf(gl[j] - gl[gs]);
                const float gw = 1.0f / den;
                int i0 = 0; float v0 = -INFINITY;
                for (int j = 0; j < 16; ++j) { const float v = L[gs * 16 + j] + b_re[gs * 16 + j]; if (v > v0) { v0 = v; i0 = j; } }
                int i1 = 0; float v1 = -INFINITY;
                for (int j = 0; j < 16; ++j) { const float v = L[gs * 16 + j] + b_re[gs * 16 + j]; if (j != i0 && v > v1) { v1 = v; i1 = j; } }
                const float e1 = expf(v1 - v0); const float w0 = gw / (1.0f + e1), w1 = gw * e1 / (1.0f + e1);
                const int ex0 = gs * 16 + i0, ex1 = gs * 16 + i1;
                const int p0 = (int)__hip_atomic_fetch_add(ecnt + ex0, 1u, RLX_AGENT), p1 = (int)__hip_atomic_fetch_add(ecnt + ex1, 1u, RLX_AGENT);
                int* rt = route + (size_t)row * 8;
                rt[0] = ex0; rt[1] = p0; rt[2] = ex1; rt[3] = p1; rt[4] = __builtin_bit_cast(int, w0); rt[5] = __builtin_bit_cast(int, w1);
            }
            __syncthreads();
        }
    }
    SEAM(8);

    LAS int* blk_e = (LAS int*)(lds + MISC_OFF + 12288);
    LAS int* bstart = (LAS int*)(lds + MISC_OFF + 12288 + 512);
    LAS int* nblk_p = (LAS int*)(lds + MISC_OFF + 12288 + 768);
    if (hi > 9 && lo <= 12) {
        if (tid == 0) { int nb = 0;
            for (int e = 0; e < NEXP; ++e) { const int cnt = (int)__hip_atomic_load(ecnt + e, RLX_AGENT); const int k = (cnt + 255) >> 8; bstart[e] = nb; for (int j = 0; j < k; ++j) blk_e[nb + j] = e; nb += k; }
            nblk_p[0] = nb; }
        __syncthreads();
    }

    if (IN(9)) {
        const int gw = bid * NWAVES + wave, NGW = G * NWAVES;
        for (int a = gw; a < 2 * T; a += NGW) {
            const int tok = a >> 1, k = a & 1; const int* rt = route + (size_t)tok * 8;
            const int e = rt[2 * k], pos = rt[2 * k + 1]; const int row = bstart[e] * 256 + pos;
            const GAS v4u* src = (const GAS v4u*)(Hb + (size_t)tok * D) + lane; GAS v4u* dst = (GAS v4u*)(XG + (size_t)row * D) + lane;
#pragma unroll
            for (int j = 0; j < 4; ++j) dst[64 * j] = src[64 * j];
        }
    }
    SEAM(9);

    if (IN(10)) {
        pg8::Gemm g{XG, WGU, 0, 0, D}; pg8::MoeOrder S{blk_e, nblk_p[0], 8, G, bid}; pg8::EpiFfn1 E{HB};
        pg8::gemm_phase<pg8::EpiFfn1, pg8::MoeOrder, true, true>(lds, g, S, E);
    }
    SEAM(10);

    if (IN(11)) {
        pg8::Gemm g{HB, WDt, 0, 0, EDIM}; pg8::MoeOrder S{blk_e, nblk_p[0], 8, G, bid}; pg8::EpiFfn2 E{YB};
        pg8::gemm_phase<pg8::EpiFfn2, pg8::MoeOrder, true, true>(lds, g, S, E);
    }
    SEAM(11);

    if (IN(12)) {
        const int gw = bid * NWAVES + wave, NGW = G * NWAVES;
        for (int row = gw; row < T; row += NGW) {
            const int b = row >> 12; const int* rt = route + (size_t)row * 8;
            const int r0 = bstart[rt[0]] * 256 + rt[1], r1 = bstart[rt[2]] * 256 + rt[3];
            const float w0 = __builtin_bit_cast(float, rt[4]), w1 = __builtin_bit_cast(float, rt[5]);
            const GAS f32x4* xr = (const GAS f32x4*)(X1 + (size_t)row * D) + lane;
            const GAS v2u* y0 = (const GAS v2u*)(YB + (size_t)r0 * D) + lane; const GAS v2u* y1 = (const GAS v2u*)(YB + (size_t)r1 * D) + lane;
            f32x4 v[8]; float ss = 0.f;
#pragma unroll
            for (int j = 0; j < 8; ++j) { const int k = 4 * lane + 256 * j;
                const f32x4 g2 = *(const GAS f32x4*)(mod + b * 12288 + 5 * 2048 + k);
                const v2u a = y0[64 * j], bq = y1[64 * j];
                f32x4 f; f.x = w0 * bf2f(a.x & 0xffffu) + w1 * bf2f(bq.x & 0xffffu); f.y = w0 * bf2f(a.x >> 16) + w1 * bf2f(bq.x >> 16);
                f.z = w0 * bf2f(a.y & 0xffffu) + w1 * bf2f(bq.y & 0xffffu); f.w = w0 * bf2f(a.y >> 16) + w1 * bf2f(bq.y >> 16);
#ifdef DBG_SKIP_MOE
                v[j] = xr[64 * j];
#else
                v[j] = xr[64 * j] + g2 * f;
#endif
                ss += (v[j].x * v[j].x + v[j].y * v[j].y) + (v[j].z * v[j].z + v[j].w * v[j].w); }
            const float r = 1.0f / sqrtf(wave_sum(ss) * (1.0f / D) + EPS);
            GAS f32x4* o = (GAS f32x4*)(args.out + (size_t)row * D) + lane;
#pragma unroll
            for (int j = 0; j < 8; ++j) { const f32x4 g = *(const GAS f32x4*)(final_gain + 4 * lane + 256 * j); o[64 * j] = v[j] * r * g; }
        }
    }
#undef IN
#undef SEAM
}


#ifdef DBG_TAP
__global__ void tap_kernel(unsigned char* ws, float* out, int mode) {
    const bf16* Hb = (const bf16*)(ws + WS_H); const bf16* P = (const bf16*)(ws + WS_P);
    const bf16* Vta = (const bf16*)(ws + WS_VTA); const bf16* Vtr = (const bf16*)(ws + WS_VTR); const bf16* Krt = (const bf16*)(ws + WS_KRT);
    const float* SC = (const float*)(ws + WS_SC); const bf16* ST = (const bf16*)(ws + WS_ST);
    const bf16* ATT = (const bf16*)(ws + WS_ATTN); const bf16* RET = (const bf16*)(ws + WS_RET); const bf16* MG = (const bf16*)(ws + WS_MERGED);
    const float* X1 = (const float*)(ws + WS_X1); const float* mod = (const float*)(ws + WS_MOD);
    for (size_t i = (size_t)blockIdx.x * blockDim.x + threadIdx.x; i < (size_t)T * D; i += (size_t)gridDim.x * blockDim.x) {
        const int row = (int)(i >> 11), c = (int)(i & 2047), b = row >> 12, s = row & 4095; float v = 0.f;
        if (mode == 0) v = mod[(i % 24576)];
        if (mode == 1) v = bf2f(Hb[i]);
        if (mode == 2) { v = bf2f(P[(size_t)row * NPROJ + c]) + bf2f(P[(size_t)row * NPROJ + C_QR + c]) + bf2f(P[(size_t)row * NPROJ + C_KR + c]) + bf2f(P[(size_t)row * NPROJ + C_GR + c]) + bf2f(P[(size_t)row * NPROJ + C_GA + c]) + bf2f(P[(size_t)row * NPROJ + C_GT + c])
                 + bf2f(P[(size_t)row * NPROJ + C_KA + (c & 255)]) + bf2f(Vtr[(size_t)(b * 2048 + c) * 4096 + s]) + bf2f(Krt[(size_t)(b * 2048 + c) * 4096 + s]) + bf2f(Vta[(size_t)(b * 256 + (c & 255)) * 4096 + s]); }
        if (mode == 3) { v = bf2f(ATT[i]); for (int j = 0; j < 4; ++j) v += SC[i * 4 + j] * 0.01f; }
        if (mode == 4) { for (int j = 0; j < 2; ++j) v += bf2f(ST[i * 2 + j]); }
        if (mode == 5) v = bf2f(RET[i]);
        if (mode == 6) v = bf2f(MG[i]);
        if (mode == 7) v = X1[i];
        out[i] = v;
    }
}
#endif
constexpr int NPHASES = 13;
#ifndef MK_ONE_LAUNCH
#define MK_ONE_LAUNCH 0
#endif
extern "C" void kernel_launch(void* const* d_in, const int* in_sizes, int n_in, void* d_out, int out_size, void* d_ws, size_t ws_size, hipStream_t stream) {
    static int grid = 0;
    if (grid == 0) {
        if (n_in != 21 || out_size != T * D || ws_size < WS_END) { fprintf(stderr, "kernel_launch: unexpected shapes (n_in %d out %d ws %zu)\n", n_in, out_size, ws_size); grid = -1; return; }
        int dev = 0, cus = 0, per_cu = 0;
        if (hipGetDevice(&dev) != hipSuccess || hipDeviceGetAttribute(&cus, hipDeviceAttributeMultiprocessorCount, dev) != hipSuccess) { grid = -1; return; }
        if (hipFuncSetAttribute((const void*)fwd_kernel, hipFuncAttributeMaxDynamicSharedMemorySize, LDS_BYTES) != hipSuccess) { fprintf(stderr, "kernel_launch: hipFuncSetAttribute failed\n"); grid = -1; return; }
        if (hipOccupancyMaxActiveBlocksPerMultiprocessor(&per_cu, (const void*)fwd_kernel, NTHR, LDS_BYTES) != hipSuccess || per_cu < 1) { fprintf(stderr, "kernel_launch: occupancy query says %d\n", per_cu); }
        (void)hipGetLastError();
        grid = cus;
    }
    if (grid < 0) return;
    if (hipMemsetAsync((char*)d_ws + WS_CTL, 0, CTL_ZERO_BYTES, stream) != hipSuccess) return;
    Args a{};
    for (int i = 0; i < 21; ++i) a.in[i] = d_in[i];
    a.out = (float*)d_out; a.ws = (unsigned char*)d_ws;
#if MK_ONE_LAUNCH
    a.ph_lo = 0; a.ph_hi = NPHASES;
    hipLaunchKernelGGL(fwd_kernel, dim3(grid), dim3(NTHR), LDS_BYTES, stream, a);
#else
#ifdef DBG_TAP
    for (int p = 0; p <= DBG_TAP; ++p) { a.ph_lo = p; a.ph_hi = p + 1; hipLaunchKernelGGL(fwd_kernel, dim3(grid), dim3(NTHR), LDS_BYTES, stream, a); }
    hipLaunchKernelGGL(tap_kernel, dim3(2048), dim3(256), 0, stream, (unsigned char*)d_ws, (float*)d_out, (int)DBG_TAPMODE);
#else
    for (int p = 0; p < NPHASES; ++p) { a.ph_lo = p; a.ph_hi = p + 1; hipLaunchKernelGGL(fwd_kernel, dim3(grid), dim3(NTHR), LDS_BYTES, stream, a); }
#endif
#endif
}
```

```cpp
#define MK_ONE_LAUNCH 1
#include <hip/hip_runtime.h>
#include <cstdio>
#include <cstdint>
#include <cmath>
namespace pg8 {
#define PG8_LAS __attribute__((address_space(3)))
typedef unsigned short bf16_t;
typedef short bf16x8 __attribute__((ext_vector_type(8)));
typedef float f32x4 __attribute__((ext_vector_type(4)));
typedef unsigned u32x4 __attribute__((ext_vector_type(4)));
constexpr int BM = 256, BK = 64, HALF = 128, HTB = HALF * BK * 2  , STAGE_BYTES = 8 * HTB, NXCD = 8, WGM = 8;

__host__ __device__ __forceinline__ int lds_byte(int r, int c) { const int st = (r >> 4) * 2 + (c >> 5), rr = r & 15, cc = c & 31, ob = rr * 64 + cc * 2; return st * 1024 + (ob ^ (((ob >> 9) & 1) << 5)); }
__host__ __device__ __forceinline__ void stage_rc(int b, int& R, int& C) { const int st = b / 1024, sb = b % 1024, swz = sb ^ (((sb >> 9) & 1) << 5); R = (st >> 1) * 16 + swz / 64; C = (st & 1) * 32 + (swz % 64) / 2; }
__host__ __device__ __forceinline__ int perm32(int rho) { const int n = rho >> 4, i = rho & 15; return 8 * (i >> 2) + 4 * n + (i & 3); }

struct Unit { int pm, pn; };
struct Gemm { const bf16_t* A; const bf16_t* Bt; int M, N, K; };

struct StaticOrder {
    int nM, nN, nwg, G, c;
    __host__ __device__ void init(int M, int N, int G_, int c_) { nM = M / BM; nN = N / BM; nwg = nM * nN; G = G_; c = c_; }
    __host__ __device__ bool next(int i, Unit& u) const {
        const long L = (long)i * G + c; if (L >= nwg) return false;
        int wgid = (int)L; { const int q = nwg / NXCD, r = nwg % NXCD, xcd = wgid % NXCD, off = wgid / NXCD; wgid = (xcd < r ? xcd * (q + 1) : r * (q + 1) + (xcd - r) * q) + off; }
        const int nig = WGM * nN, gid = wgid / nig, fm = gid * WGM, gsz = (nM - fm) < WGM ? (nM - fm) : WGM;
        u.pm = fm + ((wgid % nig) % gsz); u.pn = (wgid % nig) / gsz; return true;
    }
    __device__ __forceinline__ void a_ready(const Unit&) const {}
    __device__ __forceinline__ void done(const Unit&) const {}
};

__device__ __forceinline__ unsigned cvt_pk_bf16(float lo, float hi) { unsigned r; asm volatile("v_cvt_pk_bf16_f32 %0, %1, %2" : "=v"(r) : "v"(lo), "v"(hi)); return r; }
template <class Epi, class Sched, bool ALIGN_EPI = false, bool SP2 = false>
__device__ __forceinline__ void gemm_phase(PG8_LAS unsigned char* lds, const Gemm g, const Sched& S, const Epi& E) {
    const int tid = threadIdx.x, wid = __builtin_amdgcn_readfirstlane(tid >> 6), lane = tid & 63, wr = wid >> 2, wc = wid & 3, fr = lane & 15, fq = lane >> 4;
    const int K = g.K, nt = K / BK;
    unsigned voffA[2], voffB[2];
#pragma unroll
    for (int i = 0; i < 2; ++i) { int R, C; stage_rc(tid * 16 + i * 8192, R, C); const int Rb = Epi::PERM ? ((R & ~31) + perm32(R & 31)) : R;
        voffA[i] = (unsigned)(R * K + C) * 2u; voffB[i] = (unsigned)(Rb * K + C) * 2u; }
    const size_t kstep = (size_t)(BK * 2);
    const size_t hstep = (size_t)HALF * K * 2;
    const size_t tstep = 2 * hstep;
    const unsigned ldsw = (unsigned)wid * 1024u;
    const int aoff = lds_byte(wr * 64 + fr, fq * 8), boff = lds_byte(wc * 32 + fr, fq * 8);
#define PG8_SA(b, h) (((b) * 2 + (h)) * HTB)
#define PG8_SB(b, h) ((4 + (b) * 2 + (h)) * HTB)
#define PG8_STAGE(bufoff, gbase, voff) do { _Pragma("unroll") for (int _i = 0; _i < 2; ++_i) \
        __builtin_amdgcn_global_load_lds((const unsigned*)((const char*)(gbase) + (voff)[_i]), (PG8_LAS unsigned*)(lds + (bufoff) + ldsw + _i * 8192), 16, 0, 0); } while (0)
#define PG8_LDA(dst, b, h) do { _Pragma("unroll") for (int m = 0; m < 4; ++m) _Pragma("unroll") for (int k = 0; k < 2; ++k) dst[m][k] = *(const PG8_LAS bf16x8*)(lds + PG8_SA(b, h) + aoff + m * 2048 + k * 1024); } while (0)
#define PG8_LDB(dst, b, h) do { _Pragma("unroll") for (int n = 0; n < 2; ++n) _Pragma("unroll") for (int k = 0; k < 2; ++k) dst[n][k] = *(const PG8_LAS bf16x8*)(lds + PG8_SB(b, h) + boff + n * 2048 + k * 1024); } while (0)
#define PG8_MMA(ai, bj, At, Bt) do { __builtin_amdgcn_s_setprio(1); _Pragma("unroll") for (int m = 0; m < 4; ++m) _Pragma("unroll") for (int n = 0; n < 2; ++n) _Pragma("unroll") for (int k = 0; k < 2; ++k) \
        acc[ai][bj][m][n] = __builtin_amdgcn_mfma_f32_16x16x32_bf16(Bt[n][k], At[m][k], acc[ai][bj][m][n], 0, 0, 0); __builtin_amdgcn_s_setprio(0); } while (0)
#define PG8_WAIT_V(n) asm volatile("s_waitcnt vmcnt(" #n ")" ::: "memory")
#define PG8_WAIT_L(n) asm volatile("s_waitcnt lgkmcnt(" #n ")" ::: "memory")
#define PG8_BAR __builtin_amdgcn_s_barrier()
#define PG8_SCHED __builtin_amdgcn_sched_barrier(0)
    Unit cur, nxt; int ui = 0;
    if (!S.next(0, cur)) return;
    f32x4 acc[2][2][4][2];
#pragma unroll
    for (int a = 0; a < 2; ++a)
#pragma unroll
        for (int b = 0; b < 2; ++b)
#pragma unroll
            for (int m = 0; m < 4; ++m)
#pragma unroll
                for (int n = 0; n < 2; ++n) acc[a][b][m][n] = (f32x4){0.f, 0.f, 0.f, 0.f};
    bf16x8 At[4][2], B0[2][2], B1[2][2];
    const char* cA = (const char*)g.A + (size_t)cur.pm * tstep; const char* cB = (const char*)g.Bt + (size_t)cur.pn * tstep;
    S.a_ready(cur);
    if constexpr (SP2) {
        PG8_STAGE(PG8_SB(0, 0), cB, voffB); PG8_STAGE(PG8_SB(0, 1), cB + hstep, voffB); PG8_STAGE(PG8_SA(0, 0), cA, voffA); PG8_STAGE(PG8_SA(0, 1), cA + hstep, voffA);
        if (wr == 1) PG8_BAR;
        PG8_WAIT_V(2); PG8_BAR;
        PG8_STAGE(PG8_SB(1, 0), cB + kstep, voffB); PG8_STAGE(PG8_SA(1, 0), cA + kstep, voffA); PG8_STAGE(PG8_SB(1, 1), cB + hstep + kstep, voffB);
        PG8_WAIT_V(6); PG8_BAR;
    } else {
        PG8_STAGE(PG8_SB(0, 0), cB, voffB); PG8_STAGE(PG8_SA(0, 0), cA, voffA); PG8_STAGE(PG8_SB(0, 1), cB + hstep, voffB); PG8_STAGE(PG8_SA(0, 1), cA + hstep, voffA);
        if (wr == 1) PG8_BAR;
        PG8_WAIT_V(4); PG8_BAR;
        PG8_STAGE(PG8_SB(1, 0), cB + kstep, voffB); PG8_STAGE(PG8_SA(1, 0), cA + kstep, voffA); PG8_STAGE(PG8_SB(1, 1), cB + hstep + kstep, voffB);
        PG8_WAIT_V(6); PG8_BAR;
    }
    for (;;) {
        const bool has_next = S.next(ui + 1, nxt);
        const char* nA = has_next ? (const char*)g.A + (size_t)nxt.pm * tstep : cA; const char* nB = has_next ? (const char*)g.Bt + (size_t)nxt.pn * tstep : cB;
        for (int t = 0; t < nt; t += 2) {
            const bool last = (t == nt - 2);
            const char* a1 = cA + (size_t)(t + 1) * kstep;
            const char* a2 = last ? nA : cA + (size_t)(t + 2) * kstep; const char* b2 = last ? nB : cB + (size_t)(t + 2) * kstep;
            const char* a3 = a2 + kstep; const char* b3 = b2 + kstep;
            if (last && has_next) S.a_ready(nxt);
            if constexpr (SP2) {
            PG8_LDB(B0, 0, 0); PG8_LDB(B1, 0, 1); PG8_SCHED; PG8_LDA(At, 0, 0); PG8_STAGE(PG8_SA(1, 1), a1 + hstep, voffA);
            PG8_WAIT_V(8); PG8_WAIT_L(0); PG8_BAR; PG8_MMA(0, 0, At, B0); PG8_MMA(0, 1, At, B1); PG8_BAR; PG8_SCHED;
            PG8_LDA(At, 0, 1); PG8_STAGE(PG8_SB(0, 0), b2, voffB); PG8_STAGE(PG8_SB(0, 1), b2 + hstep, voffB); PG8_STAGE(PG8_SA(0, 0), a2, voffA);
            PG8_WAIT_V(8); PG8_WAIT_L(0); PG8_BAR; PG8_MMA(1, 0, At, B0); PG8_MMA(1, 1, At, B1); PG8_BAR; PG8_SCHED;
            PG8_LDB(B0, 1, 0); PG8_LDB(B1, 1, 1); PG8_SCHED; PG8_LDA(At, 1, 0); PG8_STAGE(PG8_SA(0, 1), a2 + hstep, voffA);
            PG8_WAIT_V(8); PG8_WAIT_L(0); PG8_BAR; PG8_MMA(0, 0, At, B0); PG8_MMA(0, 1, At, B1); PG8_BAR; PG8_SCHED;
            PG8_LDA(At, 1, 1); PG8_STAGE(PG8_SB(1, 0), b3, voffB); PG8_STAGE(PG8_SB(1, 1), b3 + hstep, voffB); PG8_STAGE(PG8_SA(1, 0), a3, voffA);
            PG8_WAIT_V(8); PG8_WAIT_L(0); PG8_BAR; PG8_MMA(1, 0, At, B0); PG8_MMA(1, 1, At, B1); PG8_BAR; PG8_SCHED;
            } else {
            PG8_LDB(B0, 0, 0); PG8_SCHED; PG8_LDA(At, 0, 0); PG8_STAGE(PG8_SA(1, 1), a1 + hstep, voffA);
            PG8_WAIT_L(8); PG8_BAR; PG8_WAIT_L(0); PG8_MMA(0, 0, At, B0); PG8_BAR; PG8_SCHED;
            PG8_LDB(B1, 0, 1); PG8_STAGE(PG8_SB(0, 0), b2, voffB);
            PG8_BAR; PG8_WAIT_L(0); PG8_MMA(0, 1, At, B1); PG8_BAR;
            PG8_LDA(At, 0, 1); PG8_STAGE(PG8_SA(0, 0), a2, voffA);
            PG8_BAR; PG8_WAIT_L(0); PG8_MMA(1, 0, At, B0); PG8_BAR; PG8_SCHED;
            PG8_STAGE(PG8_SB(0, 1), b2 + hstep, voffB);
            PG8_WAIT_V(6); PG8_BAR; PG8_MMA(1, 1, At, B1); PG8_BAR;
            PG8_LDB(B0, 1, 0); PG8_SCHED; PG8_LDA(At, 1, 0); PG8_STAGE(PG8_SA(0, 1), a2 + hstep, voffA);
            PG8_WAIT_L(8); PG8_BAR; PG8_WAIT_L(0); PG8_MMA(0, 0, At, B0); PG8_BAR; PG8_SCHED;
            PG8_LDB(B1, 1, 1); PG8_STAGE(PG8_SB(1, 0), b3, voffB);
            PG8_BAR; PG8_WAIT_L(0); PG8_MMA(0, 1, At, B1); PG8_BAR;
            PG8_LDA(At, 1, 1); PG8_STAGE(PG8_SA(1, 0), a3, voffA);
            PG8_BAR; PG8_WAIT_L(0); PG8_MMA(1, 0, At, B0); PG8_BAR; PG8_SCHED;
            PG8_STAGE(PG8_SB(1, 1), b3 + hstep, voffB);
            PG8_WAIT_V(6); PG8_BAR; PG8_MMA(1, 1, At, B1); PG8_BAR;
            }
        }
        if constexpr (ALIGN_EPI) { if (wr == 0) PG8_BAR; }
        if constexpr (!Epi::AFTER_DRAIN) { E(acc, cur, wr, wc, fr, fq); S.done(cur); }
        if (!has_next) break;
#pragma unroll
        for (int a = 0; a < 2; ++a)
#pragma unroll
            for (int b = 0; b < 2; ++b)
#pragma unroll
                for (int m = 0; m < 4; ++m)
#pragma unroll
                    for (int n = 0; n < 2; ++n) acc[a][b][m][n] = (f32x4){0.f, 0.f, 0.f, 0.f};
        cur = nxt; cA = nA; cB = nB; ++ui;
        if constexpr (ALIGN_EPI) { if (wr == 1) PG8_BAR; }
    }
    PG8_WAIT_V(0);
    if constexpr (!ALIGN_EPI) { if (wr == 0) PG8_BAR; }
    PG8_BAR;
    if constexpr (Epi::AFTER_DRAIN) { E.fused(acc, cur, wr, wc, fr, fq, lds, wid, lane); S.done(cur); }
#undef PG8_SA
#undef PG8_SB
#undef PG8_STAGE
#undef PG8_LDA
#undef PG8_LDB
#undef PG8_MMA
#undef PG8_WAIT_V
#undef PG8_WAIT_L
#undef PG8_BAR
#undef PG8_SCHED
}
}

constexpr int NWAVES = 8, NTHR = 512;
constexpr int BATCH = 2, SEQ = 4096, T = BATCH * SEQ, D = 2048;
constexpr int NPROJ = 14848;
constexpr int C_QA = 0, C_KA = 2048, C_VA = 2304, C_QR = 2560, C_KR = 4608, C_VR = 6656, C_GR = 8704, C_GA = 10752, C_GT = 12800;
constexpr int NEXP = 64, EDIM = 1024;
constexpr float EPS = 1e-6f;
constexpr float LOG2E = 1.4426950408889634f;
constexpr float QA_SCALE = 0.125f * LOG2E;

constexpr size_t MiB = 1u << 20;
constexpr size_t WS_CTL = 0, CTL_ZERO_BYTES = 1 * MiB;
constexpr size_t WS_MOD = 1 * MiB;
constexpr size_t WS_ROPE = 2 * MiB;
constexpr size_t WS_WIN = 10 * MiB;
constexpr size_t WS_WBA = 68 * MiB, WS_WBR = 76 * MiB, WS_WOUT = 84 * MiB;
constexpr size_t WS_ROUTE = 92 * MiB;
constexpr size_t WS_WRT = 94 * MiB;
constexpr size_t WS_H = 96 * MiB;
constexpr size_t WS_X1 = 128 * MiB;
constexpr size_t WS_P = 192 * MiB;
constexpr size_t WS_VTA = 424 * MiB;
constexpr size_t WS_VTR = 428 * MiB;
constexpr size_t WS_KRT = 460 * MiB;
constexpr size_t WS_SC = 492 * MiB;
constexpr size_t WS_ST = 620 * MiB;
constexpr size_t WS_ATTN = 684 * MiB;
constexpr size_t WS_RET = 716 * MiB;
constexpr size_t WS_M1 = 748 * MiB;
constexpr size_t WS_MERGED = 812 * MiB;
constexpr size_t WS_XG = 192 * MiB;
constexpr size_t WS_HB = 320 * MiB;
constexpr size_t WS_Y = 384 * MiB;
constexpr size_t WS_WGU = 848 * MiB;
constexpr size_t WS_WD = 1360 * MiB;
constexpr size_t WS_END = 1616 * MiB;

constexpr int CW_TMO = 0, CW_BAR = 4096, CW_CNT = 16384;

constexpr int RING_BYTES = 131072;
constexpr int MISC_OFF = RING_BYTES;
constexpr int MISC_BYTES = 16384;
constexpr int LDS_BYTES = RING_BYTES + MISC_BYTES;

#define GAS __attribute__((address_space(1)))
#define LAS __attribute__((address_space(3)))
typedef unsigned short bf16;
typedef unsigned v4u __attribute__((ext_vector_type(4)));
typedef unsigned v2u __attribute__((ext_vector_type(2)));
typedef float f32x4 __attribute__((ext_vector_type(4)));
typedef short bf16x8 __attribute__((ext_vector_type(8)));
typedef GAS unsigned gu32;
#define RLX_AGENT __ATOMIC_RELAXED, __HIP_MEMORY_SCOPE_AGENT
#define LDS_WAIT() asm volatile("s_waitcnt lgkmcnt(0)" ::: "memory")
#define VM_WAIT() asm volatile("s_waitcnt vmcnt(0)" ::: "memory")
__device__ __forceinline__ unsigned f2bf(float f) { unsigned u = __builtin_bit_cast(unsigned, f); return (u + 0x7fffu + ((u >> 16) & 1u)) >> 16; }
__device__ __forceinline__ unsigned pk2(float lo, float hi) { return f2bf(lo) | (f2bf(hi) << 16); }
__device__ __forceinline__ float bf2f(unsigned b) { return __builtin_bit_cast(float, b << 16); }
__device__ __forceinline__ float wave_sum(float v) {
#pragma unroll
    for (int o = 1; o < 64; o <<= 1) v += __shfl_xor(v, o);
    return v;
}
__device__ __forceinline__ float sum16(float v) {
#pragma unroll
    for (int o = 1; o < 16; o <<= 1) v += __shfl_xor(v, o);
    return v;
}
__device__ __forceinline__ float max16(float v) {
#pragma unroll
    for (int o = 1; o < 16; o <<= 1) v = fmaxf(v, __shfl_xor(v, o));
    return v;
}
__device__ __forceinline__ float sigmoidf_(float x) { return 1.0f / (1.0f + __expf(-x)); }
__device__ __forceinline__ float siluf_(float x) { return x / (1.0f + __expf(-x)); }

#define XB_TMO      128
#define XB_XCNT(j)  (256  + 64 * (j))
#define XB_XSUB(j)  (1280 + 64 * (j))
#define XB_XGEN(j)  (2304 + 64 * (j))
#define XB_TOP      3328
#define XB_TOPGEN   3392
#define XCD_BAR_WORDS 3456
#define XB_SPIN_CAP (1u << 18)

__device__ __forceinline__ unsigned xb_ld(unsigned* p)              { return __hip_atomic_load(p, __ATOMIC_RELAXED, __HIP_MEMORY_SCOPE_AGENT); }
__device__ __forceinline__ unsigned xb_add(unsigned* p, unsigned v) { return __hip_atomic_fetch_add(p, v, __ATOMIC_RELAXED, __HIP_MEMORY_SCOPE_AGENT); }
__device__ __forceinline__ unsigned xb_xcc_id() { return (unsigned)__builtin_amdgcn_s_getreg((3 << 11) | 20) & 0xFu; }
#define XB_SPIN(cond, bar) do { unsigned _sp = 0; while (cond) { __builtin_amdgcn_s_sleep(1); \
    if ((++_sp & 255u) == 0u) { if (xb_ld(&(bar)[XB_TMO])) break; if (_sp > XB_SPIN_CAP) { atomicAdd(&(bar)[XB_TMO], 1u); break; } } } } while (0)

struct XcdBarrier {
    unsigned* bar; unsigned x;
    volatile LAS unsigned* st;
};

__device__ __forceinline__ XcdBarrier xcd_barrier_post(unsigned* bar, volatile LAS unsigned* st) {
    XcdBarrier b; b.bar = bar; b.x = xb_xcc_id(); b.st = st;
    if (threadIdx.x == 0) (void)xb_add(&bar[XB_XCNT(b.x)], 1u);
    return b;
}
__device__ __forceinline__ void xcd_barrier_complete(unsigned* bar, unsigned x, unsigned& nloc, unsigned& nx) {
    const unsigned G = gridDim.x * gridDim.y * gridDim.z;
    unsigned sum, cnt, mine, sp = 0u;
    for (;;) {
        sum = 0u; cnt = 0u; mine = 0u;
#pragma unroll
        for (unsigned j = 0; j < 16; ++j) { const unsigned c = xb_ld(&bar[XB_XCNT(j)]); sum += c; cnt += (c > 0u) ? 1u : 0u; mine = (j == x) ? c : mine; }
        if (sum == G) break;
        __builtin_amdgcn_s_sleep(1);
        if ((++sp & 255u) == 0u) { if (xb_ld(&bar[XB_TMO])) break; if (sp > XB_SPIN_CAP) { atomicAdd(&bar[XB_TMO], 1u); break; } }
    }
    nloc = mine > 0u ? mine : 1u; nx = cnt > 0u ? cnt : 1u;
}

__device__ __forceinline__ void xcd_barrier(const XcdBarrier& b) {
    asm volatile("s_waitcnt vmcnt(0)" ::: "memory");
    __syncthreads();
    if (threadIdx.x == 0) {
        unsigned* bar = b.bar;
        __builtin_amdgcn_s_waitcnt(0);
        unsigned nloc = b.st[0], nx = b.st[1];
        if (nloc == 0u) { xcd_barrier_complete(bar, b.x, nloc, nx); b.st[0] = nloc; b.st[1] = nx; }
        const unsigned old = xb_add(&bar[XB_XSUB(b.x)], 1u);
        const unsigned gen = old / nloc;
        if (old + 1u == (gen + 1u) * nloc) {
            __builtin_amdgcn_fence(__ATOMIC_RELEASE, "agent");
            asm volatile("s_waitcnt vmcnt(0)" ::: "memory");
            const unsigned og = xb_add(&bar[XB_TOP], 1u);
            const unsigned tg = og / nx;
            if (og + 1u == (tg + 1u) * nx) xb_add(&bar[XB_TOPGEN], 1u);
            else XB_SPIN(xb_ld(&bar[XB_TOPGEN]) == tg, bar);
            __builtin_amdgcn_fence(__ATOMIC_ACQUIRE, "agent");
            xb_add(&bar[XB_XGEN(b.x)], 1u);
            asm volatile("s_waitcnt vmcnt(0)" ::: "memory");
        } else {
            XB_SPIN(xb_ld(&bar[XB_XGEN(b.x)]) == gen, bar);
            __builtin_amdgcn_fence(__ATOMIC_ACQUIRE, "agent");
            asm volatile("s_waitcnt vmcnt(0)" ::: "memory");
        }
    }
    __syncthreads();
}


struct Args { const void* in[21]; float* out; unsigned char* ws; int ph_lo, ph_hi; };

__device__ __forceinline__ f32x4 mma16(bf16x8 a, bf16x8 b, f32x4 c) { return __builtin_amdgcn_mfma_f32_16x16x32_bf16(a, b, c, 0, 0, 0); }
__device__ __forceinline__ bf16x8 ldg8(const bf16* p) { return *(const GAS bf16x8*)p; }

namespace pg8 {
struct EpiProj {
    static constexpr bool PERM = true, AFTER_DRAIN = false;
    bf16* P; bf16* Vta; bf16* Vtr; bf16* Krt; const float* cosT; const float* sinT;
    __device__ __forceinline__ void operator()(const f32x4 (&acc)[2][2][4][2], const Unit& u, int wr, int wc, int fr, int fq) const {
        const int pn = u.pn;
        const int row0 = u.pm * BM + wr * 64 + fr;
        const int cl = wc * 32 + 8 * fq;
        if (pn == 9 || (pn >= 26 && pn < 34)) {
            bf16* base; int chan0, nchan;
            if (pn == 9) { base = Vta; chan0 = 0; nchan = 256; } else { base = Vtr; chan0 = (pn - 26) * 256; nchan = 2048; }
#pragma unroll
            for (int ai = 0; ai < 2; ++ai)
#pragma unroll
                for (int m = 0; m < 4; ++m) {
                    const int row = row0 + ai * HALF + m * 16; const int b = row >> 12, s = row & 4095;
                    bf16* colp = base + ((size_t)(b * nchan + chan0 + cl) * 4096 + s);
#pragma unroll
                    for (int bj = 0; bj < 2; ++bj)
#pragma unroll
                        for (int n = 0; n < 2; ++n)
#pragma unroll
                            for (int i = 0; i < 4; ++i) colp[(size_t)(bj * HALF + 4 * n + i) * 4096] = (bf16)f2bf(acc[ai][bj][m][n][i]);
                }
            return;
        }
        const bool rot = (pn >= 10 && pn < 26);
        const bool isk = (pn >= 18 && pn < 26);
        float lg2 = 0.f;
        if (isk) { const int h = pn - 18; lg2 = log1pf(-exp2f(-5.0f - (float)h)) * LOG2E; }
#pragma unroll
        for (int ai = 0; ai < 2; ++ai)
#pragma unroll
            for (int m = 0; m < 4; ++m) {
                const int row = row0 + ai * HALF + m * 16;
                f32x4 v[2][2];
#pragma unroll
                for (int bj = 0; bj < 2; ++bj)
#pragma unroll
                    for (int n = 0; n < 2; ++n) v[bj][n] = acc[ai][bj][m][n];
                if (rot) {
                    const float* cp = cosT + (size_t)row * 128 + cl; const float* sp = sinT + (size_t)row * 128 + cl;
#pragma unroll
                    for (int n = 0; n < 2; ++n) {
                        const f32x4 c = *(const f32x4*)(cp + 4 * n), s = *(const f32x4*)(sp + 4 * n);
                        const f32x4 t1 = v[0][n], t2 = v[1][n];
                        v[0][n] = t1 * c - t2 * s; v[1][n] = t1 * s + t2 * c;
                    }
                    if (isk) {
#pragma unroll
                        for (int n = 0; n < 2; ++n) { v[0][n] = v[0][n] * 0.0625f; v[1][n] = v[1][n] * 0.0625f; }
                    }
                } else if (pn < 8) {
#pragma unroll
                    for (int bj = 0; bj < 2; ++bj)
#pragma unroll
                        for (int n = 0; n < 2; ++n) v[bj][n] = v[bj][n] * QA_SCALE;
                } else if (pn >= 34 && pn < 42) {
#pragma unroll
                    for (int bj = 0; bj < 2; ++bj)
#pragma unroll
                        for (int n = 0; n < 2; ++n)
#pragma unroll
                            for (int i = 0; i < 4; ++i) v[bj][n][i] = siluf_(v[bj][n][i]);
                } else if (pn >= 42) {
#pragma unroll
                    for (int bj = 0; bj < 2; ++bj)
#pragma unroll
                        for (int n = 0; n < 2; ++n)
#pragma unroll
                            for (int i = 0; i < 4; ++i) v[bj][n][i] = sigmoidf_(v[bj][n][i]);
                }
                bf16* rowp = P + (size_t)row * NPROJ + pn * BM + cl;
#pragma unroll
                for (int bj = 0; bj < 2; ++bj) {
                    u32x4 w; w.x = cvt_pk_bf16(v[bj][0][0], v[bj][0][1]); w.y = cvt_pk_bf16(v[bj][0][2], v[bj][0][3]); w.z = cvt_pk_bf16(v[bj][1][0], v[bj][1][1]); w.w = cvt_pk_bf16(v[bj][1][2], v[bj][1][3]);
                    *(u32x4*)(rowp + bj * HALF) = w;
                }
                if (isk) {
                    const int b = row >> 12, s = row & 4095;
                    const float dk = exp2f((float)(127 - (s & 127)) * lg2);
                    bf16* colp = Krt + ((size_t)(b * 2048 + (pn - 18) * 256 + cl) * 4096 + s);
#pragma unroll
                    for (int bj = 0; bj < 2; ++bj)
#pragma unroll
                        for (int n = 0; n < 2; ++n)
#pragma unroll
                            for (int i = 0; i < 4; ++i) colp[(size_t)(bj * HALF + 4 * n + i) * 4096] = (bf16)f2bf(v[bj][n][i] * dk);
                }
            }
    }
};
struct EpiBranchA {
    static constexpr bool PERM = true, AFTER_DRAIN = false;
    const bf16* P; float* M1;
    __device__ __forceinline__ void operator()(const f32x4 (&acc)[2][2][4][2], const Unit& u, int wr, int wc, int fr, int fq) const {
        const int row0 = u.pm * BM + wr * 64 + fr, col0 = u.pn * BM + wc * 32 + 8 * fq;
#pragma unroll
        for (int ai = 0; ai < 2; ++ai)
#pragma unroll
            for (int m = 0; m < 4; ++m) { const int row = row0 + ai * HALF + m * 16;
#pragma unroll
                for (int bj = 0; bj < 2; ++bj) { const int col = col0 + bj * HALF;
                    const u32x4 g = *(const u32x4*)(P + (size_t)row * NPROJ + C_GA + col);
                    f32x4 o0, o1;
                    o0[0] = bf2f(g.x & 0xffffu) * acc[ai][bj][m][0][0]; o0[1] = bf2f(g.x >> 16) * acc[ai][bj][m][0][1]; o0[2] = bf2f(g.y & 0xffffu) * acc[ai][bj][m][0][2]; o0[3] = bf2f(g.y >> 16) * acc[ai][bj][m][0][3];
                    o1[0] = bf2f(g.z & 0xffffu) * acc[ai][bj][m][1][0]; o1[1] = bf2f(g.z >> 16) * acc[ai][bj][m][1][1]; o1[2] = bf2f(g.w & 0xffffu) * acc[ai][bj][m][1][2]; o1[3] = bf2f(g.w >> 16) * acc[ai][bj][m][1][3];
                    float* op = M1 + (size_t)row * D + col; *(f32x4*)op = o0; *(f32x4*)(op + 4) = o1; } }
    }
};
struct EpiBranchR {
    static constexpr bool PERM = true, AFTER_DRAIN = false;
    const bf16* P; const float* M1; bf16* MG;
    __device__ __forceinline__ void operator()(const f32x4 (&acc)[2][2][4][2], const Unit& u, int wr, int wc, int fr, int fq) const {
        const int row0 = u.pm * BM + wr * 64 + fr, col0 = u.pn * BM + wc * 32 + 8 * fq;
#pragma unroll
        for (int ai = 0; ai < 2; ++ai)
#pragma unroll
            for (int m = 0; m < 4; ++m) { const int row = row0 + ai * HALF + m * 16;
#pragma unroll
                for (int bj = 0; bj < 2; ++bj) { const int col = col0 + bj * HALF;
                    const u32x4 g = *(const u32x4*)(P + (size_t)row * NPROJ + C_GT + col);
                    const float* ip = M1 + (size_t)row * D + col; const f32x4 a0 = *(const f32x4*)ip, a1 = *(const f32x4*)(ip + 4);
                    f32x4 o0, o1;
                    o0[0] = a0[0] + bf2f(g.x & 0xffffu) * acc[ai][bj][m][0][0]; o0[1] = a0[1] + bf2f(g.x >> 16) * acc[ai][bj][m][0][1]; o0[2] = a0[2] + bf2f(g.y & 0xffffu) * acc[ai][bj][m][0][2]; o0[3] = a0[3] + bf2f(g.y >> 16) * acc[ai][bj][m][0][3];
                    o1[0] = a1[0] + bf2f(g.z & 0xffffu) * acc[ai][bj][m][1][0]; o1[1] = a1[1] + bf2f(g.z >> 16) * acc[ai][bj][m][1][1]; o1[2] = a1[2] + bf2f(g.w & 0xffffu) * acc[ai][bj][m][1][2]; o1[3] = a1[3] + bf2f(g.w >> 16) * acc[ai][bj][m][1][3];
                    u32x4 w; w.x = cvt_pk_bf16(o0[0], o0[1]); w.y = cvt_pk_bf16(o0[2], o0[3]); w.z = cvt_pk_bf16(o1[0], o1[1]); w.w = cvt_pk_bf16(o1[2], o1[3]);
                    *(u32x4*)(MG + (size_t)row * D + col) = w; } }
    }
};
struct EpiOut {
    static constexpr bool PERM = false, AFTER_DRAIN = false;
    const float* x; const float* gate1; float* X1;
    __device__ __forceinline__ void operator()(const f32x4 (&acc)[2][2][4][2], const Unit& u, int wr, int wc, int fr, int fq) const {
        const int row0 = u.pm * BM + wr * 64 + fr, col0 = u.pn * BM + wc * 32 + 4 * fq;
        const int b = (u.pm * BM) >> 12;
        f32x4 gv[2][2];
#pragma unroll
        for (int bj = 0; bj < 2; ++bj)
#pragma unroll
            for (int n = 0; n < 2; ++n) gv[bj][n] = *(const f32x4*)(gate1 + (size_t)b * 12288 + col0 + bj * HALF + n * 16);
#pragma unroll
        for (int ai = 0; ai < 2; ++ai)
#pragma unroll
            for (int m = 0; m < 4; ++m) { const size_t off = (size_t)(row0 + ai * HALF + m * 16) * D + col0;
#pragma unroll
                for (int bj = 0; bj < 2; ++bj)
#pragma unroll
                    for (int n = 0; n < 2; ++n) { const f32x4 xv = *(const f32x4*)(x + off + bj * HALF + n * 16);
                        *(f32x4*)(X1 + off + bj * HALF + n * 16) = xv + gv[bj][n] * acc[ai][bj][m][n]; } }
    }
};
struct EpiFfn1 {
    static constexpr bool PERM = true, AFTER_DRAIN = false;
    bf16* HB;
    __device__ __forceinline__ void operator()(const f32x4 (&acc)[2][2][4][2], const Unit& u, int wr, int wc, int fr, int fq) const {
        const int row0 = u.pm * BM + wr * 64 + fr, col0 = (u.pn & 7) * 128 + wc * 32 + 8 * fq;
#pragma unroll
        for (int ai = 0; ai < 2; ++ai)
#pragma unroll
            for (int m = 0; m < 4; ++m) { const int row = row0 + ai * HALF + m * 16;
                float h[8];
#pragma unroll
                for (int n = 0; n < 2; ++n)
#pragma unroll
                    for (int i = 0; i < 4; ++i) h[4 * n + i] = siluf_(acc[ai][0][m][n][i]) * acc[ai][1][m][n][i];
                u32x4 w; w.x = cvt_pk_bf16(h[0], h[1]); w.y = cvt_pk_bf16(h[2], h[3]); w.z = cvt_pk_bf16(h[4], h[5]); w.w = cvt_pk_bf16(h[6], h[7]);
                *(u32x4*)(HB + (size_t)row * EDIM + col0) = w; }
    }
};
struct EpiFfn2 {
    static constexpr bool PERM = true, AFTER_DRAIN = false;
    bf16* Y;
    __device__ __forceinline__ void operator()(const f32x4 (&acc)[2][2][4][2], const Unit& u, int wr, int wc, int fr, int fq) const {
        const int row0 = u.pm * BM + wr * 64 + fr, col0 = (u.pn & 7) * BM + wc * 32 + 8 * fq;
#pragma unroll
        for (int ai = 0; ai < 2; ++ai)
#pragma unroll
            for (int m = 0; m < 4; ++m) { const int row = row0 + ai * HALF + m * 16;
#pragma unroll
                for (int bj = 0; bj < 2; ++bj) {
                    u32x4 w; w.x = cvt_pk_bf16(acc[ai][bj][m][0][0], acc[ai][bj][m][0][1]); w.y = cvt_pk_bf16(acc[ai][bj][m][0][2], acc[ai][bj][m][0][3]);
                    w.z = cvt_pk_bf16(acc[ai][bj][m][1][0], acc[ai][bj][m][1][1]); w.w = cvt_pk_bf16(acc[ai][bj][m][1][2], acc[ai][bj][m][1][3]);
                    *(u32x4*)(Y + (size_t)row * D + col0 + bj * HALF) = w; } }
    }
};
struct MoeOrder {
    const LAS int* blk_e; int nblk, NT, G, c;
    __device__ __forceinline__ bool next(int i, Unit& u) const {
        const int L = i * G + c; if (L >= nblk * NT) return false;
        const int blk = L / NT, j = L - blk * NT; u.pm = blk; u.pn = blk_e[blk] * NT + j; return true;
    }
    __device__ __forceinline__ void a_ready(const Unit&) const {}
    __device__ __forceinline__ void done(const Unit&) const {}
};
}

__device__ __forceinline__ void transpose_item(const float* W, int K, int N, int k0, int n0, bf16* dst  , LAS float* scr, int lane) {
#pragma unroll 8
    for (int i = 0; i < 32; ++i) { const int kk = 2 * i + (lane >> 5); scr[kk * 33 + (lane & 31)] = W[(size_t)(k0 + kk) * N + n0 + (lane & 31)]; }
    LDS_WAIT();
    const int c = lane & 7;
#pragma unroll
    for (int j = 0; j < 4; ++j) { const int n = (lane >> 3) + 8 * j; const LAS float* s = scr + (8 * c) * 33 + n;
        v4u o; o.x = pk2(s[0 * 33], s[1 * 33]); o.y = pk2(s[2 * 33], s[3 * 33]); o.z = pk2(s[4 * 33], s[5 * 33]); o.w = pk2(s[6 * 33], s[7 * 33]);
        *(GAS v4u*)(dst + (size_t)n * K + k0 + 8 * c) = o; }
    LDS_WAIT();
}

__global__ void __launch_bounds__(NTHR, 2) fwd_kernel(Args args) {
    extern __shared__ __attribute__((aligned(16))) unsigned char lds_raw[];
    LAS unsigned char* lds = (LAS unsigned char*)lds_raw;
    volatile LAS unsigned* MISC = (volatile LAS unsigned*)(lds + MISC_OFF);
    const int tid = threadIdx.x, lane = tid & 63, wave = __builtin_amdgcn_readfirstlane(tid >> 6);
    const int G = gridDim.x, bid = blockIdx.x;
    unsigned char* ws = args.ws;
    gu32* ctl = (gu32*)(ws + WS_CTL);
    const int lo = args.ph_lo, hi = args.ph_hi;

    const float* x = (const float*)args.in[0];
    const float* cvec = (const float*)args.in[1];
    const int* positions = (const int*)args.in[2];
    const float* norm1_gain = (const float*)args.in[3];
    const float* norm2_gain = (const float*)args.in[4];
    const float* final_gain = (const float*)args.in[5];
    const float* w_ada = (const float*)args.in[6];
    const float* b_ada = (const float*)args.in[7];
    const float* w_in = (const float*)args.in[8];
    const float* attn_sinks = (const float*)args.in[9];
    const float* ret_gain = (const float*)args.in[10];
    const float* w_ba = (const float*)args.in[11];
    const float* w_br = (const float*)args.in[12];
    const float* w_out = (const float*)args.in[13];
    const float* w_rg = (const float*)args.in[14];
    const float* b_rg = (const float*)args.in[15];
    const float* w_re = (const float*)args.in[16];
    const float* b_re = (const float*)args.in[17];
    const float* w_eg = (const float*)args.in[18];
    const float* w_eu = (const float*)args.in[19];
    const float* w_ed = (const float*)args.in[20];

    float* mod = (float*)(ws + WS_MOD);
    float* cosT = (float*)(ws + WS_ROPE); float* sinT = cosT + (size_t)T * 128;
    bf16* Win_t = (bf16*)(ws + WS_WIN); bf16* Wba_t = (bf16*)(ws + WS_WBA); bf16* Wbr_t = (bf16*)(ws + WS_WBR); bf16* Wout_t = (bf16*)(ws + WS_WOUT);
    bf16* Wrt = (bf16*)(ws + WS_WRT);
    bf16* Hb = (bf16*)(ws + WS_H);
    float* X1 = (float*)(ws + WS_X1);
    bf16* P = (bf16*)(ws + WS_P);
    bf16* Vta = (bf16*)(ws + WS_VTA); bf16* Vtr = (bf16*)(ws + WS_VTR); bf16* Krt = (bf16*)(ws + WS_KRT);
    float* SC = (float*)(ws + WS_SC); bf16* ST = (bf16*)(ws + WS_ST);
    bf16* ATT = (bf16*)(ws + WS_ATTN); bf16* RET = (bf16*)(ws + WS_RET);
    float* M1 = (float*)(ws + WS_M1); bf16* MG = (bf16*)(ws + WS_MERGED);
    bf16* XG = (bf16*)(ws + WS_XG); bf16* HB = (bf16*)(ws + WS_HB); bf16* YB = (bf16*)(ws + WS_Y);
    bf16* WGU = (bf16*)(ws + WS_WGU); bf16* WDt = (bf16*)(ws + WS_WD);
    int* route = (int*)(ws + WS_ROUTE);
    gu32* ecnt = ctl + CW_CNT;

    for (int u = tid; u < MISC_BYTES / 4; u += NTHR) ((LAS unsigned*)(lds + MISC_OFF))[u] = 0u;
    __syncthreads();
    XcdBarrier bar = xcd_barrier_post((unsigned*)(ctl + CW_BAR), MISC + 8);

#define IN(k) (lo <= (k) && (k) < hi)
#define SEAM(k) do { if (IN(k) && IN((k) + 1)) xcd_barrier(bar); } while (0)

    if (IN(0)) {
        {
            LAS float* sc = (LAS float*)lds;
            LAS float* red = (LAS float*)(lds + 16384);
            bool have = false;
            for (int it = bid; it < 192; it += G) {
                if (!have) { for (int i = tid; i < 2 * D; i += NTHR) sc[i] = siluf_(cvec[i]); have = true; __syncthreads(); }
                const int n0 = it * 64, cg = tid & 15, rg = tid >> 4;
                f32x4 a0 = {0.f, 0.f, 0.f, 0.f}, a1 = {0.f, 0.f, 0.f, 0.f};
                for (int k = rg; k < D; k += 32) { const f32x4 w = *(const GAS f32x4*)(w_ada + (size_t)k * 12288 + n0 + 4 * cg); a0 += w * sc[k]; a1 += w * sc[D + k]; }
#pragma unroll
                for (int i = 0; i < 4; ++i) { red[tid * 8 + i] = a0[i]; red[tid * 8 + 4 + i] = a1[i]; }
                __syncthreads();
                if (tid < 128) { const int b = tid >> 6, col = tid & 63, cgi = col >> 2, ci = col & 3; float s = 0.f;
                    for (int r = 0; r < 32; ++r) s += red[(r * 16 + cgi) * 8 + b * 4 + ci];
                    mod[b * 12288 + n0 + col] = s + b_ada[n0 + col]; }
                __syncthreads();
            }
            __syncthreads();
        }
        for (int i = bid * NTHR + tid; i < T * 128; i += G * NTHR) {
            const int tok = i >> 7, f = i & 127;
            const double inv = exp2(-(double)f * (13.287712379549449 / 128.0));
            double rv = (double)positions[tok] * inv * 0.15915494309189535;
            rv -= floor(rv);
            const float rf = (float)rv;
            cosT[i] = __builtin_amdgcn_cosf(rf); sinT[i] = __builtin_amdgcn_sinf(rf);
        }
        for (int i = bid * NTHR + tid; i < 80 * D; i += G * NTHR) {
            const int n = i >> 11, k = i & 2047; float v = 0.f;
            if (n < 64) v = w_re[(size_t)k * 64 + n]; else if (n < 68) v = w_rg[(size_t)k * 4 + (n - 64)];
            Wrt[i] = (bf16)f2bf(v);
        }
        {
            LAS float* scr = (LAS float*)(lds + 32768 + wave * 8704);
            const int gw = bid * NWAVES + wave, NGW = G * NWAVES;
            constexpr int I_IN = 32 * (NPROJ / 32), I_SQ = 32 * 64, I_EGU = 32 * 32, I_ED = 16 * 64;
            constexpr int NIT = I_IN + 3 * I_SQ + NEXP * (2 * I_EGU + I_ED);
            for (int it = gw; it < NIT; it += NGW) {
                int r = it;
                if (r < I_IN) { const int nb = NPROJ / 32, kb = r / nb, n0 = (r % nb) * 32; transpose_item(w_in, D, NPROJ, kb * 64, n0, Win_t + (size_t)n0 * D, scr, lane); continue; } r -= I_IN;
                if (r < 3 * I_SQ) { const int w = r / I_SQ; r -= w * I_SQ; const int kb = r / 64, n0 = (r % 64) * 32;
                    const float* src = w == 0 ? w_ba : (w == 1 ? w_br : w_out); bf16* dst = w == 0 ? Wba_t : (w == 1 ? Wbr_t : Wout_t);
                    transpose_item(src, D, D, kb * 64, n0, dst + (size_t)n0 * D, scr, lane); continue; } r -= 3 * I_SQ;
                const int e = r / (2 * I_EGU + I_ED); r -= e * (2 * I_EGU + I_ED);
                if (r < 2 * I_EGU) { const int up = r / I_EGU; r -= up * I_EGU; const int kb = r / 32, n0 = (r % 32) * 32;
                    const float* src = (up ? w_eu : w_eg) + (size_t)e * D * EDIM;
                    bf16* dst = WGU + (size_t)((e * 8 + (n0 >> 7)) * 256 + up * 128 + (n0 & 127)) * D;
                    transpose_item(src, D, EDIM, kb * 64, n0, dst, scr, lane); continue; } r -= 2 * I_EGU;
                { const int kb = r / 64, n0 = (r % 64) * 32; const float* src = w_ed + (size_t)e * EDIM * D;
                    transpose_item(src, EDIM, D, kb * 64, n0, WDt + (size_t)(e * 2048 + n0) * EDIM, scr, lane); }
            }
        }
    }
    SEAM(0);

    if (IN(1)) {
        const int gw = bid * NWAVES + wave, NGW = G * NWAVES;
        for (int row = gw; row < T; row += NGW) {
            const int b = row >> 12;
            const GAS f32x4* xr = (const GAS f32x4*)(x + (size_t)row * D) + lane;
            f32x4 v[8]; float ss = 0.f;
#pragma unroll
            for (int j = 0; j < 8; ++j) { v[j] = xr[64 * j]; ss += (v[j].x * v[j].x + v[j].y * v[j].y) + (v[j].z * v[j].z + v[j].w * v[j].w); }
            const float r = 1.0f / sqrtf(wave_sum(ss) * (1.0f / D) + EPS);
            GAS v2u* o8 = (GAS v2u*)(Hb + (size_t)row * D) + lane;
#pragma unroll
            for (int j = 0; j < 8; ++j) { const int k = 4 * lane + 256 * j;
                const f32x4 g = *(const GAS f32x4*)(norm1_gain + k), sh = *(const GAS f32x4*)(mod + b * 12288 + k), scl = *(const GAS f32x4*)(mod + b * 12288 + 2048 + k);
                const f32x4 hv = v[j] * r * g * (scl + 1.0f) + sh;
                v2u o; o.x = pk2(hv.x, hv.y); o.y = pk2(hv.z, hv.w); o8[64 * j] = o; }
        }
    }
    SEAM(1);

    if (IN(2)) {
        pg8::Gemm g{Hb, Win_t, T, NPROJ, D}; pg8::StaticOrder S; S.init(T, NPROJ, G, bid);
        pg8::EpiProj E{P, Vta, Vtr, Krt, cosT, sinT};
        pg8::gemm_phase<pg8::EpiProj, pg8::StaticOrder, true, true>(lds, g, S, E);
    }
    SEAM(2);

    if (IN(3)) {
        const int r16 = lane & 15, q4 = lane >> 4;
        for (int unit = bid; unit < 256 + 512; unit += G) {
            if (unit < 256) {
                const int b = unit >> 7, kvh = (unit >> 5) & 3, nb = unit & 31, head = kvh * 8 + wave;
                const float sink2 = attn_sinks[head] * LOG2E;
                const int tq0 = nb * 128, ks = (nb - 1) * 128;
                const bf16* Qb = P + (size_t)(b * SEQ + tq0) * NPROJ + C_QA + head * 64;
                const bf16* Kb = P + (size_t)(b * SEQ) * NPROJ + C_KA + kvh * 64;
                const bf16* Vb = Vta + (size_t)(b * 256 + kvh * 64) * 4096;
                LAS bf16* Pl = (LAS bf16*)(lds + wave * 5376);
                for (int t = 0; t < 8; ++t) {
                    bf16x8 qa[2];
#pragma unroll
                    for (int s = 0; s < 2; ++s) qa[s] = ldg8(Qb + (size_t)(16 * t + r16) * NPROJ + 32 * s + 8 * q4);
                    f32x4 sc[10];
#pragma unroll
                    for (int n = 0; n < 10; ++n) {
                        const int kb = (t + n) < 16 ? (t + n) : 15;
                        int tk = ks + 16 * kb + r16; tk = tk < 0 ? 0 : tk;
                        f32x4 a = {0.f, 0.f, 0.f, 0.f};
#pragma unroll
                        for (int s = 0; s < 2; ++s) a = mma16(qa[s], ldg8(Kb + (size_t)tk * NPROJ + 32 * s + 8 * q4), a);
                        sc[n] = a;
                    }
                    float mx[4], sm[4];
#pragma unroll
                    for (int reg = 0; reg < 4; ++reg) {
                        const int tq = tq0 + 16 * t + 4 * q4 + reg; float m = -INFINITY;
#pragma unroll
                        for (int n = 0; n < 10; ++n) { const int tk = ks + 16 * (t + n) + r16; const bool ok = (t + n < 16) && (tk >= 0) && (tk <= tq) && (tk + 128 > tq);
                            sc[n][reg] = ok ? sc[n][reg] : -INFINITY; m = fmaxf(m, sc[n][reg]); }
                        m = fmaxf(max16(m), sink2); mx[reg] = m; float s = 0.f;
#pragma unroll
                        for (int n = 0; n < 10; ++n) { const float p = exp2f(sc[n][reg] - m); sc[n][reg] = p; s += p; }
                        sm[reg] = 1.0f / (sum16(s) + exp2f(sink2 - m));
                    }
#pragma unroll
                    for (int n = 0; n < 10; ++n)
#pragma unroll
                        for (int reg = 0; reg < 4; ++reg) Pl[(4 * q4 + reg) * 168 + 16 * n + r16] = (bf16)f2bf(sc[n][reg] * sm[reg]);
                    LDS_WAIT();
                    f32x4 o[4];
#pragma unroll
                    for (int nd = 0; nd < 4; ++nd) o[nd] = (f32x4){0.f, 0.f, 0.f, 0.f};
#pragma unroll
                    for (int s = 0; s < 5; ++s) {
                        const bf16x8 pa = *(const LAS bf16x8*)(Pl + r16 * 168 + 32 * s + 8 * q4);
                        const int n = 2 * s + (q4 >> 1); const int kb = (t + n) < 16 ? (t + n) : 15;
                        int tk0 = ks + 16 * kb + 8 * (q4 & 1); tk0 = tk0 < 0 ? 0 : tk0;
#pragma unroll
                        for (int nd = 0; nd < 4; ++nd) o[nd] = mma16(pa, ldg8(Vb + (size_t)(16 * nd + r16) * 4096 + tk0), o[nd]);
                    }
#pragma unroll
                    for (int nd = 0; nd < 4; ++nd)
#pragma unroll
                        for (int reg = 0; reg < 4; ++reg) ATT[(size_t)(b * SEQ + tq0 + 16 * t + 4 * q4 + reg) * D + head * 64 + 16 * nd + r16] = (bf16)f2bf(o[nd][reg]);
                    LDS_WAIT();
                }
            } else {
                const int u = unit - 256, bh = u >> 5, c = u & 31, b = bh >> 3, h = bh & 7;
                const bf16* Ab = Vtr + (size_t)(b * 2048 + h * 256 + 32 * wave) * 4096 + c * 128;
                const bf16* Bb = Krt + (size_t)(b * 2048 + h * 256) * 4096 + c * 128;
#pragma unroll 1
                for (int nh = 0; nh < 2; ++nh) {
                    f32x4 acc[2][8];
#pragma unroll
                    for (int m = 0; m < 2; ++m)
#pragma unroll
                        for (int n = 0; n < 8; ++n) acc[m][n] = (f32x4){0.f, 0.f, 0.f, 0.f};
#pragma unroll 1
                    for (int s = 0; s < 4; ++s) {
                        bf16x8 a[2];
#pragma unroll
                        for (int m = 0; m < 2; ++m) a[m] = ldg8(Ab + (size_t)(16 * m + r16) * 4096 + 32 * s + 8 * q4);
#pragma unroll
                        for (int n = 0; n < 8; ++n) { const bf16x8 bb = ldg8(Bb + (size_t)(128 * nh + 16 * n + r16) * 4096 + 32 * s + 8 * q4);
                            acc[0][n] = mma16(a[0], bb, acc[0][n]); acc[1][n] = mma16(a[1], bb, acc[1][n]); }
                    }
                    float* out = SC + (size_t)u * 65536;
#pragma unroll
                    for (int m = 0; m < 2; ++m)
#pragma unroll
                        for (int n = 0; n < 8; ++n)
#pragma unroll
                            for (int reg = 0; reg < 4; ++reg) out[(size_t)(32 * wave + 16 * m + 4 * q4 + reg) * 256 + 128 * nh + 16 * n + r16] = acc[m][n][reg];
                }
            }
        }
    }
    SEAM(3);

    if (IN(4)) {
        for (int i = bid * NTHR + tid; i < 16 * 16384; i += G * NTHR) {
            const int bh = i >> 14, e4 = i & 16383, h = bh & 7;
            const float dc = expf(128.0f * log1pf(-exp2f(-5.0f - (float)h)));
            f32x4 st = {0.f, 0.f, 0.f, 0.f};
            for (int c = 0; c < 32; ++c) {
                const size_t off = (size_t)(bh * 32 + c) * 65536 + 4 * e4;
                v2u o; o.x = pk2(st.x, st.y); o.y = pk2(st.z, st.w); *(GAS v2u*)(ST + off) = o;
                const f32x4 s = *(const GAS f32x4*)(SC + off);
                st = st * dc + s;
            }
        }
    }
    SEAM(4);

    if (IN(5)) {
        const int r16 = lane & 15, q4 = lane >> 4;
        for (int u = bid; u < 512; u += G) {
            const int bh = u >> 5, c = u & 31, b = bh >> 3, h = bh & 7;
            const float lg2 = log1pf(-exp2f(-5.0f - (float)h)) * LOG2E;
            const int tok0 = b * SEQ + c * 128;
            const bf16* Qb = P + (size_t)(tok0 + 16 * wave) * NPROJ + C_QR + h * 256;
            const bf16* Kb = P + (size_t)tok0 * NPROJ + C_KR + h * 256;
            const bf16* Vb = Vtr + (size_t)(b * 2048 + h * 256) * 4096 + c * 128;
            const bf16* Sb = ST + (size_t)u * 65536;
            LAS bf16* Il = (LAS bf16*)(lds + wave * 4352);
            bf16x8 qa[8];
#pragma unroll
            for (int s = 0; s < 8; ++s) qa[s] = ldg8(Qb + (size_t)r16 * NPROJ + 32 * s + 8 * q4);
#pragma unroll
            for (int n = 0; n < 8; ++n) {
                f32x4 a = {0.f, 0.f, 0.f, 0.f};
                if (n <= wave) {
#pragma unroll
                    for (int s = 0; s < 8; ++s) a = mma16(qa[s], ldg8(Kb + (size_t)(16 * n + r16) * NPROJ + 32 * s + 8 * q4), a);
                }
#pragma unroll
                for (int reg = 0; reg < 4; ++reg) { const int qi = 16 * wave + 4 * q4 + reg, ki = 16 * n + r16; const int df = qi - ki;
                    const float v = df >= 0 ? a[reg] * exp2f((float)df * lg2) : 0.f;
                    Il[(4 * q4 + reg) * 136 + ki] = (bf16)f2bf(v); }
            }
            LDS_WAIT();
            bf16x8 ia[4];
#pragma unroll
            for (int s = 0; s < 4; ++s) ia[s] = *(const LAS bf16x8*)(Il + r16 * 136 + 32 * s + 8 * q4);
            float dq[4];
#pragma unroll
            for (int reg = 0; reg < 4; ++reg) dq[reg] = exp2f((float)(16 * wave + 4 * q4 + reg + 1) * lg2);
            f32x4 O[16]; float ss[4] = {0.f, 0.f, 0.f, 0.f};
#pragma unroll
            for (int nd = 0; nd < 16; ++nd) {
                f32x4 t2 = {0.f, 0.f, 0.f, 0.f}, t1 = {0.f, 0.f, 0.f, 0.f};
#pragma unroll
                for (int s = 0; s < 8; ++s) t2 = mma16(qa[s], ldg8(Sb + (size_t)(16 * nd + r16) * 256 + 32 * s + 8 * q4), t2);
#pragma unroll
                for (int s = 0; s < 4; ++s) t1 = mma16(ia[s], ldg8(Vb + (size_t)(16 * nd + r16) * 4096 + 32 * s + 8 * q4), t1);
#pragma unroll
                for (int reg = 0; reg < 4; ++reg) { const float v = t1[reg] + dq[reg] * t2[reg]; O[nd][reg] = v; ss[reg] += v * v; }
            }
            float rs[4];
#pragma unroll
            for (int reg = 0; reg < 4; ++reg) rs[reg] = 1.0f / sqrtf(sum16(ss[reg]) * (1.0f / 256.0f) + EPS);
#pragma unroll
            for (int nd = 0; nd < 16; ++nd) { const int ch = h * 256 + 16 * nd + r16; const float gn = ret_gain[ch];
#pragma unroll
                for (int reg = 0; reg < 4; ++reg) { const size_t tok = (size_t)(tok0 + 16 * wave + 4 * q4 + reg);
                    const float sg = bf2f(P[tok * NPROJ + C_GR + ch]);
                    RET[tok * D + ch] = (bf16)f2bf(O[nd][reg] * rs[reg] * gn * sg); } }
            LDS_WAIT();
        }
    }
    SEAM(5);

    if (IN(6)) {
        { pg8::Gemm g{ATT, Wba_t, T, D, D}; pg8::StaticOrder S; S.init(T, D, G, bid); pg8::EpiBranchA E{P, M1};
          pg8::gemm_phase<pg8::EpiBranchA, pg8::StaticOrder, true, true>(lds, g, S, E); }
        VM_WAIT(); __syncthreads();
        { pg8::Gemm g{RET, Wbr_t, T, D, D}; pg8::StaticOrder S; S.init(T, D, G, bid); pg8::EpiBranchR E{P, M1, MG};
          pg8::gemm_phase<pg8::EpiBranchR, pg8::StaticOrder, true, true>(lds, g, S, E); }
    }
    SEAM(6);

    if (IN(7)) {
        pg8::Gemm g{MG, Wout_t, T, D, D}; pg8::StaticOrder S; S.init(T, D, G, bid); pg8::EpiOut E{x, mod + 2 * 2048, X1};
        pg8::gemm_phase<pg8::EpiOut, pg8::StaticOrder, true, true>(lds, g, S, E);
    }
    SEAM(7);

    if (IN(8)) {
        const int r16 = lane & 15, q4 = lane >> 4;
        LAS bf16* Al = (LAS bf16*)lds;
        LAS float* Lg = (LAS float*)(lds + MISC_OFF + 1024);
        for (int t0 = bid * 32; t0 < T; t0 += G * 32) {
            for (int rr = 0; rr < 4; ++rr) {
                const int lrow = 4 * wave + rr, row = t0 + lrow, b = row >> 12;
                const GAS f32x4* xr = (const GAS f32x4*)(X1 + (size_t)row * D) + lane;
                f32x4 v[8]; float ss = 0.f;
#pragma unroll
                for (int j = 0; j < 8; ++j) { v[j] = xr[64 * j]; ss += (v[j].x * v[j].x + v[j].y * v[j].y) + (v[j].z * v[j].z + v[j].w * v[j].w); }
                const float r = 1.0f / sqrtf(wave_sum(ss) * (1.0f / D) + EPS);
                GAS v2u* o8 = (GAS v2u*)(Hb + (size_t)row * D) + lane;
#pragma unroll
                for (int j = 0; j < 8; ++j) { const int k = 4 * lane + 256 * j;
                    const f32x4 g = *(const GAS f32x4*)(norm2_gain + k), sh = *(const GAS f32x4*)(mod + b * 12288 + 3 * 2048 + k), scl = *(const GAS f32x4*)(mod + b * 12288 + 4 * 2048 + k);
                    const f32x4 hv = v[j] * r * g * (scl + 1.0f) + sh;
                    v2u o; o.x = pk2(hv.x, hv.y); o.y = pk2(hv.z, hv.w); o8[64 * j] = o;
                    *(LAS v2u*)(Al + lrow * 2048 + k) = o; }
            }
            __syncthreads();
            if (wave < 5) {
                f32x4 a0 = {0.f, 0.f, 0.f, 0.f}, a1 = {0.f, 0.f, 0.f, 0.f};
                const bf16* Bb = Wrt + (size_t)(16 * wave + r16) * D + 8 * q4;
                for (int s = 0; s < 64; ++s) {
                    const bf16x8 bb = ldg8(Bb + 32 * s);
                    const bf16x8 x0 = *(const LAS bf16x8*)(Al + r16 * 2048 + 32 * s + 8 * q4), x1v = *(const LAS bf16x8*)(Al + (16 + r16) * 2048 + 32 * s + 8 * q4);
                    a0 = mma16(x0, bb, a0); a1 = mma16(x1v, bb, a1);
                }
#pragma unroll
                for (int reg = 0; reg < 4; ++reg) { Lg[(4 * q4 + reg) * 80 + 16 * wave + r16] = a0[reg]; Lg[(16 + 4 * q4 + reg) * 80 + 16 * wave + r16] = a1[reg]; }
            }
            __syncthreads();
            if (tid < 32) {
                const int row = t0 + tid; const LAS float* L = Lg + tid * 80;
                float gl[4]; int gs = 0;
#pragma unroll
                for (int j = 0; j < 4; ++j) gl[j] = L[64 + j] + b_rg[j];
#pragma unroll
                for (int j = 1; j < 4; ++j) if (gl[j] > gl[gs]) gs = j;
                float den = 0.f;
#pragma unroll
                for (int j = 0; j < 4; ++j) den += expf(gl[j] - gl[gs]);
                const float gw = 1.0f / den;
                int i0 = 0; float v0 = -INFINITY;
                for (int j = 0; j < 16; ++j) { const float v = L[gs * 16 + j] + b_re[gs * 16 + j]; if (v > v0) { v0 = v; i0 = j; } }
                int i1 = 0; float v1 = -INFINITY;
                for (int j = 0; j < 16; ++j) { const float v = L[gs * 16 + j] + b_re[gs * 16 + j]; if (j != i0 && v > v1) { v1 = v; i1 = j; } }
                const float e1 = expf(v1 - v0); const float w0 = gw / (1.0f + e1), w1 = gw * e1 / (1.0f + e1);
                const int ex0 = gs * 16 + i0, ex1 = gs * 16 + i1;
                const int p0 = (int)__hip_atomic_fetch_add(ecnt + ex0, 1u, RLX_AGENT), p1 = (int)__hip_atomic_fetch_add(ecnt + ex1, 1u, RLX_AGENT);
                int* rt = route + (size_t)row * 8;
                rt[0] = ex0; rt[1] = p0; rt[2] = ex1; rt[3] = p1; rt[4] = __builtin_bit_cast(int, w0); rt[5] = __builtin_bit_cast(int, w1);
            }
            __syncthreads();
        }
    }
    SEAM(8);

    LAS int* blk_e = (LAS int*)(lds + MISC_OFF + 12288);
    LAS int* bstart = (LAS int*)(lds + MISC_OFF + 12288 + 512);
    LAS int* nblk_p = (LAS int*)(lds + MISC_OFF + 12288 + 768);
    if (hi > 9 && lo <= 12) {
        if (tid == 0) { int nb = 0;
            for (int e = 0; e < NEXP; ++e) { const int cnt = (int)__hip_atomic_load(ecnt + e, RLX_AGENT); const int k = (cnt + 255) >> 8; bstart[e] = nb; for (int j = 0; j < k; ++j) blk_e[nb + j] = e; nb += k; }
            nblk_p[0] = nb; }
        __syncthreads();
    }

    if (IN(9)) {
        const int gw = bid * NWAVES + wave, NGW = G * NWAVES;
        for (int a = gw; a < 2 * T; a += NGW) {
            const int tok = a >> 1, k = a & 1; const int* rt = route + (size_t)tok * 8;
            const int e = rt[2 * k], pos = rt[2 * k + 1]; const int row = bstart[e] * 256 + pos;
            const GAS v4u* src = (const GAS v4u*)(Hb + (size_t)tok * D) + lane; GAS v4u* dst = (GAS v4u*)(XG + (size_t)row * D) + lane;
#pragma unroll
            for (int j = 0; j < 4; ++j) dst[64 * j] = src[64 * j];
        }
    }
    SEAM(9);

    if (IN(10)) {
        pg8::Gemm g{XG, WGU, 0, 0, D}; pg8::MoeOrder S{blk_e, nblk_p[0], 8, G, bid}; pg8::EpiFfn1 E{HB};
        pg8::gemm_phase<pg8::EpiFfn1, pg8::MoeOrder, true, true>(lds, g, S, E);
    }
    SEAM(10);

    if (IN(11)) {
        pg8::Gemm g{HB, WDt, 0, 0, EDIM}; pg8::MoeOrder S{blk_e, nblk_p[0], 8, G, bid}; pg8::EpiFfn2 E{YB};
        pg8::gemm_phase<pg8::EpiFfn2, pg8::MoeOrder, true, true>(lds, g, S, E);
    }
    SEAM(11);

    if (IN(12)) {
        const int gw = bid * NWAVES + wave, NGW = G * NWAVES;
        for (int row = gw; row < T; row += NGW) {
            const int b = row >> 12; const int* rt = route + (size_t)row * 8;
            const int r0 = bstart[rt[0]] * 256 + rt[1], r1 = bstart[rt[2]] * 256 + rt[3];
            const float w0 = __builtin_bit_cast(float, rt[4]), w1 = __builtin_bit_cast(float, rt[5]);
            const GAS f32x4* xr = (const GAS f32x4*)(X1 + (size_t)row * D) + lane;
            const GAS v2u* y0 = (const GAS v2u*)(YB + (size_t)r0 * D) + lane; const GAS v2u* y1 = (const GAS v2u*)(YB + (size_t)r1 * D) + lane;
            f32x4 v[8]; float ss = 0.f;
#pragma unroll
            for (int j = 0; j < 8; ++j) { const int k = 4 * lane + 256 * j;
                const f32x4 g2 = *(const GAS f32x4*)(mod + b * 12288 + 5 * 2048 + k);
                const v2u a = y0[64 * j], bq = y1[64 * j];
                f32x4 f; f.x = w0 * bf2f(a.x & 0xffffu) + w1 * bf2f(bq.x & 0xffffu); f.y = w0 * bf2f(a.x >> 16) + w1 * bf2f(bq.x >> 16);
                f.z = w0 * bf2f(a.y & 0xffffu) + w1 * bf2f(bq.y & 0xffffu); f.w = w0 * bf2f(a.y >> 16) + w1 * bf2f(bq.y >> 16);
#ifdef DBG_SKIP_MOE
                v[j] = xr[64 * j];
#else
                v[j] = xr[64 * j] + g2 * f;
#endif
                ss += (v[j].x * v[j].x + v[j].y * v[j].y) + (v[j].z * v[j].z + v[j].w * v[j].w); }
            const float r = 1.0f / sqrtf(wave_sum(ss) * (1.0f / D) + EPS);
            GAS f32x4* o = (GAS f32x4*)(args.out + (size_t)row * D) + lane;
#pragma unroll
            for (int j = 0; j < 8; ++j) { const f32x4 g = *(const GAS f32x4*)(final_gain + 4 * lane + 256 * j); o[64 * j] = v[j] * r * g; }
        }
    }
#undef IN
#undef SEAM
}


#ifdef DBG_TAP
__global__ void tap_kernel(unsigned char* ws, float* out, int mode) {
    const bf16* Hb = (const bf16*)(ws + WS_H); const bf16* P = (const bf16*)(ws + WS_P);
    const bf16* Vta = (const bf16*)(ws + WS_VTA); const bf16* Vtr = (const bf16*)(ws + WS_VTR); const bf16* Krt = (const bf16*)(ws + WS_KRT);
    const float* SC = (const float*)(ws + WS_SC); const bf16* ST = (const bf16*)(ws + WS_ST);
    const bf16* ATT = (const bf16*)(ws + WS_ATTN); const bf16* RET = (const bf16*)(ws + WS_RET); const bf16* MG = (const bf16*)(ws + WS_MERGED);
    const float* X1 = (const float*)(ws + WS_X1); const float* mod = (const float*)(ws + WS_MOD);
    for (size_t i = (size_t)blockIdx.x * blockDim.x + threadIdx.x; i < (size_t)T * D; i += (size_t)gridDim.x * blockDim.x) {
        const int row = (int)(i >> 11), c = (int)(i & 2047), b = row >> 12, s = row & 4095; float v = 0.f;
        if (mode == 0) v = mod[(i % 24576)];
        if (mode == 1) v = bf2f(Hb[i]);
        if (mode == 2) { v = bf2f(P[(size_t)row * NPROJ + c]) + bf2f(P[(size_t)row * NPROJ + C_QR + c]) + bf2f(P[(size_t)row * NPROJ + C_KR + c]) + bf2f(P[(size_t)row * NPROJ + C_GR + c]) + bf2f(P[(size_t)row * NPROJ + C_GA + c]) + bf2f(P[(size_t)row * NPROJ + C_GT + c])
                 + bf2f(P[(size_t)row * NPROJ + C_KA + (c & 255)]) + bf2f(Vtr[(size_t)(b * 2048 + c) * 4096 + s]) + bf2f(Krt[(size_t)(b * 2048 + c) * 4096 + s]) + bf2f(Vta[(size_t)(b * 256 + (c & 255)) * 4096 + s]); }
        if (mode == 3) { v = bf2f(ATT[i]); for (int j = 0; j < 4; ++j) v += SC[i * 4 + j] * 0.01f; }
        if (mode == 4) { for (int j = 0; j < 2; ++j) v += bf2f(ST[i * 2 + j]); }
        if (mode == 5) v = bf2f(RET[i]);
        if (mode == 6) v = bf2f(MG[i]);
        if (mode == 7) v = X1[i];
        out[i] = v;
    }
}
#endif
constexpr int NPHASES = 13;
#ifndef MK_ONE_LAUNCH
#define MK_ONE_LAUNCH 0
#endif
extern "C" void kernel_launch(void* const* d_in, const int* in_sizes, int n_in, void* d_out, int out_size, void* d_ws, size_t ws_size, hipStream_t stream) {
    static int grid = 0;
    if (grid == 0) {
        if (n_in != 21 || out_size != T * D || ws_size < WS_END) { fprintf(stderr, "kernel_launch: unexpected shapes (n_in %d out %d ws %zu)\n", n_in, out_size, ws_size); grid = -1; return; }
        int dev = 0, cus = 0, per_cu = 0;
        if (hipGetDevice(&dev) != hipSuccess || hipDeviceGetAttribute(&cus, hipDeviceAttributeMultiprocessorCount, dev) != hipSuccess) { grid = -1; return; }
        if (hipFuncSetAttribute((const void*)fwd_kernel, hipFuncAttributeMaxDynamicSharedMemorySize, LDS_BYTES) != hipSuccess) { fprintf(stderr, "kernel_launch: hipFuncSetAttribute failed\n"); grid = -1; return; }
        if (hipOccupancyMaxActiveBlocksPerMultiprocessor(&per_cu, (const void*)fwd_kernel, NTHR, LDS_BYTES) != hipSuccess || per_cu < 1) { fprintf(stderr, "kernel_launch: occupancy query says %d\n", per_cu); }
        (void)hipGetLastError();
        grid = cus;
    }
    if (grid < 0) return;
    if (hipMemsetAsync((char*)d_ws + WS_CTL, 0, CTL_ZERO_BYTES, stream) != hipSuccess) return;
    Args a{};
    for (int i = 0; i < 21; ++i) a.in[i] = d_in[i];
    a.out = (float*)d_out; a.ws = (unsigned char*)d_ws;
#if MK_ONE_LAUNCH
    a.ph_lo = 0; a.ph_hi = NPHASES;
    hipLaunchKernelGGL(fwd_kernel, dim3(grid), dim3(NTHR), LDS_BYTES, stream, a);
#else
#ifdef DBG_TAP
    for (int p = 0; p <= DBG_TAP; ++p) { a.ph_lo = p; a.ph_hi = p + 1; hipLaunchKernelGGL(fwd_kernel, dim3(grid), dim3(NTHR), LDS_BYTES, stream, a); }
    hipLaunchKernelGGL(tap_kernel, dim3(2048), dim3(256), 0, stream, (unsigned char*)d_ws, (float*)d_out, (int)DBG_TAPMODE);
#else
    for (int p = 0; p < NPHASES; ++p) { a.ph_lo = p; a.ph_hi = p + 1; hipLaunchKernelGGL(fwd_kernel, dim3(grid), dim3(NTHR), LDS_BYTES, stream, a); }
#endif
#endif
}
```

```cpp
#define MK_ONE_LAUNCH 1
#include <hip/hip_runtime.h>
#include <cstdio>
#include <cstdint>
#include <cmath>
namespace pg8 {
#define PG8_LAS __attribute__((address_space(3)))
typedef unsigned short bf16_t;
typedef short bf16x8 __attribute__((ext_vector_type(8)));
typedef float f32x4 __attribute__((ext_vector_type(4)));
typedef unsigned u32x4 __attribute__((ext_vector_type(4)));
constexpr int BM = 256, BK = 64, HALF = 128, HTB = HALF * BK * 2  , STAGE_BYTES = 8 * HTB, NXCD = 8, WGM = 8;

__host__ __device__ __forceinline__ int lds_byte(int r, int c) { const int st = (r >> 4) * 2 + (c >> 5), rr = r & 15, cc = c & 31, ob = rr * 64 + cc * 2; return st * 1024 + (ob ^ (((ob >> 9) & 1) << 5)); }
__host__ __device__ __forceinline__ void stage_rc(int b, int& R, int& C) { const int st = b / 1024, sb = b % 1024, swz = sb ^ (((sb >> 9) & 1) << 5); R = (st >> 1) * 16 + swz / 64; C = (st & 1) * 32 + (swz % 64) / 2; }
__host__ __device__ __forceinline__ int perm32(int rho) { const int n = rho >> 4, i = rho & 15; return 8 * (i >> 2) + 4 * n + (i & 3); }

struct Unit { int pm, pn; };
struct Gemm { const bf16_t* A; const bf16_t* Bt; int M, N, K; };

struct StaticOrder {
    int nM, nN, nwg, G, c;
    __host__ __device__ void init(int M, int N, int G_, int c_) { nM = M / BM; nN = N / BM; nwg = nM * nN; G = G_; c = c_; }
    __host__ __device__ bool next(int i, Unit& u) const {
        const long L = (long)i * G + c; if (L >= nwg) return false;
        int wgid = (int)L; { const int q = nwg / NXCD, r = nwg % NXCD, xcd = wgid % NXCD, off = wgid / NXCD; wgid = (xcd < r ? xcd * (q + 1) : r * (q + 1) + (xcd - r) * q) + off; }
        const int nig = WGM * nN, gid = wgid / nig, fm = gid * WGM, gsz = (nM - fm) < WGM ? (nM - fm) : WGM;
        u.pm = fm + ((wgid % nig) % gsz); u.pn = (wgid % nig) / gsz; return true;
    }
    __device__ __forceinline__ void a_ready(const Unit&) const {}
    __device__ __forceinline__ void done(const Unit&) const {}
};

__device__ __forceinline__ unsigned cvt_pk_bf16(float lo, float hi) { unsigned r; asm volatile("v_cvt_pk_bf16_f32 %0, %1, %2" : "=v"(r) : "v"(lo), "v"(hi)); return r; }
template <class Epi, class Sched, bool ALIGN_EPI = false, bool SP2 = false>
__device__ __forceinline__ void gemm_phase(PG8_LAS unsigned char* lds, const Gemm g, const Sched& S, const Epi& E) {
    const int tid = threadIdx.x, wid = __builtin_amdgcn_readfirstlane(tid >> 6), lane = tid & 63, wr = wid >> 2, wc = wid & 3, fr = lane & 15, fq = lane >> 4;
    const int K = g.K, nt = K / BK;
    unsigned voffA[2], voffB[2];
#pragma unroll
    for (int i = 0; i < 2; ++i) { int R, C; stage_rc(tid * 16 + i * 8192, R, C); const int Rb = Epi::PERM ? ((R & ~31) + perm32(R & 31)) : R;
        voffA[i] = (unsigned)(R * K + C) * 2u; voffB[i] = (unsigned)(Rb * K + C) * 2u; }
    const size_t kstep = (size_t)(BK * 2);
    const size_t hstep = (size_t)HALF * K * 2;
    const size_t tstep = 2 * hstep;
    const unsigned ldsw = (unsigned)wid * 1024u;
    const int aoff = lds_byte(wr * 64 + fr, fq * 8), boff = lds_byte(wc * 32 + fr, fq * 8);
#define PG8_SA(b, h) (((b) * 2 + (h)) * HTB)
#define PG8_SB(b, h) ((4 + (b) * 2 + (h)) * HTB)
#define PG8_STAGE(bufoff, gbase, voff) do { _Pragma("unroll") for (int _i = 0; _i < 2; ++_i) \
        __builtin_amdgcn_global_load_lds((const unsigned*)((const char*)(gbase) + (voff)[_i]), (PG8_LAS unsigned*)(lds + (bufoff) + ldsw + _i * 8192), 16, 0, 0); } while (0)
#define PG8_LDA(dst, b, h) do { _Pragma("unroll") for (int m = 0; m < 4; ++m) _Pragma("unroll") for (int k = 0; k < 2; ++k) dst[m][k] = *(const PG8_LAS bf16x8*)(lds + PG8_SA(b, h) + aoff + m * 2048 + k * 1024); } while (0)
#define PG8_LDB(dst, b, h) do { _Pragma("unroll") for (int n = 0; n < 2; ++n) _Pragma("unroll") for (int k = 0; k < 2; ++k) dst[n][k] = *(const PG8_LAS bf16x8*)(lds + PG8_SB(b, h) + boff + n * 2048 + k * 1024); } while (0)
#define PG8_MMA(ai, bj, At, Bt) do { __builtin_amdgcn_s_setprio(1); _Pragma("unroll") for (int m = 0; m < 4; ++m) _Pragma("unroll") for (int n = 0; n < 2; ++n) _Pragma("unroll") for (int k = 0; k < 2; ++k) \
        acc[ai][bj][m][n] = __builtin_amdgcn_mfma_f32_16x16x32_bf16(Bt[n][k], At[m][k], acc[ai][bj][m][n], 0, 0, 0); __builtin_amdgcn_s_setprio(0); } while (0)
#define PG8_WAIT_V(n) asm volatile("s_waitcnt vmcnt(" #n ")" ::: "memory")
#define PG8_WAIT_L(n) asm volatile("s_waitcnt lgkmcnt(" #n ")" ::: "memory")
#define PG8_BAR __builtin_amdgcn_s_barrier()
#define PG8_SCHED __builtin_amdgcn_sched_barrier(0)
    Unit cur, nxt; int ui = 0;
    if (!S.next(0, cur)) return;
    f32x4 acc[2][2][4][2];
#pragma unroll
    for (int a = 0; a < 2; ++a)
#pragma unroll
        for (int b = 0; b < 2; ++b)
#pragma unroll
            for (int m = 0; m < 4; ++m)
#pragma unroll
                for (int n = 0; n < 2; ++n) acc[a][b][m][n] = (f32x4){0.f, 0.f, 0.f, 0.f};
    bf16x8 At[4][2], B0[2][2], B1[2][2];
    const char* cA = (const char*)g.A + (size_t)cur.pm * tstep; const char* cB = (const char*)g.Bt + (size_t)cur.pn * tstep;
    S.a_ready(cur);
    if constexpr (SP2) {
        PG8_STAGE(PG8_SB(0, 0), cB, voffB); PG8_STAGE(PG8_SB(0, 1), cB + hstep, voffB); PG8_STAGE(PG8_SA(0, 0), cA, voffA); PG8_STAGE(PG8_SA(0, 1), cA + hstep, voffA);
        if (wr == 1) PG8_BAR;
        PG8_WAIT_V(2); PG8_BAR;
        PG8_STAGE(PG8_SB(1, 0), cB + kstep, voffB); PG8_STAGE(PG8_SA(1, 0), cA + kstep, voffA); PG8_STAGE(PG8_SB(1, 1), cB + hstep + kstep, voffB);
        PG8_WAIT_V(6); PG8_BAR;
    } else {
        PG8_STAGE(PG8_SB(0, 0), cB, voffB); PG8_STAGE(PG8_SA(0, 0), cA, voffA); PG8_STAGE(PG8_SB(0, 1), cB + hstep, voffB); PG8_STAGE(PG8_SA(0, 1), cA + hstep, voffA);
        if (wr == 1) PG8_BAR;
        PG8_WAIT_V(4); PG8_BAR;
        PG8_STAGE(PG8_SB(1, 0), cB + kstep, voffB); PG8_STAGE(PG8_SA(1, 0), cA + kstep, voffA); PG8_STAGE(PG8_SB(1, 1), cB + hstep + kstep, voffB);
        PG8_WAIT_V(6); PG8_BAR;
    }
    for (;;) {
        const bool has_next = S.next(ui + 1, nxt);
        const char* nA = has_next ? (const char*)g.A + (size_t)nxt.pm * tstep : cA; const char* nB = has_next ? (const char*)g.Bt + (size_t)nxt.pn * tstep : cB;
        for (int t = 0; t < nt; t += 2) {
            const bool last = (t == nt - 2);
            const char* a1 = cA + (size_t)(t + 1) * kstep;
            const char* a2 = last ? nA : cA + (size_t)(t + 2) * kstep; const char* b2 = last ? nB : cB + (size_t)(t + 2) * kstep;
            const char* a3 = a2 + kstep; const char* b3 = b2 + kstep;
            if (last && has_next) S.a_ready(nxt);
            if constexpr (SP2) {
            PG8_LDB(B0, 0, 0); PG8_LDB(B1, 0, 1); PG8_SCHED; PG8_LDA(At, 0, 0); PG8_STAGE(PG8_SA(1, 1), a1 + hstep, voffA);
            PG8_WAIT_V(8); PG8_WAIT_L(0); PG8_BAR; PG8_MMA(0, 0, At, B0); PG8_MMA(0, 1, At, B1); PG8_BAR; PG8_SCHED;
            PG8_LDA(At, 0, 1); PG8_STAGE(PG8_SB(0, 0), b2, voffB); PG8_STAGE(PG8_SB(0, 1), b2 + hstep, voffB); PG8_STAGE(PG8_SA(0, 0), a2, voffA);
            PG8_WAIT_V(8); PG8_WAIT_L(0); PG8_BAR; PG8_MMA(1, 0, At, B0); PG8_MMA(1, 1, At, B1); PG8_BAR; PG8_SCHED;
            PG8_LDB(B0, 1, 0); PG8_LDB(B1, 1, 1); PG8_SCHED; PG8_LDA(At, 1, 0); PG8_STAGE(PG8_SA(0, 1), a2 + hstep, voffA);
            PG8_WAIT_V(8); PG8_WAIT_L(0); PG8_BAR; PG8_MMA(0, 0, At, B0); PG8_MMA(0, 1, At, B1); PG8_BAR; PG8_SCHED;
            PG8_LDA(At, 1, 1); PG8_STAGE(PG8_SB(1, 0), b3, voffB); PG8_STAGE(PG8_SB(1, 1), b3 + hstep, voffB); PG8_STAGE(PG8_SA(1, 0), a3, voffA);
            PG8_WAIT_V(8); PG8_WAIT_L(0); PG8_BAR; PG8_MMA(1, 0, At, B0); PG8_MMA(1, 1, At, B1); PG8_BAR; PG8_SCHED;
            } else {
            PG8_LDB(B0, 0, 0); PG8_SCHED; PG8_LDA(At, 0, 0); PG8_STAGE(PG8_SA(1, 1), a1 + hstep, voffA);
            PG8_WAIT_L(8); PG8_BAR; PG8_WAIT_L(0); PG8_MMA(0, 0, At, B0); PG8_BAR; PG8_SCHED;
            PG8_LDB(B1, 0, 1); PG8_STAGE(PG8_SB(0, 0), b2, voffB);
            PG8_BAR; PG8_WAIT_L(0); PG8_MMA(0, 1, At, B1); PG8_BAR;
            PG8_LDA(At, 0, 1); PG8_STAGE(PG8_SA(0, 0), a2, voffA);
            PG8_BAR; PG8_WAIT_L(0); PG8_MMA(1, 0, At, B0); PG8_BAR; PG8_SCHED;
            PG8_STAGE(PG8_SB(0, 1), b2 + hstep, voffB);
            PG8_WAIT_V(6); PG8_BAR; PG8_MMA(1, 1, At, B1); PG8_BAR;
            PG8_LDB(B0, 1, 0); PG8_SCHED; PG8_LDA(At, 1, 0); PG8_STAGE(PG8_SA(0, 1), a2 + hstep, voffA);
            PG8_WAIT_L(8); PG8_BAR; PG8_WAIT_L(0); PG8_MMA(0, 0, At, B0); PG8_BAR; PG8_SCHED;
            PG8_LDB(B1, 1, 1); PG8_STAGE(PG8_SB(1, 0), b3, voffB);
            PG8_BAR; PG8_WAIT_L(0); PG8_MMA(0, 1, At, B1); PG8_BAR;
            PG8_LDA(At, 1, 1); PG8_STAGE(PG8_SA(1, 0), a3, voffA);
            PG8_BAR; PG8_WAIT_L(0); PG8_MMA(1, 0, At, B0); PG8_BAR; PG8_SCHED;
            PG8_STAGE(PG8_SB(1, 1), b3 + hstep, voffB);
            PG8_WAIT_V(6); PG8_BAR; PG8_MMA(1, 1, At, B1); PG8_BAR;
            }
        }
        if constexpr (ALIGN_EPI) { if (wr == 0) PG8_BAR; }
        if constexpr (!Epi::AFTER_DRAIN) { E(acc, cur, wr, wc, fr, fq); S.done(cur); }
        if (!has_next) break;
#pragma unroll
        for (int a = 0; a < 2; ++a)
#pragma unroll
            for (int b = 0; b < 2; ++b)
#pragma unroll
                for (int m = 0; m < 4; ++m)
#pragma unroll
                    for (int n = 0; n < 2; ++n) acc[a][b][m][n] = (f32x4){0.f, 0.f, 0.f, 0.f};
        cur = nxt; cA = nA; cB = nB; ++ui;
        if constexpr (ALIGN_EPI) { if (wr == 1) PG8_BAR; }
    }
    PG8_WAIT_V(0);
    if constexpr (!ALIGN_EPI) { if (wr == 0) PG8_BAR; }
    PG8_BAR;
    if constexpr (Epi::AFTER_DRAIN) { E.fused(acc, cur, wr, wc, fr, fq, lds, wid, lane); S.done(cur); }
#undef PG8_SA
#undef PG8_SB
#undef PG8_STAGE
#undef PG8_LDA
#undef PG8_LDB
#undef PG8_MMA
#undef PG8_WAIT_V
#undef PG8_WAIT_L
#undef PG8_BAR
#undef PG8_SCHED
}
}

constexpr int NWAVES = 8, NTHR = 512;
constexpr int BATCH = 2, SEQ = 4096, T = BATCH * SEQ, D = 2048;
constexpr int NPROJ = 14848;
constexpr int C_QA = 0, C_KA = 2048, C_VA = 2304, C_QR = 2560, C_KR = 4608, C_VR = 6656, C_GR = 8704, C_GA = 10752, C_GT = 12800;
constexpr int NEXP = 64, EDIM = 1024;
constexpr float EPS = 1e-6f;
constexpr float LOG2E = 1.4426950408889634f;
constexpr float QA_SCALE = 0.125f * LOG2E;

constexpr size_t MiB = 1u << 20;
constexpr size_t WS_CTL = 0, CTL_ZERO_BYTES = 1 * MiB;
constexpr size_t WS_MOD = 1 * MiB;
constexpr size_t WS_ROPE = 2 * MiB;
constexpr size_t WS_WIN = 10 * MiB;
constexpr size_t WS_WBA = 68 * MiB, WS_WBR = 76 * MiB, WS_WOUT = 84 * MiB;
constexpr size_t WS_ROUTE = 92 * MiB;
constexpr size_t WS_WRT = 94 * MiB;
constexpr size_t WS_H = 96 * MiB;
constexpr size_t WS_X1 = 128 * MiB;
constexpr size_t WS_P = 192 * MiB;
constexpr size_t WS_VTA = 424 * MiB;
constexpr size_t WS_VTR = 428 * MiB;
constexpr size_t WS_KRT = 460 * MiB;
constexpr size_t WS_SC = 492 * MiB;
constexpr size_t WS_ST = 620 * MiB;
constexpr size_t WS_ATTN = 684 * MiB;
constexpr size_t WS_RET = 716 * MiB;
constexpr size_t WS_M1 = 748 * MiB;
constexpr size_t WS_MERGED = 812 * MiB;
constexpr size_t WS_XG = 192 * MiB;
constexpr size_t WS_HB = 320 * MiB;
constexpr size_t WS_Y = 384 * MiB;
constexpr size_t WS_RTOK = 848 * MiB;
constexpr size_t WS_END = 850 * MiB;

constexpr int CW_TMO = 0, CW_BAR = 4096, CW_CNT = 16384;

constexpr int RING_BYTES = 131072;
constexpr int MISC_OFF = 155648;
constexpr int MISC_BYTES = 8192;
constexpr int LDS_BYTES = MISC_OFF + MISC_BYTES;

#define GAS __attribute__((address_space(1)))
#define LAS __attribute__((address_space(3)))
typedef unsigned short bf16;
typedef unsigned v4u __attribute__((ext_vector_type(4)));
typedef unsigned v2u __attribute__((ext_vector_type(2)));
typedef float f32x4 __attribute__((ext_vector_type(4)));
typedef short bf16x8 __attribute__((ext_vector_type(8)));
typedef GAS unsigned gu32;
#define RLX_AGENT __ATOMIC_RELAXED, __HIP_MEMORY_SCOPE_AGENT
#define LDS_WAIT() asm volatile("s_waitcnt lgkmcnt(0)" ::: "memory")
#define VM_WAIT() asm volatile("s_waitcnt vmcnt(0)" ::: "memory")
__device__ __forceinline__ unsigned f2bf(float f) { unsigned u = __builtin_bit_cast(unsigned, f); return (u + 0x7fffu + ((u >> 16) & 1u)) >> 16; }
__device__ __forceinline__ unsigned pk2(float lo, float hi) { return f2bf(lo) | (f2bf(hi) << 16); }
__device__ __forceinline__ float bf2f(unsigned b) { return __builtin_bit_cast(float, b << 16); }
__device__ __forceinline__ float wave_sum(float v) {
#pragma unroll
    for (int o = 1; o < 64; o <<= 1) v += __shfl_xor(v, o);
    return v;
}
__device__ __forceinline__ float sum16(float v) {
#pragma unroll
    for (int o = 1; o < 16; o <<= 1) v += __shfl_xor(v, o);
    return v;
}
__device__ __forceinline__ float max16(float v) {
#pragma unroll
    for (int o = 1; o < 16; o <<= 1) v = fmaxf(v, __shfl_xor(v, o));
    return v;
}
__device__ __forceinline__ float sigmoidf_(float x) { return 1.0f / (1.0f + __expf(-x)); }
__device__ __forceinline__ float siluf_(float x) { return x / (1.0f + __expf(-x)); }

#define XB_TMO      128
#define XB_XCNT(j)  (256  + 64 * (j))
#define XB_XSUB(j)  (1280 + 64 * (j))
#define XB_XGEN(j)  (2304 + 64 * (j))
#define XB_TOP      3328
#define XB_TOPGEN   3392
#define XCD_BAR_WORDS 3456
#define XB_SPIN_CAP (1u << 18)

__device__ __forceinline__ unsigned xb_ld(unsigned* p)              { return __hip_atomic_load(p, __ATOMIC_RELAXED, __HIP_MEMORY_SCOPE_AGENT); }
__device__ __forceinline__ unsigned xb_add(unsigned* p, unsigned v) { return __hip_atomic_fetch_add(p, v, __ATOMIC_RELAXED, __HIP_MEMORY_SCOPE_AGENT); }
__device__ __forceinline__ unsigned xb_xcc_id() { return (unsigned)__builtin_amdgcn_s_getreg((3 << 11) | 20) & 0xFu; }
#define XB_SPIN(cond, bar) do { unsigned _sp = 0; while (cond) { __builtin_amdgcn_s_sleep(1); \
    if ((++_sp & 255u) == 0u) { if (xb_ld(&(bar)[XB_TMO])) break; if (_sp > XB_SPIN_CAP) { atomicAdd(&(bar)[XB_TMO], 1u); break; } } } } while (0)

struct XcdBarrier {
    unsigned* bar; unsigned x;
    volatile LAS unsigned* st;
};

__device__ __forceinline__ XcdBarrier xcd_barrier_post(unsigned* bar, volatile LAS unsigned* st) {
    XcdBarrier b; b.bar = bar; b.x = xb_xcc_id(); b.st = st;
    if (threadIdx.x == 0) (void)xb_add(&bar[XB_XCNT(b.x)], 1u);
    return b;
}
__device__ __forceinline__ void xcd_barrier_complete(unsigned* bar, unsigned x, unsigned& nloc, unsigned& nx) {
    const unsigned G = gridDim.x * gridDim.y * gridDim.z;
    unsigned sum, cnt, mine, sp = 0u;
    for (;;) {
        sum = 0u; cnt = 0u; mine = 0u;
#pragma unroll
        for (unsigned j = 0; j < 16; ++j) { const unsigned c = xb_ld(&bar[XB_XCNT(j)]); sum += c; cnt += (c > 0u) ? 1u : 0u; mine = (j == x) ? c : mine; }
        if (sum == G) break;
        __builtin_amdgcn_s_sleep(1);
        if ((++sp & 255u) == 0u) { if (xb_ld(&bar[XB_TMO])) break; if (sp > XB_SPIN_CAP) { atomicAdd(&bar[XB_TMO], 1u); break; } }
    }
    nloc = mine > 0u ? mine : 1u; nx = cnt > 0u ? cnt : 1u;
}

__device__ __forceinline__ void xcd_barrier(const XcdBarrier& b) {
    asm volatile("s_waitcnt vmcnt(0)" ::: "memory");
    __syncthreads();
    if (threadIdx.x == 0) {
        unsigned* bar = b.bar;
        __builtin_amdgcn_s_waitcnt(0);
        unsigned nloc = b.st[0], nx = b.st[1];
        if (nloc == 0u) { xcd_barrier_complete(bar, b.x, nloc, nx); b.st[0] = nloc; b.st[1] = nx; }
        const unsigned old = xb_add(&bar[XB_XSUB(b.x)], 1u);
        const unsigned gen = old / nloc;
        if (old + 1u == (gen + 1u) * nloc) {
            __builtin_amdgcn_fence(__ATOMIC_RELEASE, "agent");
            asm volatile("s_waitcnt vmcnt(0)" ::: "memory");
            const unsigned og = xb_add(&bar[XB_TOP], 1u);
            const unsigned tg = og / nx;
            if (og + 1u == (tg + 1u) * nx) xb_add(&bar[XB_TOPGEN], 1u);
            else XB_SPIN(xb_ld(&bar[XB_TOPGEN]) == tg, bar);
            __builtin_amdgcn_fence(__ATOMIC_ACQUIRE, "agent");
            xb_add(&bar[XB_XGEN(b.x)], 1u);
            asm volatile("s_waitcnt vmcnt(0)" ::: "memory");
        } else {
            XB_SPIN(xb_ld(&bar[XB_XGEN(b.x)]) == gen, bar);
            __builtin_amdgcn_fence(__ATOMIC_ACQUIRE, "agent");
            asm volatile("s_waitcnt vmcnt(0)" ::: "memory");
        }
    }
    __syncthreads();
}


struct Args { const void* in[21]; float* out; unsigned char* ws; int ph_lo, ph_hi, bar_region, pad; };

__device__ __forceinline__ f32x4 mma16(bf16x8 a, bf16x8 b, f32x4 c) { return __builtin_amdgcn_mfma_f32_16x16x32_bf16(a, b, c, 0, 0, 0); }
__device__ __forceinline__ bf16x8 ldg8(const bf16* p) { return *(const GAS bf16x8*)p; }

namespace pg8 {
struct EpiProj {
    static constexpr bool PERM = true, AFTER_DRAIN = false;
    bf16* P; bf16* Vta; bf16* Vtr; bf16* Krt; const float* cosT; const float* sinT;
    __device__ __forceinline__ void operator()(const f32x4 (&acc)[2][2][4][2], const Unit& u, int wr, int wc, int fr, int fq) const {
        const int pn = u.pn;
        const int row0 = u.pm * BM + wr * 64 + fr;
        const int cl = wc * 32 + 8 * fq;
        if (pn == 9 || (pn >= 26 && pn < 34)) {
            bf16* base; int chan0, nchan;
            if (pn == 9) { base = Vta; chan0 = 0; nchan = 256; } else { base = Vtr; chan0 = (pn - 26) * 256; nchan = 2048; }
#pragma unroll
            for (int ai = 0; ai < 2; ++ai)
#pragma unroll
                for (int m = 0; m < 4; ++m) {
                    const int row = row0 + ai * HALF + m * 16; const int b = row >> 12, s = row & 4095;
                    bf16* colp = base + ((size_t)(b * nchan + chan0 + cl) * 4096 + s);
#pragma unroll
                    for (int bj = 0; bj < 2; ++bj)
#pragma unroll
                        for (int n = 0; n < 2; ++n)
#pragma unroll
                            for (int i = 0; i < 4; ++i) colp[(size_t)(bj * HALF + 4 * n + i) * 4096] = (bf16)f2bf(acc[ai][bj][m][n][i]);
                }
            return;
        }
        const bool rot = (pn >= 10 && pn < 26);
        const bool isk = (pn >= 18 && pn < 26);
        float lg2 = 0.f;
        if (isk) { const int h = pn - 18; lg2 = log1pf(-exp2f(-5.0f - (float)h)) * LOG2E; }
#pragma unroll
        for (int ai = 0; ai < 2; ++ai)
#pragma unroll
            for (int m = 0; m < 4; ++m) {
                const int row = row0 + ai * HALF + m * 16;
                f32x4 v[2][2];
#pragma unroll
                for (int bj = 0; bj < 2; ++bj)
#pragma unroll
                    for (int n = 0; n < 2; ++n) v[bj][n] = acc[ai][bj][m][n];
                if (rot) {
                    const float* cp = cosT + (size_t)row * 128 + cl; const float* sp = sinT + (size_t)row * 128 + cl;
#pragma unroll
                    for (int n = 0; n < 2; ++n) {
                        const f32x4 c = *(const f32x4*)(cp + 4 * n), s = *(const f32x4*)(sp + 4 * n);
                        const f32x4 t1 = v[0][n], t2 = v[1][n];
                        v[0][n] = t1 * c - t2 * s; v[1][n] = t1 * s + t2 * c;
                    }
                    if (isk) {
#pragma unroll
                        for (int n = 0; n < 2; ++n) { v[0][n] = v[0][n] * 0.0625f; v[1][n] = v[1][n] * 0.0625f; }
                    }
                } else if (pn < 8) {
#pragma unroll
                    for (int bj = 0; bj < 2; ++bj)
#pragma unroll
                        for (int n = 0; n < 2; ++n) v[bj][n] = v[bj][n] * QA_SCALE;
                } else if (pn >= 34 && pn < 42) {
#pragma unroll
                    for (int bj = 0; bj < 2; ++bj)
#pragma unroll
                        for (int n = 0; n < 2; ++n)
#pragma unroll
                            for (int i = 0; i < 4; ++i) v[bj][n][i] = siluf_(v[bj][n][i]);
                } else if (pn >= 42) {
#pragma unroll
                    for (int bj = 0; bj < 2; ++bj)
#pragma unroll
                        for (int n = 0; n < 2; ++n)
#pragma unroll
                            for (int i = 0; i < 4; ++i) v[bj][n][i] = sigmoidf_(v[bj][n][i]);
                }
                bf16* rowp = P + (size_t)row * NPROJ + pn * BM + cl;
#pragma unroll
                for (int bj = 0; bj < 2; ++bj) {
                    u32x4 w; w.x = cvt_pk_bf16(v[bj][0][0], v[bj][0][1]); w.y = cvt_pk_bf16(v[bj][0][2], v[bj][0][3]); w.z = cvt_pk_bf16(v[bj][1][0], v[bj][1][1]); w.w = cvt_pk_bf16(v[bj][1][2], v[bj][1][3]);
                    *(u32x4*)(rowp + bj * HALF) = w;
                }
                if (isk) {
                    const int b = row >> 12, s = row & 4095;
                    const float dk = exp2f((float)(127 - (s & 127)) * lg2);
                    bf16* colp = Krt + ((size_t)(b * 2048 + (pn - 18) * 256 + cl) * 4096 + s);
#pragma unroll
                    for (int bj = 0; bj < 2; ++bj)
#pragma unroll
                        for (int n = 0; n < 2; ++n)
#pragma unroll
                            for (int i = 0; i < 4; ++i) colp[(size_t)(bj * HALF + 4 * n + i) * 4096] = (bf16)f2bf(v[bj][n][i] * dk);
                }
            }
    }
};
struct EpiBranchA {
    static constexpr bool PERM = true, AFTER_DRAIN = false;
    const bf16* P; float* M1;
    __device__ __forceinline__ void operator()(const f32x4 (&acc)[2][2][4][2], const Unit& u, int wr, int wc, int fr, int fq) const {
        const int row0 = u.pm * BM + wr * 64 + fr, col0 = u.pn * BM + wc * 32 + 8 * fq;
#pragma unroll
        for (int ai = 0; ai < 2; ++ai)
#pragma unroll
            for (int m = 0; m < 4; ++m) { const int row = row0 + ai * HALF + m * 16;
#pragma unroll
                for (int bj = 0; bj < 2; ++bj) { const int col = col0 + bj * HALF;
                    const u32x4 g = *(const u32x4*)(P + (size_t)row * NPROJ + C_GA + col);
                    f32x4 o0, o1;
                    o0[0] = bf2f(g.x & 0xffffu) * acc[ai][bj][m][0][0]; o0[1] = bf2f(g.x >> 16) * acc[ai][bj][m][0][1]; o0[2] = bf2f(g.y & 0xffffu) * acc[ai][bj][m][0][2]; o0[3] = bf2f(g.y >> 16) * acc[ai][bj][m][0][3];
                    o1[0] = bf2f(g.z & 0xffffu) * acc[ai][bj][m][1][0]; o1[1] = bf2f(g.z >> 16) * acc[ai][bj][m][1][1]; o1[2] = bf2f(g.w & 0xffffu) * acc[ai][bj][m][1][2]; o1[3] = bf2f(g.w >> 16) * acc[ai][bj][m][1][3];
                    float* op = M1 + (size_t)row * D + col; *(f32x4*)op = o0; *(f32x4*)(op + 4) = o1; } }
    }
};
struct EpiBranchR {
    static constexpr bool PERM = true, AFTER_DRAIN = false;
    const bf16* P; const float* M1; bf16* MG;
    __device__ __forceinline__ void operator()(const f32x4 (&acc)[2][2][4][2], const Unit& u, int wr, int wc, int fr, int fq) const {
        const int row0 = u.pm * BM + wr * 64 + fr, col0 = u.pn * BM + wc * 32 + 8 * fq;
#pragma unroll
        for (int ai = 0; ai < 2; ++ai)
#pragma unroll
            for (int m = 0; m < 4; ++m) { const int row = row0 + ai * HALF + m * 16;
#pragma unroll
                for (int bj = 0; bj < 2; ++bj) { const int col = col0 + bj * HALF;
                    const u32x4 g = *(const u32x4*)(P + (size_t)row * NPROJ + C_GT + col);
                    const float* ip = M1 + (size_t)row * D + col; const f32x4 a0 = *(const f32x4*)ip, a1 = *(const f32x4*)(ip + 4);
                    f32x4 o0, o1;
                    o0[0] = a0[0] + bf2f(g.x & 0xffffu) * acc[ai][bj][m][0][0]; o0[1] = a0[1] + bf2f(g.x >> 16) * acc[ai][bj][m][0][1]; o0[2] = a0[2] + bf2f(g.y & 0xffffu) * acc[ai][bj][m][0][2]; o0[3] = a0[3] + bf2f(g.y >> 16) * acc[ai][bj][m][0][3];
                    o1[0] = a1[0] + bf2f(g.z & 0xffffu) * acc[ai][bj][m][1][0]; o1[1] = a1[1] + bf2f(g.z >> 16) * acc[ai][bj][m][1][1]; o1[2] = a1[2] + bf2f(g.w & 0xffffu) * acc[ai][bj][m][1][2]; o1[3] = a1[3] + bf2f(g.w >> 16) * acc[ai][bj][m][1][3];
                    u32x4 w; w.x = cvt_pk_bf16(o0[0], o0[1]); w.y = cvt_pk_bf16(o0[2], o0[3]); w.z = cvt_pk_bf16(o1[0], o1[1]); w.w = cvt_pk_bf16(o1[2], o1[3]);
                    *(u32x4*)(MG + (size_t)row * D + col) = w; } }
    }
};
struct EpiOut {
    static constexpr bool PERM = false, AFTER_DRAIN = false;
    const float* x; const float* gate1; float* X1;
    __device__ __forceinline__ void operator()(const f32x4 (&acc)[2][2][4][2], const Unit& u, int wr, int wc, int fr, int fq) const {
        const int row0 = u.pm * BM + wr * 64 + fr, col0 = u.pn * BM + wc * 32 + 4 * fq;
        const int b = (u.pm * BM) >> 12;
        f32x4 gv[2][2];
#pragma unroll
        for (int bj = 0; bj < 2; ++bj)
#pragma unroll
            for (int n = 0; n < 2; ++n) gv[bj][n] = *(const f32x4*)(gate1 + (size_t)b * 12288 + col0 + bj * HALF + n * 16);
#pragma unroll
        for (int ai = 0; ai < 2; ++ai)
#pragma unroll
            for (int m = 0; m < 4; ++m) { const size_t off = (size_t)(row0 + ai * HALF + m * 16) * D + col0;
#pragma unroll
                for (int bj = 0; bj < 2; ++bj)
#pragma unroll
                    for (int n = 0; n < 2; ++n) { const f32x4 xv = *(const f32x4*)(x + off + bj * HALF + n * 16);
                        *(f32x4*)(X1 + off + bj * HALF + n * 16) = xv + gv[bj][n] * acc[ai][bj][m][n]; } }
    }
};
struct EpiFfn1 {
    static constexpr bool PERM = true, AFTER_DRAIN = false;
    bf16* HB;
    __device__ __forceinline__ void operator()(const f32x4 (&acc)[2][2][4][2], const Unit& u, int wr, int wc, int fr, int fq) const {
        const int row0 = u.pm * BM + wr * 64 + fr, col0 = (u.pn & 7) * 128 + wc * 32 + 8 * fq;
#pragma unroll
        for (int ai = 0; ai < 2; ++ai)
#pragma unroll
            for (int m = 0; m < 4; ++m) { const int row = row0 + ai * HALF + m * 16;
                float h[8];
#pragma unroll
                for (int n = 0; n < 2; ++n)
#pragma unroll
                    for (int i = 0; i < 4; ++i) h[4 * n + i] = siluf_(acc[ai][0][m][n][i]) * acc[ai][1][m][n][i];
                u32x4 w; w.x = cvt_pk_bf16(h[0], h[1]); w.y = cvt_pk_bf16(h[2], h[3]); w.z = cvt_pk_bf16(h[4], h[5]); w.w = cvt_pk_bf16(h[6], h[7]);
                *(u32x4*)(HB + (size_t)row * EDIM + col0) = w; }
    }
};
struct EpiFfn2 {
    static constexpr bool PERM = true, AFTER_DRAIN = false;
    bf16* Y;
    __device__ __forceinline__ void operator()(const f32x4 (&acc)[2][2][4][2], const Unit& u, int wr, int wc, int fr, int fq) const {
        const int row0 = u.pm * BM + wr * 64 + fr, col0 = (u.pn & 7) * BM + wc * 32 + 8 * fq;
#pragma unroll
        for (int ai = 0; ai < 2; ++ai)
#pragma unroll
            for (int m = 0; m < 4; ++m) { const int row = row0 + ai * HALF + m * 16;
#pragma unroll
                for (int bj = 0; bj < 2; ++bj) {
                    u32x4 w; w.x = cvt_pk_bf16(acc[ai][bj][m][0][0], acc[ai][bj][m][0][1]); w.y = cvt_pk_bf16(acc[ai][bj][m][0][2], acc[ai][bj][m][0][3]);
                    w.z = cvt_pk_bf16(acc[ai][bj][m][1][0], acc[ai][bj][m][1][1]); w.w = cvt_pk_bf16(acc[ai][bj][m][1][2], acc[ai][bj][m][1][3]);
                    *(u32x4*)(Y + (size_t)row * D + col0 + bj * HALF) = w; } }
    }
};
struct MoeOrder {
    const LAS int* blk_e; int nblk, NT, G, c;
    __device__ __forceinline__ bool next(int i, Unit& u) const {
        const int L = i * G + c; if (L >= nblk * NT) return false;
        const int blk = L / NT, j = L - blk * NT; u.pm = blk; u.pn = blk_e[blk] * NT + j; return true;
    }
    __device__ __forceinline__ void a_ready(const Unit&) const {}
    __device__ __forceinline__ void done(const Unit&) const {}
};
}


namespace moe {
constexpr int MT = 320, NIB = MT / 64, BK = 64, A_STAGE = MT * BK * 2, B_STAGE = 128 * BK * 2;
constexpr int LDS_A = 0, LDS_B = 3 * A_STAGE;
typedef float f32x2 __attribute__((ext_vector_type(2)));
template <int KIND>
__device__ __forceinline__ void tile(LAS unsigned char* lds, const unsigned char* Abase, const unsigned (&arow)[5], const float* W0, const float* W1, int ldw,
                                     int nblk16, int mrows, bf16* Out, int ldo, int tid) {
    constexpr int NK = (KIND == 1) ? 32 : 16;
    const int lane = tid & 63, wave = __builtin_amdgcn_readfirstlane(tid >> 6), wm = wave & 3, wn = wave >> 2, fr = lane & 15, fq = lane >> 4;
    const int fo = pg8::lds_byte(fr, fq * 8);
    const float* bbase; unsigned bvoff; int n0, kc;
    if (KIND == 1) { const int mat = wave & 1, kq = wave >> 1, kg = lane >> 4, cq = lane & 15;
        bbase = (mat ? W1 : W0) + (size_t)(16 * kq) * ldw; bvoff = (unsigned)((4 * kg * ldw + 4 * cq) * 4);
        n0 = 64 * ((4 * cq) >> 5) + 32 * mat + ((4 * cq) & 31); kc = 16 * kq + 4 * kg; }
    else { const int kg = lane >> 5, cq = lane & 31;
        bbase = W0 + (size_t)(8 * wave) * ldw; bvoff = (unsigned)((4 * kg * ldw + 4 * cq) * 4); n0 = 4 * cq; kc = 8 * wave + 4 * kg; }
    int bw[4];
#pragma unroll
    for (int c = 0; c < 4; ++c) bw[c] = pg8::lds_byte(n0 + c, kc);
    const unsigned ldsw = (unsigned)wave * 1024u;
    f32x4 acc[NIB][4];
#pragma unroll
    for (int a = 0; a < NIB; ++a)
#pragma unroll
        for (int b = 0; b < 4; ++b) acc[a][b] = (f32x4){0.f, 0.f, 0.f, 0.f};
    f32x4 breg[4][4];
#define MOE_DMA1(kt, st, p) __builtin_amdgcn_global_load_lds((const unsigned*)(Abase + (size_t)(arow[p] + (unsigned)(kt) * (unsigned)(BK * 2))), (LAS unsigned*)(lds + LDS_A + (st) * A_STAGE + ((p) >> 1) * 16384 + ((p) & 1) * 8192 + ldsw), 16, 0, 0)
#define MOE_DMA_A(kt, st) do { MOE_DMA1(kt, st, 0); MOE_DMA1(kt, st, 1); MOE_DMA1(kt, st, 2); MOE_DMA1(kt, st, 3); MOE_DMA1(kt, st, 4); } while (0)
#define MOE_LD1(kt, set, j) breg[set][j] = __builtin_nontemporal_load((const GAS f32x4*)((const char*)(bbase + (size_t)((kt) * BK + (j)) * ldw) + bvoff))
#define MOE_LD_B(kt, set) do { MOE_LD1(kt, set, 0); MOE_LD1(kt, set, 1); MOE_LD1(kt, set, 2); MOE_LD1(kt, set, 3); } while (0)
#define MOE_CVT_B(set, st) do { _Pragma("unroll") for (int _c = 0; _c < 4; ++_c) { v2u _o; _o.x = pg8::cvt_pk_bf16(breg[set][0][_c], breg[set][1][_c]); _o.y = pg8::cvt_pk_bf16(breg[set][2][_c], breg[set][3][_c]); \
        *(LAS v2u*)(lds + LDS_B + (st) * B_STAGE + bw[_c]) = _o; } } while (0)
#define MOE_BLK(st, sa, ks, ib) do { if (wm + 4 * (ib) < nblk16) { const bf16x8 _a = *(const LAS bf16x8*)(lds + LDS_A + (sa) * A_STAGE + (wm + 4 * (ib)) * 2048 + (ks) * 1024 + fo); \
        _Pragma("unroll") for (int _nb = 0; _nb < 4; ++_nb) acc[ib][_nb] = __builtin_amdgcn_mfma_f32_16x16x32_bf16(bfr[_nb], _a, acc[ib][_nb], 0, 0, 0); } } while (0)
#define MOE_BFR(st, ks) do { _Pragma("unroll") for (int _nb = 0; _nb < 4; ++_nb) bfr[_nb] = *(const LAS bf16x8*)(lds + LDS_B + (st) * B_STAGE + (4 * wn + _nb) * 2048 + (ks) * 1024 + fo); } while (0)
#define MOE_STEP(kt, u, DO_LD, DO_DMA, DO_NEXT, WAITIMM) do { bf16x8 bfr[4]; \
        if (DO_NEXT) MOE_CVT_B(((u) + 1) & 3, ((u) + 1) & 1); \
        MOE_BFR((u) & 1, 0); \
        MOE_BLK((u) & 1, sa0, 0, 0); if (DO_DMA) MOE_DMA1((kt) + 2, sa2, 0); \
        MOE_BLK((u) & 1, sa0, 0, 1); if (DO_DMA) MOE_DMA1((kt) + 2, sa2, 1); \
        MOE_BLK((u) & 1, sa0, 0, 2); if (DO_DMA) MOE_DMA1((kt) + 2, sa2, 2); \
        MOE_BLK((u) & 1, sa0, 0, 3); if (DO_DMA) MOE_DMA1((kt) + 2, sa2, 3); \
        MOE_BLK((u) & 1, sa0, 0, 4); if (DO_DMA) MOE_DMA1((kt) + 2, sa2, 4); \
        MOE_BFR((u) & 1, 1); \
        MOE_BLK((u) & 1, sa0, 1, 0); if (DO_LD) MOE_LD1((kt) + 4, (u), 0); \
        MOE_BLK((u) & 1, sa0, 1, 1); if (DO_LD) MOE_LD1((kt) + 4, (u), 1); \
        MOE_BLK((u) & 1, sa0, 1, 2); if (DO_LD) MOE_LD1((kt) + 4, (u), 2); \
        MOE_BLK((u) & 1, sa0, 1, 3); if (DO_LD) MOE_LD1((kt) + 4, (u), 3); \
        MOE_BLK((u) & 1, sa0, 1, 4); \
        __builtin_amdgcn_s_waitcnt(WAITIMM); \
        asm volatile("" ::: "memory"); __builtin_amdgcn_s_barrier(); asm volatile("" ::: "memory"); \
        { const int _t = sa0; sa0 = sa1; sa1 = sa2; sa2 = _t; } } while (0)
    int sa0 = 0, sa1 = 1, sa2 = 2;
    MOE_DMA_A(0, 0); MOE_DMA_A(1, 1); MOE_LD_B(0, 0); MOE_LD_B(1, 1); MOE_LD_B(2, 2); MOE_LD_B(3, 3);
    __builtin_amdgcn_s_waitcnt(0x0F74);
    MOE_CVT_B(0, 0);
    __builtin_amdgcn_s_waitcnt(0x0074);
    asm volatile("" ::: "memory"); __builtin_amdgcn_s_barrier(); asm volatile("" ::: "memory");
#pragma unroll 1
    for (int kt = 0; kt < NK - 4; kt += 4) { MOE_STEP(kt, 0, true, true, true, 0x007D); MOE_STEP(kt + 1, 1, true, true, true, 0x007D); MOE_STEP(kt + 2, 2, true, true, true, 0x007D); MOE_STEP(kt + 3, 3, true, true, true, 0x007D); }
    MOE_STEP(NK - 4, 0, false, true, true, 0x0079);
    MOE_STEP(NK - 3, 1, false, true, true, 0x0075);
    MOE_STEP(NK - 2, 2, false, false, true, 0x0070);
    MOE_STEP(NK - 1, 3, false, false, false, 0x0070);
#undef MOE_DMA1
#undef MOE_DMA_A
#undef MOE_LD1
#undef MOE_LD_B
#undef MOE_CVT_B
#undef MOE_BLK
#undef MOE_BFR
#undef MOE_STEP
#pragma unroll
    for (int ib = 0; ib < NIB; ++ib) {
        const int row = 16 * (wm + 4 * ib) + fr;
        if (row < mrows) {
            bf16* op = Out + (size_t)row * ldo;
            if (KIND == 1) {
#pragma unroll
                for (int nb = 0; nb < 2; ++nb) { float h[4];
#pragma unroll
                    for (int i = 0; i < 4; ++i) h[i] = siluf_(acc[ib][nb][i]) * acc[ib][nb + 2][i];
                    v2u w; w.x = pg8::cvt_pk_bf16(h[0], h[1]); w.y = pg8::cvt_pk_bf16(h[2], h[3]);
                    *(GAS v2u*)(op + 32 * wn + 16 * nb + 4 * fq) = w; }
            } else {
#pragma unroll
                for (int nb = 0; nb < 4; ++nb) { v2u w; w.x = pg8::cvt_pk_bf16(acc[ib][nb][0], acc[ib][nb][1]); w.y = pg8::cvt_pk_bf16(acc[ib][nb][2], acc[ib][nb][3]);
                    *(GAS v2u*)(op + 64 * wn + 16 * nb + 4 * fq) = w; }
            }
        }
    }
}
}

__device__ __forceinline__ void transpose_item(const float* W, int K, int N, int k0, int n0, bf16* dst  , LAS float* scr, int lane) {
#pragma unroll 8
    for (int i = 0; i < 32; ++i) { const int kk = 2 * i + (lane >> 5); scr[kk * 33 + (lane & 31)] = W[(size_t)(k0 + kk) * N + n0 + (lane & 31)]; }
    LDS_WAIT();
    const int c = lane & 7;
#pragma unroll
    for (int j = 0; j < 4; ++j) { const int n = (lane >> 3) + 8 * j; const LAS float* s = scr + (8 * c) * 33 + n;
        v4u o; o.x = pk2(s[0 * 33], s[1 * 33]); o.y = pk2(s[2 * 33], s[3 * 33]); o.z = pk2(s[4 * 33], s[5 * 33]); o.w = pk2(s[6 * 33], s[7 * 33]);
        *(GAS v4u*)(dst + (size_t)n * K + k0 + 8 * c) = o; }
    LDS_WAIT();
}

__global__ void __launch_bounds__(NTHR, 2) fwd_kernel(Args args) {
    extern __shared__ __attribute__((aligned(16))) unsigned char lds_raw[];
    LAS unsigned char* lds = (LAS unsigned char*)lds_raw;
    volatile LAS unsigned* MISC = (volatile LAS unsigned*)(lds + MISC_OFF);
    const int tid = threadIdx.x, lane = tid & 63, wave = __builtin_amdgcn_readfirstlane(tid >> 6);
    const int G = gridDim.x, bid = blockIdx.x;
    unsigned char* ws = args.ws;
    gu32* ctl = (gu32*)(ws + WS_CTL);
    const int lo = args.ph_lo, hi = args.ph_hi;

    const float* x = (const float*)args.in[0];
    const float* cvec = (const float*)args.in[1];
    const int* positions = (const int*)args.in[2];
    const float* norm1_gain = (const float*)args.in[3];
    const float* norm2_gain = (const float*)args.in[4];
    const float* final_gain = (const float*)args.in[5];
    const float* w_ada = (const float*)args.in[6];
    const float* b_ada = (const float*)args.in[7];
    const float* w_in = (const float*)args.in[8];
    const float* attn_sinks = (const float*)args.in[9];
    const float* ret_gain = (const float*)args.in[10];
    const float* w_ba = (const float*)args.in[11];
    const float* w_br = (const float*)args.in[12];
    const float* w_out = (const float*)args.in[13];
    const float* w_rg = (const float*)args.in[14];
    const float* b_rg = (const float*)args.in[15];
    const float* w_re = (const float*)args.in[16];
    const float* b_re = (const float*)args.in[17];
    const float* w_eg = (const float*)args.in[18];
    const float* w_eu = (const float*)args.in[19];
    const float* w_ed = (const float*)args.in[20];

    float* mod = (float*)(ws + WS_MOD);
    float* cosT = (float*)(ws + WS_ROPE); float* sinT = cosT + (size_t)T * 128;
    bf16* Win_t = (bf16*)(ws + WS_WIN); bf16* Wba_t = (bf16*)(ws + WS_WBA); bf16* Wbr_t = (bf16*)(ws + WS_WBR); bf16* Wout_t = (bf16*)(ws + WS_WOUT);
    bf16* Wrt = (bf16*)(ws + WS_WRT);
    bf16* Hb = (bf16*)(ws + WS_H);
    float* X1 = (float*)(ws + WS_X1);
    bf16* P = (bf16*)(ws + WS_P);
    bf16* Vta = (bf16*)(ws + WS_VTA); bf16* Vtr = (bf16*)(ws + WS_VTR); bf16* Krt = (bf16*)(ws + WS_KRT);
    float* SC = (float*)(ws + WS_SC); bf16* ST = (bf16*)(ws + WS_ST);
    bf16* ATT = (bf16*)(ws + WS_ATTN); bf16* RET = (bf16*)(ws + WS_RET);
    float* M1 = (float*)(ws + WS_M1); bf16* MG = (bf16*)(ws + WS_MERGED);
    bf16* HB = (bf16*)(ws + WS_HB); bf16* YB = (bf16*)(ws + WS_Y);
    int* rowtok = (int*)(ws + WS_RTOK);
    int* route = (int*)(ws + WS_ROUTE);
    gu32* ecnt = ctl + CW_CNT;

    for (int u = tid; u < MISC_BYTES / 4; u += NTHR) ((LAS unsigned*)(lds + MISC_OFF))[u] = 0u;
    __syncthreads();
    XcdBarrier bar = xcd_barrier_post((unsigned*)(ctl + CW_BAR) + args.bar_region * XCD_BAR_WORDS, MISC + 8);

#define IN(k) (lo <= (k) && (k) < hi)
#define SEAM(k) do { if (IN(k) && IN((k) + 1)) xcd_barrier(bar); } while (0)

    if (IN(0)) {
        {
            LAS float* sc = (LAS float*)lds;
            LAS float* red = (LAS float*)(lds + 16384);
            bool have = false;
            for (int it = bid; it < 192; it += G) {
                if (!have) { for (int i = tid; i < 2 * D; i += NTHR) sc[i] = siluf_(cvec[i]); have = true; __syncthreads(); }
                const int n0 = it * 64, cg = tid & 15, rg = tid >> 4;
                f32x4 a0 = {0.f, 0.f, 0.f, 0.f}, a1 = {0.f, 0.f, 0.f, 0.f};
                for (int k = rg; k < D; k += 32) { const f32x4 w = *(const GAS f32x4*)(w_ada + (size_t)k * 12288 + n0 + 4 * cg); a0 += w * sc[k]; a1 += w * sc[D + k]; }
#pragma unroll
                for (int i = 0; i < 4; ++i) { red[tid * 8 + i] = a0[i]; red[tid * 8 + 4 + i] = a1[i]; }
                __syncthreads();
                if (tid < 128) { const int b = tid >> 6, col = tid & 63, cgi = col >> 2, ci = col & 3; float s = 0.f;
                    for (int r = 0; r < 32; ++r) s += red[(r * 16 + cgi) * 8 + b * 4 + ci];
                    mod[b * 12288 + n0 + col] = s + b_ada[n0 + col]; }
                __syncthreads();
            }
            __syncthreads();
        }
        for (int i = bid * NTHR + tid; i < T * 128; i += G * NTHR) {
            const int tok = i >> 7, f = i & 127;
            const double inv = exp2(-(double)f * (13.287712379549449 / 128.0));
            double rv = (double)positions[tok] * inv * 0.15915494309189535;
            rv -= floor(rv);
            const float rf = (float)rv;
            cosT[i] = __builtin_amdgcn_cosf(rf); sinT[i] = __builtin_amdgcn_sinf(rf);
        }
        for (int i = bid * NTHR + tid; i < 80 * D; i += G * NTHR) {
            const int n = i >> 11, k = i & 2047; float v = 0.f;
            if (n < 64) v = w_re[(size_t)k * 64 + n]; else if (n < 68) v = w_rg[(size_t)k * 4 + (n - 64)];
            Wrt[i] = (bf16)f2bf(v);
        }
        {
            LAS float* scr = (LAS float*)(lds + 32768 + wave * 8704);
            const int gw = bid * NWAVES + wave, NGW = G * NWAVES;
            constexpr int I_IN = 32 * (NPROJ / 32), I_SQ = 32 * 64;
            constexpr int NIT = I_IN + 3 * I_SQ;
            for (int it = gw; it < NIT; it += NGW) {
                int r = it;
                if (r < I_IN) { const int nb = NPROJ / 32, kb = r / nb, n0 = (r % nb) * 32; transpose_item(w_in, D, NPROJ, kb * 64, n0, Win_t + (size_t)n0 * D, scr, lane); continue; } r -= I_IN;
                { const int w = r / I_SQ; r -= w * I_SQ; const int kb = r / 64, n0 = (r % 64) * 32;
                    const float* src = w == 0 ? w_ba : (w == 1 ? w_br : w_out); bf16* dst = w == 0 ? Wba_t : (w == 1 ? Wbr_t : Wout_t);
                    transpose_item(src, D, D, kb * 64, n0, dst + (size_t)n0 * D, scr, lane); }
            }
        }
    }
    SEAM(0);

    if (IN(1)) {
        const int gw = bid * NWAVES + wave, NGW = G * NWAVES;
        for (int row = gw; row < T; row += NGW) {
            const int b = row >> 12;
            const GAS f32x4* xr = (const GAS f32x4*)(x + (size_t)row * D) + lane;
            f32x4 v[8]; float ss = 0.f;
#pragma unroll
            for (int j = 0; j < 8; ++j) { v[j] = xr[64 * j]; ss += (v[j].x * v[j].x + v[j].y * v[j].y) + (v[j].z * v[j].z + v[j].w * v[j].w); }
            const float r = 1.0f / sqrtf(wave_sum(ss) * (1.0f / D) + EPS);
            GAS v2u* o8 = (GAS v2u*)(Hb + (size_t)row * D) + lane;
#pragma unroll
            for (int j = 0; j < 8; ++j) { const int k = 4 * lane + 256 * j;
                const f32x4 g = *(const GAS f32x4*)(norm1_gain + k), sh = *(const GAS f32x4*)(mod + b * 12288 + k), scl = *(const GAS f32x4*)(mod + b * 12288 + 2048 + k);
                const f32x4 hv = v[j] * r * g * (scl + 1.0f) + sh;
                v2u o; o.x = pk2(hv.x, hv.y); o.y = pk2(hv.z, hv.w); o8[64 * j] = o; }
        }
    }
    SEAM(1);

    if (IN(2)) {
        pg8::Gemm g{Hb, Win_t, T, NPROJ, D}; pg8::StaticOrder S; S.init(T, NPROJ, G, bid);
        pg8::EpiProj E{P, Vta, Vtr, Krt, cosT, sinT};
        pg8::gemm_phase<pg8::EpiProj, pg8::StaticOrder, true, true>(lds, g, S, E);
    }
    SEAM(2);

    if (IN(3)) {
        const int r16 = lane & 15, q4 = lane >> 4;
        for (int unit = bid; unit < 256 + 512; unit += G) {
            if (unit < 256) {
                const int b = unit >> 7, kvh = (unit >> 5) & 3, nb = unit & 31, head = kvh * 8 + wave;
                const float sink2 = attn_sinks[head] * LOG2E;
                const int tq0 = nb * 128, ks = (nb - 1) * 128;
                const bf16* Qb = P + (size_t)(b * SEQ + tq0) * NPROJ + C_QA + head * 64;
                const bf16* Kb = P + (size_t)(b * SEQ) * NPROJ + C_KA + kvh * 64;
                const bf16* Vb = Vta + (size_t)(b * 256 + kvh * 64) * 4096;
                LAS bf16* Kl = (LAS bf16*)lds;
                LAS bf16* Vl = (LAS bf16*)(lds + 36864);
                LAS bf16* Pl = (LAS bf16*)(lds + 70656 + wave * 5376);
#pragma unroll
                for (int j = 0; j < 4; ++j) { const int p = tid + 512 * j, row = p >> 3, ch = p & 7; int tk = ks + row; tk = tk < 0 ? 0 : tk;
                    *(LAS v4u*)(Kl + row * 72 + ch * 8) = *(const GAS v4u*)(Kb + (size_t)tk * NPROJ + ch * 8); }
#pragma unroll
                for (int j = 0; j < 4; ++j) { const int p = tid + 512 * j, row = p >> 5, ch = p & 31; int tk0 = ks + 8 * ch; tk0 = tk0 < 0 ? 8 * ch : tk0;
                    *(LAS v4u*)(Vl + row * 264 + ch * 8) = *(const GAS v4u*)(Vb + (size_t)row * 4096 + tk0); }
                __syncthreads();
                for (int t = 0; t < 8; ++t) {
                    bf16x8 qa[2];
#pragma unroll
                    for (int s = 0; s < 2; ++s) qa[s] = ldg8(Qb + (size_t)(16 * t + r16) * NPROJ + 32 * s + 8 * q4);
                    f32x4 sc[10];
#pragma unroll
                    for (int n = 0; n < 10; ++n) {
                        const int kb = (t + n) < 16 ? (t + n) : 15;
                        f32x4 a = {0.f, 0.f, 0.f, 0.f};
#pragma unroll
                        for (int s = 0; s < 2; ++s) a = mma16(qa[s], *(const LAS bf16x8*)(Kl + (16 * kb + r16) * 72 + 32 * s + 8 * q4), a);
                        sc[n] = a;
                    }
                    float sm[4];
#pragma unroll
                    for (int reg = 0; reg < 4; ++reg) {
                        const int tq = tq0 + 16 * t + 4 * q4 + reg; float m = -INFINITY;
#pragma unroll
                        for (int n = 0; n < 10; ++n) { const int tk = ks + 16 * (t + n) + r16; const bool ok = (t + n < 16) && (tk >= 0) && (tk <= tq) && (tk + 128 > tq);
                            sc[n][reg] = ok ? sc[n][reg] : -INFINITY; m = fmaxf(m, sc[n][reg]); }
                        m = fmaxf(max16(m), sink2); float s = 0.f;
#pragma unroll
                        for (int n = 0; n < 10; ++n) { const float p = exp2f(sc[n][reg] - m); sc[n][reg] = p; s += p; }
                        sm[reg] = 1.0f / (sum16(s) + exp2f(sink2 - m));
                    }
#pragma unroll
                    for (int n = 0; n < 10; ++n)
#pragma unroll
                        for (int reg = 0; reg < 4; ++reg) Pl[(4 * q4 + reg) * 168 + 16 * n + r16] = (bf16)f2bf(sc[n][reg] * sm[reg]);
                    LDS_WAIT();
                    f32x4 o[4];
#pragma unroll
                    for (int nd = 0; nd < 4; ++nd) o[nd] = (f32x4){0.f, 0.f, 0.f, 0.f};
#pragma unroll
                    for (int s = 0; s < 5; ++s) {
                        const bf16x8 pa = *(const LAS bf16x8*)(Pl + r16 * 168 + 32 * s + 8 * q4);
                        const int n = 2 * s + (q4 >> 1); const int kb = (t + n) < 16 ? (t + n) : 15;
#pragma unroll
                        for (int nd = 0; nd < 4; ++nd) o[nd] = mma16(*(const LAS bf16x8*)(Vl + (16 * nd + r16) * 264 + 16 * kb + 8 * (q4 & 1)), pa, o[nd]);
                    }
#pragma unroll
                    for (int nd = 0; nd < 4; ++nd) { v2u w; w.x = pk2(o[nd][0], o[nd][1]); w.y = pk2(o[nd][2], o[nd][3]);
                        *(GAS v2u*)(ATT + (size_t)(b * SEQ + tq0 + 16 * t + r16) * D + head * 64 + 16 * nd + 4 * q4) = w; }
                    LDS_WAIT();
                }
                __syncthreads();
            } else {
                const int u = unit - 256, bh = u >> 5, c = u & 31, b = bh >> 3, h = bh & 7;
                const bf16* Ag = Vtr + (size_t)(b * 2048 + h * 256) * 4096 + c * 128;
                const bf16* Bg = Krt + (size_t)(b * 2048 + h * 256) * 4096 + c * 128;
                LAS bf16* Al = (LAS bf16*)lds;
                LAS bf16* Bl = (LAS bf16*)(lds + 69632);
#pragma unroll
                for (int j = 0; j < 8; ++j) { const int p = tid + 512 * j, row = p >> 4, ch = p & 15;
                    *(LAS v4u*)(Al + row * 136 + ch * 8) = *(const GAS v4u*)(Ag + (size_t)row * 4096 + ch * 8);
                    *(LAS v4u*)(Bl + row * 136 + ch * 8) = *(const GAS v4u*)(Bg + (size_t)row * 4096 + ch * 8); }
                __syncthreads();
#pragma unroll 1
                for (int nh = 0; nh < 2; ++nh) {
                    f32x4 acc[2][8];
#pragma unroll
                    for (int m = 0; m < 2; ++m)
#pragma unroll
                        for (int n = 0; n < 8; ++n) acc[m][n] = (f32x4){0.f, 0.f, 0.f, 0.f};
#pragma unroll
                    for (int s = 0; s < 4; ++s) {
                        bf16x8 a[2];
#pragma unroll
                        for (int m = 0; m < 2; ++m) a[m] = *(const LAS bf16x8*)(Al + (32 * wave + 16 * m + r16) * 136 + 32 * s + 8 * q4);
#pragma unroll
                        for (int n = 0; n < 8; ++n) { const bf16x8 bb = *(const LAS bf16x8*)(Bl + (128 * nh + 16 * n + r16) * 136 + 32 * s + 8 * q4);
                            acc[0][n] = mma16(bb, a[0], acc[0][n]); acc[1][n] = mma16(bb, a[1], acc[1][n]); }
                    }
                    float* out = SC + (size_t)u * 65536;
#pragma unroll
                    for (int m = 0; m < 2; ++m)
#pragma unroll
                        for (int n = 0; n < 8; ++n) *(GAS f32x4*)(out + (size_t)(32 * wave + 16 * m + r16) * 256 + 128 * nh + 16 * n + 4 * q4) = acc[m][n];
                }
                __syncthreads();
            }
        }
    }
    SEAM(3);

    if (IN(4)) {
        for (int i = bid * NTHR + tid; i < 16 * 16384; i += G * NTHR) {
            const int bh = i >> 14, e4 = i & 16383, h = bh & 7;
            const float dc = expf(128.0f * log1pf(-exp2f(-5.0f - (float)h)));
            f32x4 st = {0.f, 0.f, 0.f, 0.f};
            for (int c = 0; c < 32; ++c) {
                const size_t off = (size_t)(bh * 32 + c) * 65536 + 4 * e4;
                v2u o; o.x = pk2(st.x, st.y); o.y = pk2(st.z, st.w); *(GAS v2u*)(ST + off) = o;
                const f32x4 s = *(const GAS f32x4*)(SC + off);
                st = st * dc + s;
            }
        }
    }
    SEAM(4);

    if (IN(5)) {
        const int r16 = lane & 15, q4 = lane >> 4;
        for (int u = bid; u < 512; u += G) {
            const int bh = u >> 5, c = u & 31, b = bh >> 3, h = bh & 7;
            const float lg2 = log1pf(-exp2f(-5.0f - (float)h)) * LOG2E;
            const int tok0 = b * SEQ + c * 128;
            const bf16* Qg = P + (size_t)tok0 * NPROJ + C_QR + h * 256;
            const bf16* Kg = P + (size_t)tok0 * NPROJ + C_KR + h * 256;
            const bf16* Vg = Vtr + (size_t)(b * 2048 + h * 256 + 32 * wave) * 4096 + c * 128;
            const bf16* Sg = ST + (size_t)u * 65536 + (size_t)(32 * wave) * 256;
            LAS bf16* Kl = (LAS bf16*)lds;
            LAS bf16* Il = (LAS bf16*)lds;
            LAS bf16* Ql = (LAS bf16*)(lds + 67584);
            LAS float* red = (LAS float*)(lds + 135168);
#pragma unroll
            for (int j = 0; j < 8; ++j) { const int p = tid + 512 * j, row = p >> 5, ch = p & 31;
                *(LAS v4u*)(Kl + row * 264 + ch * 8) = *(const GAS v4u*)(Kg + (size_t)row * NPROJ + ch * 8);
                *(LAS v4u*)(Ql + row * 264 + ch * 8) = *(const GAS v4u*)(Qg + (size_t)row * NPROJ + ch * 8); }
            __syncthreads();
            f32x4 sc[8];
            {
                bf16x8 qa[8];
#pragma unroll
                for (int s = 0; s < 8; ++s) qa[s] = *(const LAS bf16x8*)(Ql + (16 * wave + r16) * 264 + 32 * s + 8 * q4);
#pragma unroll
                for (int n = 0; n < 8; ++n) {
                    f32x4 a = {0.f, 0.f, 0.f, 0.f};
                    if (n <= wave) {
#pragma unroll
                        for (int s = 0; s < 8; ++s) a = mma16(qa[s], *(const LAS bf16x8*)(Kl + (16 * n + r16) * 264 + 32 * s + 8 * q4), a);
                    }
#pragma unroll
                    for (int reg = 0; reg < 4; ++reg) { const int df = (16 * wave + 4 * q4 + reg) - (16 * n + r16); a[reg] = df >= 0 ? a[reg] * exp2f((float)df * lg2) : 0.f; }
                    sc[n] = a;
                }
            }
            __syncthreads();
#pragma unroll
            for (int n = 0; n < 8; ++n)
#pragma unroll
                for (int reg = 0; reg < 4; ++reg) Il[(16 * wave + 4 * q4 + reg) * 136 + 16 * n + r16] = (bf16)f2bf(sc[n][reg]);
            __syncthreads();
            f32x4 O1[8][2];
#pragma unroll
            for (int qb = 0; qb < 8; ++qb)
#pragma unroll
                for (int n2 = 0; n2 < 2; ++n2) O1[qb][n2] = (f32x4){0.f, 0.f, 0.f, 0.f};
#pragma unroll
            for (int s = 0; s < 8; ++s) {
                bf16x8 sf[2];
#pragma unroll
                for (int n2 = 0; n2 < 2; ++n2) sf[n2] = ldg8(Sg + (size_t)(16 * n2 + r16) * 256 + 32 * s + 8 * q4);
#pragma unroll
                for (int qb = 0; qb < 8; ++qb) { const bf16x8 qf = *(const LAS bf16x8*)(Ql + (16 * qb + r16) * 264 + 32 * s + 8 * q4);
                    O1[qb][0] = mma16(sf[0], qf, O1[qb][0]); O1[qb][1] = mma16(sf[1], qf, O1[qb][1]); }
            }
#pragma unroll
            for (int qb = 0; qb < 8; ++qb) { const float dq = exp2f((float)(16 * qb + r16 + 1) * lg2);
#pragma unroll
                for (int n2 = 0; n2 < 2; ++n2) O1[qb][n2] = O1[qb][n2] * dq; }
#pragma unroll
            for (int s = 0; s < 4; ++s) {
                bf16x8 vf[2];
#pragma unroll
                for (int n2 = 0; n2 < 2; ++n2) vf[n2] = ldg8(Vg + (size_t)(16 * n2 + r16) * 4096 + 32 * s + 8 * q4);
#pragma unroll
                for (int qb = 0; qb < 8; ++qb) if (2 * s <= qb) { const bf16x8 pf = *(const LAS bf16x8*)(Il + (16 * qb + r16) * 136 + 32 * s + 8 * q4);
                    O1[qb][0] = mma16(vf[0], pf, O1[qb][0]); O1[qb][1] = mma16(vf[1], pf, O1[qb][1]); }
            }
#pragma unroll
            for (int qb = 0; qb < 8; ++qb) { float ss = 0.f;
#pragma unroll
                for (int n2 = 0; n2 < 2; ++n2)
#pragma unroll
                    for (int reg = 0; reg < 4; ++reg) { const float v = O1[qb][n2][reg]; ss += v * v; }
                ss += __shfl_xor(ss, 16); ss += __shfl_xor(ss, 32);
                if (q4 == 0) red[(16 * qb + r16) * 8 + wave] = ss; }
            __syncthreads();
#pragma unroll
            for (int qb = 0; qb < 8; ++qb) { const int q = 16 * qb + r16; float tot = 0.f;
#pragma unroll
                for (int w2 = 0; w2 < 8; ++w2) tot += red[q * 8 + w2];
                const float rs = 1.0f / sqrtf(tot * (1.0f / 256.0f) + EPS);
                const size_t tok = (size_t)(tok0 + q);
#pragma unroll
                for (int n2 = 0; n2 < 2; ++n2) { const int ch = h * 256 + 32 * wave + 16 * n2 + 4 * q4;
                    const f32x4 gn = *(const GAS f32x4*)(ret_gain + ch); const v2u sg = *(const GAS v2u*)(P + tok * NPROJ + C_GR + ch);
                    const float o0 = O1[qb][n2][0] * rs * gn[0] * bf2f(sg.x & 0xffffu), o1 = O1[qb][n2][1] * rs * gn[1] * bf2f(sg.x >> 16);
                    const float o2 = O1[qb][n2][2] * rs * gn[2] * bf2f(sg.y & 0xffffu), o3 = O1[qb][n2][3] * rs * gn[3] * bf2f(sg.y >> 16);
                    v2u w; w.x = pk2(o0, o1); w.y = pk2(o2, o3); *(GAS v2u*)(RET + tok * D + ch) = w; } }
            __syncthreads();
        }
    }
    SEAM(5);

    if (IN(6)) {
        { pg8::Gemm g{ATT, Wba_t, T, D, D}; pg8::StaticOrder S; S.init(T, D, G, bid); pg8::EpiBranchA E{P, M1};
          pg8::gemm_phase<pg8::EpiBranchA, pg8::StaticOrder, true, true>(lds, g, S, E); }
        VM_WAIT(); __syncthreads();
        { pg8::Gemm g{RET, Wbr_t, T, D, D}; pg8::StaticOrder S; S.init(T, D, G, bid); pg8::EpiBranchR E{P, M1, MG};
          pg8::gemm_phase<pg8::EpiBranchR, pg8::StaticOrder, true, true>(lds, g, S, E); }
    }
    SEAM(6);

    if (IN(7)) {
        pg8::Gemm g{MG, Wout_t, T, D, D}; pg8::StaticOrder S; S.init(T, D, G, bid); pg8::EpiOut E{x, mod + 2 * 2048, X1};
        pg8::gemm_phase<pg8::EpiOut, pg8::StaticOrder, true, true>(lds, g, S, E);
    }
    SEAM(7);

    if (IN(8)) {
        const int r16 = lane & 15, q4 = lane >> 4;
        LAS bf16* Al = (LAS bf16*)lds;
        LAS float* Lg = (LAS float*)(lds + RING_BYTES);
        for (int t0 = bid * 32; t0 < T; t0 += G * 32) {
            for (int rr = 0; rr < 4; ++rr) {
                const int lrow = 4 * wave + rr, row = t0 + lrow, b = row >> 12;
                const GAS f32x4* xr = (const GAS f32x4*)(X1 + (size_t)row * D) + lane;
                f32x4 v[8]; float ss = 0.f;
#pragma unroll
                for (int j = 0; j < 8; ++j) { v[j] = xr[64 * j]; ss += (v[j].x * v[j].x + v[j].y * v[j].y) + (v[j].z * v[j].z + v[j].w * v[j].w); }
                const float r = 1.0f / sqrtf(wave_sum(ss) * (1.0f / D) + EPS);
                GAS v2u* o8 = (GAS v2u*)(Hb + (size_t)row * D) + lane;
#pragma unroll
                for (int j = 0; j < 8; ++j) { const int k = 4 * lane + 256 * j;
                    const f32x4 g = *(const GAS f32x4*)(norm2_gain + k), sh = *(const GAS f32x4*)(mod + b * 12288 + 3 * 2048 + k), scl = *(const GAS f32x4*)(mod + b * 12288 + 4 * 2048 + k);
                    const f32x4 hv = v[j] * r * g * (scl + 1.0f) + sh;
                    v2u o; o.x = pk2(hv.x, hv.y); o.y = pk2(hv.z, hv.w); o8[64 * j] = o;
                    *(LAS v2u*)(Al + lrow * 2048 + k) = o; }
            }
            __syncthreads();
            if (wave < 5) {
                f32x4 a0 = {0.f, 0.f, 0.f, 0.f}, a1 = {0.f, 0.f, 0.f, 0.f};
                const bf16* Bb = Wrt + (size_t)(16 * wave + r16) * D + 8 * q4;
                for (int s = 0; s < 64; ++s) {
                    const bf16x8 bb = ldg8(Bb + 32 * s);
                    const bf16x8 x0 = *(const LAS bf16x8*)(Al + r16 * 2048 + 32 * s + 8 * q4), x1v = *(const LAS bf16x8*)(Al + (16 + r16) * 2048 + 32 * s + 8 * q4);
                    a0 = mma16(x0, bb, a0); a1 = mma16(x1v, bb, a1);
                }
#pragma unroll
                for (int reg = 0; reg < 4; ++reg) { Lg[(4 * q4 + reg) * 80 + 16 * wave + r16] = a0[reg]; Lg[(16 + 4 * q4 + reg) * 80 + 16 * wave + r16] = a1[reg]; }
            }
            __syncthreads();
            if (tid < 32) {
                const int row = t0 + tid; const LAS float* L = Lg + tid * 80;
                float gl[4]; int gs = 0;
#pragma unroll
                for (int j = 0; j < 4; ++j) gl[j] = L[64 + j] + b_rg[j];
#pragma unroll
                for (int j = 1; j < 4; ++j) if (gl[j] > gl[gs]) gs = j;
                float den = 0.f;
#pragma unroll
                for (int j = 0; j < 4; ++j) den += expf(gl[j] - gl[gs]);
                const float gw = 1.0f / den;
                int i0 = 0; float v0 = -INFINITY;
                for (int j = 0; j < 16; ++j) { const float v = L[gs * 16 + j] + b_re[gs * 16 + j]; if (v > v0) { v0 = v; i0 = j; } }
                int i1 = 0; float v1 = -INFINITY;
                for (int j = 0; j < 16; ++j) { const float v = L[gs * 16 + j] + b_re[gs * 16 + j]; if (j != i0 && v > v1) { v1 = v; i1 = j; } }
                const float e1 = expf(v1 - v0); const float w0 = gw / (1.0f + e1), w1 = gw * e1 / (1.0f + e1);
                const int ex0 = gs * 16 + i0, ex1 = gs * 16 + i1;
                const int p0 = (int)__hip_atomic_fetch_add(ecnt + ex0, 1u, RLX_AGENT), p1 = (int)__hip_atomic_fetch_add(ecnt + ex1, 1u, RLX_AGENT);
                int* rt = route + (size_t)row * 8;
                rt[0] = ex0; rt[1] = p0; rt[2] = ex1; rt[3] = p1; rt[4] = __builtin_bit_cast(int, w0); rt[5] = __builtin_bit_cast(int, w1);
                rowtok[ex0 * 8192 + p0] = row; rowtok[ex1 * 8192 + p1] = row;
            }
            __syncthreads();
        }
    }
    SEAM(8);

    LAS int* ecl = (LAS int*)(lds + MISC_OFF + 1024);
    LAS int* bstart = (LAS int*)(lds + MISC_OFF + 1536);
    if (hi > 9 && lo <= 12) {
        if (tid == 0) { int nb = 0;
            for (int e = 0; e < NEXP; ++e) { const int cnt = (int)__hip_atomic_load(ecnt + e, RLX_AGENT); ecl[e] = cnt; bstart[e] = nb; nb += cnt; } }
        __syncthreads();
    }

    if (IN(10)) {
        for (int L = bid; L < 1024; L += G) {
            const int lx = L & 7, li = (L >> 3) & 31, r = L >> 8; const int e = 8 * lx + 2 * r + (li >> 4), j = li & 15;
            const int Me = ecl[e], rb = bstart[e];
            for (int p0 = 0; p0 < Me; p0 += moe::MT) {
                const int mrows = (Me - p0) < moe::MT ? (Me - p0) : moe::MT;
                unsigned arow[5];
#pragma unroll
                for (int h = 0; h < 3; ++h)
#pragma unroll
                    for (int i = 0; i < 2; ++i) if (h * 2 + i < 5) { int R, C; pg8::stage_rc(tid * 16 + i * 8192, R, C); int rr = p0 + h * 128 + R; rr = rr < Me ? rr : Me - 1;
                        arow[h * 2 + i] = (unsigned)rowtok[e * 8192 + rr] * (unsigned)(D * 2) + (unsigned)(C * 2); }
                moe::tile<1>(lds, (const unsigned char*)Hb, arow, w_eg + (size_t)e * D * EDIM + j * 64, w_eu + (size_t)e * D * EDIM + j * 64, EDIM,
                             (mrows + 15) >> 4, mrows, HB + (size_t)(rb + p0) * EDIM + j * 64, EDIM, tid);
            }
        }
    }
    SEAM(10);

    if (IN(11)) {
        for (int L = bid; L < 1024; L += G) {
            const int lx = L & 7, li = (L >> 3) & 31, r = L >> 8; const int e = 8 * lx + 2 * r + (li >> 4), j = li & 15;
            const int Me = ecl[e], rb = bstart[e];
            for (int p0 = 0; p0 < Me; p0 += moe::MT) {
                const int mrows = (Me - p0) < moe::MT ? (Me - p0) : moe::MT;
                unsigned arow[5];
#pragma unroll
                for (int h = 0; h < 3; ++h)
#pragma unroll
                    for (int i = 0; i < 2; ++i) if (h * 2 + i < 5) { int R, C; pg8::stage_rc(tid * 16 + i * 8192, R, C); int rr = p0 + h * 128 + R; rr = rr < Me ? rr : Me - 1;
                        arow[h * 2 + i] = (unsigned)(rb + rr) * (unsigned)(EDIM * 2) + (unsigned)(C * 2); }
                moe::tile<2>(lds, (const unsigned char*)HB, arow, w_ed + (size_t)e * EDIM * D + j * 128, nullptr, D,
                             (mrows + 15) >> 4, mrows, YB + (size_t)(rb + p0) * D + j * 128, D, tid);
            }
        }
    }
    SEAM(11);

    if (IN(12)) {
        const int gw = bid * NWAVES + wave, NGW = G * NWAVES;
        for (int row = gw; row < T; row += NGW) {
            const int b = row >> 12; const int* rt = route + (size_t)row * 8;
            const int r0 = bstart[rt[0]] + rt[1], r1 = bstart[rt[2]] + rt[3];
            const float w0 = __builtin_bit_cast(float, rt[4]), w1 = __builtin_bit_cast(float, rt[5]);
            const GAS f32x4* xr = (const GAS f32x4*)(X1 + (size_t)row * D) + lane;
            const GAS v2u* y0 = (const GAS v2u*)(YB + (size_t)r0 * D) + lane; const GAS v2u* y1 = (const GAS v2u*)(YB + (size_t)r1 * D) + lane;
            f32x4 v[8]; float ss = 0.f;
#pragma unroll
            for (int j = 0; j < 8; ++j) { const int k = 4 * lane + 256 * j;
                const f32x4 g2 = *(const GAS f32x4*)(mod + b * 12288 + 5 * 2048 + k);
                const v2u a = y0[64 * j], bq = y1[64 * j];
                f32x4 f; f.x = w0 * bf2f(a.x & 0xffffu) + w1 * bf2f(bq.x & 0xffffu); f.y = w0 * bf2f(a.x >> 16) + w1 * bf2f(bq.x >> 16);
                f.z = w0 * bf2f(a.y & 0xffffu) + w1 * bf2f(bq.y & 0xffffu); f.w = w0 * bf2f(a.y >> 16) + w1 * bf2f(bq.y >> 16);
#ifdef DBG_SKIP_MOE
                v[j] = xr[64 * j];
#else
                v[j] = xr[64 * j] + g2 * f;
#endif
                ss += (v[j].x * v[j].x + v[j].y * v[j].y) + (v[j].z * v[j].z + v[j].w * v[j].w); }
            const float r = 1.0f / sqrtf(wave_sum(ss) * (1.0f / D) + EPS);
            GAS f32x4* o = (GAS f32x4*)(args.out + (size_t)row * D) + lane;
#pragma unroll
            for (int j = 0; j < 8; ++j) { const f32x4 g = *(const GAS f32x4*)(final_gain + 4 * lane + 256 * j); o[64 * j] = v[j] * r * g; }
        }
    }
#undef IN
#undef SEAM
}


#ifdef DBG_TAP
__global__ void tap_kernel(unsigned char* ws, float* out, int mode) {
    const bf16* Hb = (const bf16*)(ws + WS_H); const bf16* P = (const bf16*)(ws + WS_P);
    const bf16* Vta = (const bf16*)(ws + WS_VTA); const bf16* Vtr = (const bf16*)(ws + WS_VTR); const bf16* Krt = (const bf16*)(ws + WS_KRT);
    const float* SC = (const float*)(ws + WS_SC); const bf16* ST = (const bf16*)(ws + WS_ST);
    const bf16* ATT = (const bf16*)(ws + WS_ATTN); const bf16* RET = (const bf16*)(ws + WS_RET); const bf16* MG = (const bf16*)(ws + WS_MERGED);
    const float* X1 = (const float*)(ws + WS_X1); const float* mod = (const float*)(ws + WS_MOD);
    for (size_t i = (size_t)blockIdx.x * blockDim.x + threadIdx.x; i < (size_t)T * D; i += (size_t)gridDim.x * blockDim.x) {
        const int row = (int)(i >> 11), c = (int)(i & 2047), b = row >> 12, s = row & 4095; float v = 0.f;
        if (mode == 0) v = mod[(i % 24576)];
        if (mode == 1) v = bf2f(Hb[i]);
        if (mode == 2) { v = bf2f(P[(size_t)row * NPROJ + c]) + bf2f(P[(size_t)row * NPROJ + C_QR + c]) + bf2f(P[(size_t)row * NPROJ + C_KR + c]) + bf2f(P[(size_t)row * NPROJ + C_GR + c]) + bf2f(P[(size_t)row * NPROJ + C_GA + c]) + bf2f(P[(size_t)row * NPROJ + C_GT + c])
                 + bf2f(P[(size_t)row * NPROJ + C_KA + (c & 255)]) + bf2f(Vtr[(size_t)(b * 2048 + c) * 4096 + s]) + bf2f(Krt[(size_t)(b * 2048 + c) * 4096 + s]) + bf2f(Vta[(size_t)(b * 256 + (c & 255)) * 4096 + s]); }
        if (mode == 3) { v = bf2f(ATT[i]); for (int j = 0; j < 4; ++j) v += SC[i * 4 + j] * 0.01f; }
        if (mode == 4) { for (int j = 0; j < 2; ++j) v += bf2f(ST[i * 2 + j]); }
        if (mode == 5) v = bf2f(RET[i]);
        if (mode == 6) v = bf2f(MG[i]);
        if (mode == 7) v = X1[i];
        out[i] = v;
    }
}
#endif

#ifdef DBG_STREAM
__global__ void __launch_bounds__(512, 2) probe_stream(const float* w_eg, const float* w_eu, float* dump) {
    const int tid = threadIdx.x, lane = tid & 63, wave = tid >> 6, bid = blockIdx.x, G = gridDim.x;
    f32x4 s = {0.f, 0.f, 0.f, 0.f};
    for (int L = bid; L < 1024; L += G) {
        const int lx = L & 7, li = (L >> 3) & 31, r = L >> 8; const int e = 8 * lx + 2 * r + (li >> 4), j = li & 15;
        const int mat = wave & 1, kq = wave >> 1, kg = lane >> 4, cq = lane & 15;
        const float* base = (mat ? w_eu : w_eg) + (size_t)e * D * EDIM + j * 64 + (size_t)(16 * kq + 4 * kg) * EDIM + 4 * cq;
#if DBG_STREAM == 1
        for (int kt = 0; kt < 32; kt += DBG_DEPTH) {
            f32x4 v[DBG_DEPTH][4];
#pragma unroll
            for (int t = 0; t < DBG_DEPTH; ++t)
#pragma unroll
                for (int q = 0; q < 4; ++q) v[t][q] = __builtin_nontemporal_load((const GAS f32x4*)(base + (size_t)((kt + t) * 64 + q) * EDIM));
#pragma unroll
            for (int t = 0; t < DBG_DEPTH; ++t)
#pragma unroll
                for (int q = 0; q < 4; ++q) s += v[t][q];
        }
#endif
    }
    if (s.x + s.y + s.z + s.w == 12345.678f) dump[tid] = s.x;
}
#endif
constexpr int NPHASES = 13;
#ifndef MK_ONE_LAUNCH
#define MK_ONE_LAUNCH 0
#endif
extern "C" void kernel_launch(void* const* d_in, const int* in_sizes, int n_in, void* d_out, int out_size, void* d_ws, size_t ws_size, hipStream_t stream) {
    static int grid = 0;
    if (grid == 0) {
        if (n_in != 21 || out_size != T * D || ws_size < WS_END) { fprintf(stderr, "kernel_launch: unexpected shapes (n_in %d out %d ws %zu)\n", n_in, out_size, ws_size); grid = -1; return; }
        int dev = 0, cus = 0, per_cu = 0;
        if (hipGetDevice(&dev) != hipSuccess || hipDeviceGetAttribute(&cus, hipDeviceAttributeMultiprocessorCount, dev) != hipSuccess) { grid = -1; return; }
        if (hipFuncSetAttribute((const void*)fwd_kernel, hipFuncAttributeMaxDynamicSharedMemorySize, LDS_BYTES) != hipSuccess) { fprintf(stderr, "kernel_launch: hipFuncSetAttribute failed\n"); grid = -1; return; }
        if (hipOccupancyMaxActiveBlocksPerMultiprocessor(&per_cu, (const void*)fwd_kernel, NTHR, LDS_BYTES) != hipSuccess || per_cu < 1) { fprintf(stderr, "kernel_launch: occupancy query says %d\n", per_cu); }
        (void)hipGetLastError();
        grid = cus;
    }
    if (grid < 0) return;
    if (hipMemsetAsync((char*)d_ws + WS_CTL, 0, CTL_ZERO_BYTES, stream) != hipSuccess) return;
    Args a{};
    for (int i = 0; i < 21; ++i) a.in[i] = d_in[i];
    a.out = (float*)d_out; a.ws = (unsigned char*)d_ws;
#if MK_ONE_LAUNCH
#ifdef DBG_REP
    a.ph_lo = 0; a.ph_hi = DBG_REP_HI + 1; a.bar_region = 0; hipLaunchKernelGGL(fwd_kernel, dim3(grid), dim3(NTHR), LDS_BYTES, stream, a);
    a.ph_lo = DBG_REP; a.ph_hi = DBG_REP_HI + 1; a.bar_region = 1; hipLaunchKernelGGL(fwd_kernel, dim3(grid), dim3(NTHR), LDS_BYTES, stream, a);
    if (DBG_REP_HI + 1 < NPHASES) { a.ph_lo = DBG_REP_HI + 1; a.ph_hi = NPHASES; a.bar_region = 2; hipLaunchKernelGGL(fwd_kernel, dim3(grid), dim3(NTHR), LDS_BYTES, stream, a); }
#else
    a.ph_lo = 0; a.ph_hi = NPHASES;
    hipLaunchKernelGGL(fwd_kernel, dim3(grid), dim3(NTHR), LDS_BYTES, stream, a);
#ifdef DBG_STREAM
    hipLaunchKernelGGL(probe_stream, dim3(grid), dim3(512), 0, stream, (const float*)d_in[18], (const float*)d_in[19], (float*)((char*)d_ws + WS_END));
#endif
#endif
#else
#ifdef DBG_TAP
    for (int p = 0; p <= DBG_TAP; ++p) { a.ph_lo = p; a.ph_hi = p + 1; hipLaunchKernelGGL(fwd_kernel, dim3(grid), dim3(NTHR), LDS_BYTES, stream, a); }
    hipLaunchKernelGGL(tap_kernel, dim3(2048), dim3(256), 0, stream, (unsigned char*)d_ws, (float*)d_out, (int)DBG_TAPMODE);
#else
    for (int p = 0; p < NPHASES; ++p) { a.ph_lo = p; a.ph_hi = p + 1; hipLaunchKernelGGL(fwd_kernel, dim3(grid), dim3(NTHR), LDS_BYTES, stream, a); }
#endif
#endif
}
```

```cpp
#define MK_ONE_LAUNCH 1
#include <hip/hip_runtime.h>
#include <cstdio>
#include <cstdint>
#include <cmath>
namespace pg8 {
#define PG8_LAS __attribute__((address_space(3)))
typedef unsigned short bf16_t;
typedef short bf16x8 __attribute__((ext_vector_type(8)));
typedef float f32x4 __attribute__((ext_vector_type(4)));
typedef unsigned u32x4 __attribute__((ext_vector_type(4)));
constexpr int BM = 256, BK = 64, HALF = 128, HTB = HALF * BK * 2  , STAGE_BYTES = 8 * HTB, NXCD = 8, WGM = 8;

__host__ __device__ __forceinline__ int lds_byte(int r, int c) { const int st = (r >> 4) * 2 + (c >> 5), rr = r & 15, cc = c & 31, ob = rr * 64 + cc * 2; return st * 1024 + (ob ^ (((ob >> 9) & 1) << 5)); }
__host__ __device__ __forceinline__ void stage_rc(int b, int& R, int& C) { const int st = b / 1024, sb = b % 1024, swz = sb ^ (((sb >> 9) & 1) << 5); R = (st >> 1) * 16 + swz / 64; C = (st & 1) * 32 + (swz % 64) / 2; }
__host__ __device__ __forceinline__ int perm32(int rho) { const int n = rho >> 4, i = rho & 15; return 8 * (i >> 2) + 4 * n + (i & 3); }

struct Unit { int pm, pn; };
struct Gemm { const bf16_t* A; const bf16_t* Bt; int M, N, K; };

struct StaticOrder {
    int nM, nN, nwg, G, c;
    __host__ __device__ void init(int M, int N, int G_, int c_) { nM = M / BM; nN = N / BM; nwg = nM * nN; G = G_; c = c_; }
    __host__ __device__ bool next(int i, Unit& u) const {
        const long L = (long)i * G + c; if (L >= nwg) return false;
        int wgid = (int)L; { const int q = nwg / NXCD, r = nwg % NXCD, xcd = wgid % NXCD, off = wgid / NXCD; wgid = (xcd < r ? xcd * (q + 1) : r * (q + 1) + (xcd - r) * q) + off; }
        const int nig = WGM * nN, gid = wgid / nig, fm = gid * WGM, gsz = (nM - fm) < WGM ? (nM - fm) : WGM;
        u.pm = fm + ((wgid % nig) % gsz); u.pn = (wgid % nig) / gsz; return true;
    }
    __device__ __forceinline__ void a_ready(const Unit&) const {}
    __device__ __forceinline__ void done(const Unit&) const {}
};

__device__ __forceinline__ unsigned cvt_pk_bf16(float lo, float hi) { unsigned r; asm volatile("v_cvt_pk_bf16_f32 %0, %1, %2" : "=v"(r) : "v"(lo), "v"(hi)); return r; }
template <class Epi, class Sched, bool ALIGN_EPI = false, bool SP2 = false>
__device__ __forceinline__ void gemm_phase(PG8_LAS unsigned char* lds, const Gemm g, const Sched& S, const Epi& E) {
    const int tid = threadIdx.x, wid = __builtin_amdgcn_readfirstlane(tid >> 6), lane = tid & 63, wr = wid >> 2, wc = wid & 3, fr = lane & 15, fq = lane >> 4;
    const int K = g.K, nt = K / BK;
    unsigned voffA[2], voffB[2];
#pragma unroll
    for (int i = 0; i < 2; ++i) { int R, C; stage_rc(tid * 16 + i * 8192, R, C); const int Rb = Epi::PERM ? ((R & ~31) + perm32(R & 31)) : R;
        voffA[i] = (unsigned)(R * K + C) * 2u; voffB[i] = (unsigned)(Rb * K + C) * 2u; }
    const size_t kstep = (size_t)(BK * 2);
    const size_t hstep = (size_t)HALF * K * 2;
    const size_t tstep = 2 * hstep;
    const unsigned ldsw = (unsigned)wid * 1024u;
    const int aoff = lds_byte(wr * 64 + fr, fq * 8), boff = lds_byte(wc * 32 + fr, fq * 8);
#define PG8_SA(b, h) (((b) * 2 + (h)) * HTB)
#define PG8_SB(b, h) ((4 + (b) * 2 + (h)) * HTB)
#define PG8_STAGE(bufoff, gbase, voff) do { _Pragma("unroll") for (int _i = 0; _i < 2; ++_i) \
        __builtin_amdgcn_global_load_lds((const unsigned*)((const char*)(gbase) + (voff)[_i]), (PG8_LAS unsigned*)(lds + (bufoff) + ldsw + _i * 8192), 16, 0, 0); } while (0)
#define PG8_LDA(dst, b, h) do { _Pragma("unroll") for (int m = 0; m < 4; ++m) _Pragma("unroll") for (int k = 0; k < 2; ++k) dst[m][k] = *(const PG8_LAS bf16x8*)(lds + PG8_SA(b, h) + aoff + m * 2048 + k * 1024); } while (0)
#define PG8_LDB(dst, b, h) do { _Pragma("unroll") for (int n = 0; n < 2; ++n) _Pragma("unroll") for (int k = 0; k < 2; ++k) dst[n][k] = *(const PG8_LAS bf16x8*)(lds + PG8_SB(b, h) + boff + n * 2048 + k * 1024); } while (0)
#define PG8_MMA(ai, bj, At, Bt) do { __builtin_amdgcn_s_setprio(1); _Pragma("unroll") for (int m = 0; m < 4; ++m) _Pragma("unroll") for (int n = 0; n < 2; ++n) _Pragma("unroll") for (int k = 0; k < 2; ++k) \
        acc[ai][bj][m][n] = __builtin_amdgcn_mfma_f32_16x16x32_bf16(Bt[n][k], At[m][k], acc[ai][bj][m][n], 0, 0, 0); __builtin_amdgcn_s_setprio(0); } while (0)
#define PG8_WAIT_V(n) asm volatile("s_waitcnt vmcnt(" #n ")" ::: "memory")
#define PG8_WAIT_L(n) asm volatile("s_waitcnt lgkmcnt(" #n ")" ::: "memory")
#define PG8_BAR __builtin_amdgcn_s_barrier()
#define PG8_SCHED __builtin_amdgcn_sched_barrier(0)
    Unit cur, nxt; int ui = 0;
    if (!S.next(0, cur)) return;
    f32x4 acc[2][2][4][2];
#pragma unroll
    for (int a = 0; a < 2; ++a)
#pragma unroll
        for (int b = 0; b < 2; ++b)
#pragma unroll
            for (int m = 0; m < 4; ++m)
#pragma unroll
                for (int n = 0; n < 2; ++n) acc[a][b][m][n] = (f32x4){0.f, 0.f, 0.f, 0.f};
    bf16x8 At[4][2], B0[2][2], B1[2][2];
    const char* cA = (const char*)g.A + (size_t)cur.pm * tstep; const char* cB = (const char*)g.Bt + (size_t)cur.pn * tstep;
    S.a_ready(cur);
    if constexpr (SP2) {
        PG8_STAGE(PG8_SB(0, 0), cB, voffB); PG8_STAGE(PG8_SB(0, 1), cB + hstep, voffB); PG8_STAGE(PG8_SA(0, 0), cA, voffA); PG8_STAGE(PG8_SA(0, 1), cA + hstep, voffA);
        if (wr == 1) PG8_BAR;
        PG8_WAIT_V(2); PG8_BAR;
        PG8_STAGE(PG8_SB(1, 0), cB + kstep, voffB); PG8_STAGE(PG8_SA(1, 0), cA + kstep, voffA); PG8_STAGE(PG8_SB(1, 1), cB + hstep + kstep, voffB);
        PG8_WAIT_V(6); PG8_BAR;
    } else {
        PG8_STAGE(PG8_SB(0, 0), cB, voffB); PG8_STAGE(PG8_SA(0, 0), cA, voffA); PG8_STAGE(PG8_SB(0, 1), cB + hstep, voffB); PG8_STAGE(PG8_SA(0, 1), cA + hstep, voffA);
        if (wr == 1) PG8_BAR;
        PG8_WAIT_V(4); PG8_BAR;
        PG8_STAGE(PG8_SB(1, 0), cB + kstep, voffB); PG8_STAGE(PG8_SA(1, 0), cA + kstep, voffA); PG8_STAGE(PG8_SB(1, 1), cB + hstep + kstep, voffB);
        PG8_WAIT_V(6); PG8_BAR;
    }
    for (;;) {
        const bool has_next = S.next(ui + 1, nxt);
        const char* nA = has_next ? (const char*)g.A + (size_t)nxt.pm * tstep : cA; const char* nB = has_next ? (const char*)g.Bt + (size_t)nxt.pn * tstep : cB;
        for (int t = 0; t < nt; t += 2) {
            const bool last = (t == nt - 2);
            const char* a1 = cA + (size_t)(t + 1) * kstep;
            const char* a2 = last ? nA : cA + (size_t)(t + 2) * kstep; const char* b2 = last ? nB : cB + (size_t)(t + 2) * kstep;
            const char* a3 = a2 + kstep; const char* b3 = b2 + kstep;
            if (last && has_next) S.a_ready(nxt);
            if constexpr (SP2) {
            PG8_LDB(B0, 0, 0); PG8_LDB(B1, 0, 1); PG8_SCHED; PG8_LDA(At, 0, 0); PG8_STAGE(PG8_SA(1, 1), a1 + hstep, voffA);
            PG8_WAIT_V(8); PG8_WAIT_L(0); PG8_BAR; PG8_MMA(0, 0, At, B0); PG8_MMA(0, 1, At, B1); PG8_BAR; PG8_SCHED;
            PG8_LDA(At, 0, 1); PG8_STAGE(PG8_SB(0, 0), b2, voffB); PG8_STAGE(PG8_SB(0, 1), b2 + hstep, voffB); PG8_STAGE(PG8_SA(0, 0), a2, voffA);
            PG8_WAIT_V(8); PG8_WAIT_L(0); PG8_BAR; PG8_MMA(1, 0, At, B0); PG8_MMA(1, 1, At, B1); PG8_BAR; PG8_SCHED;
            PG8_LDB(B0, 1, 0); PG8_LDB(B1, 1, 1); PG8_SCHED; PG8_LDA(At, 1, 0); PG8_STAGE(PG8_SA(0, 1), a2 + hstep, voffA);
            PG8_WAIT_V(8); PG8_WAIT_L(0); PG8_BAR; PG8_MMA(0, 0, At, B0); PG8_MMA(0, 1, At, B1); PG8_BAR; PG8_SCHED;
            PG8_LDA(At, 1, 1); PG8_STAGE(PG8_SB(1, 0), b3, voffB); PG8_STAGE(PG8_SB(1, 1), b3 + hstep, voffB); PG8_STAGE(PG8_SA(1, 0), a3, voffA);
            PG8_WAIT_V(8); PG8_WAIT_L(0); PG8_BAR; PG8_MMA(1, 0, At, B0); PG8_MMA(1, 1, At, B1); PG8_BAR; PG8_SCHED;
            } else {
            PG8_LDB(B0, 0, 0); PG8_SCHED; PG8_LDA(At, 0, 0); PG8_STAGE(PG8_SA(1, 1), a1 + hstep, voffA);
            PG8_WAIT_L(8); PG8_BAR; PG8_WAIT_L(0); PG8_MMA(0, 0, At, B0); PG8_BAR; PG8_SCHED;
            PG8_LDB(B1, 0, 1); PG8_STAGE(PG8_SB(0, 0), b2, voffB);
            PG8_BAR; PG8_WAIT_L(0); PG8_MMA(0, 1, At, B1); PG8_BAR;
            PG8_LDA(At, 0, 1); PG8_STAGE(PG8_SA(0, 0), a2, voffA);
            PG8_BAR; PG8_WAIT_L(0); PG8_MMA(1, 0, At, B0); PG8_BAR; PG8_SCHED;
            PG8_STAGE(PG8_SB(0, 1), b2 + hstep, voffB);
            PG8_WAIT_V(6); PG8_BAR; PG8_MMA(1, 1, At, B1); PG8_BAR;
            PG8_LDB(B0, 1, 0); PG8_SCHED; PG8_LDA(At, 1, 0); PG8_STAGE(PG8_SA(0, 1), a2 + hstep, voffA);
            PG8_WAIT_L(8); PG8_BAR; PG8_WAIT_L(0); PG8_MMA(0, 0, At, B0); PG8_BAR; PG8_SCHED;
            PG8_LDB(B1, 1, 1); PG8_STAGE(PG8_SB(1, 0), b3, voffB);
            PG8_BAR; PG8_WAIT_L(0); PG8_MMA(0, 1, At, B1); PG8_BAR;
            PG8_LDA(At, 1, 1); PG8_STAGE(PG8_SA(1, 0), a3, voffA);
            PG8_BAR; PG8_WAIT_L(0); PG8_MMA(1, 0, At, B0); PG8_BAR; PG8_SCHED;
            PG8_STAGE(PG8_SB(1, 1), b3 + hstep, voffB);
            PG8_WAIT_V(6); PG8_BAR; PG8_MMA(1, 1, At, B1); PG8_BAR;
            }
        }
        if constexpr (ALIGN_EPI) { if (wr == 0) PG8_BAR; }
        if constexpr (!Epi::AFTER_DRAIN) { E(acc, cur, wr, wc, fr, fq); S.done(cur); }
        if (!has_next) break;
#pragma unroll
        for (int a = 0; a < 2; ++a)
#pragma unroll
            for (int b = 0; b < 2; ++b)
#pragma unroll
                for (int m = 0; m < 4; ++m)
#pragma unroll
                    for (int n = 0; n < 2; ++n) acc[a][b][m][n] = (f32x4){0.f, 0.f, 0.f, 0.f};
        cur = nxt; cA = nA; cB = nB; ++ui;
        if constexpr (ALIGN_EPI) { if (wr == 1) PG8_BAR; }
    }
    PG8_WAIT_V(0);
    if constexpr (!ALIGN_EPI) { if (wr == 0) PG8_BAR; }
    PG8_BAR;
    if constexpr (Epi::AFTER_DRAIN) { E.fused(acc, cur, wr, wc, fr, fq, lds, wid, lane); S.done(cur); }
#undef PG8_SA
#undef PG8_SB
#undef PG8_STAGE
#undef PG8_LDA
#undef PG8_LDB
#undef PG8_MMA
#undef PG8_WAIT_V
#undef PG8_WAIT_L
#undef PG8_BAR
#undef PG8_SCHED
}
}

constexpr int NWAVES = 8, NTHR = 512;
constexpr int BATCH = 2, SEQ = 4096, T = BATCH * SEQ, D = 2048;
constexpr int NPROJ = 14848;
constexpr int C_QA = 0, C_KA = 2048, C_VA = 2304, C_QR = 2560, C_KR = 4608, C_VR = 6656, C_GR = 8704, C_GA = 10752, C_GT = 12800;
constexpr int NEXP = 64, EDIM = 1024;
constexpr float EPS = 1e-6f;
constexpr float LOG2E = 1.4426950408889634f;
constexpr float QA_SCALE = 0.125f * LOG2E;

constexpr size_t MiB = 1u << 20;
constexpr size_t WS_CTL = 0, CTL_ZERO_BYTES = 1 * MiB;
constexpr size_t WS_MOD = 1 * MiB;
constexpr size_t WS_ROPE = 2 * MiB;
constexpr size_t WS_WIN = 10 * MiB;
constexpr size_t WS_WBA = 68 * MiB, WS_WBR = 76 * MiB, WS_WOUT = 84 * MiB;
constexpr size_t WS_ROUTE = 92 * MiB;
constexpr size_t WS_WRT = 94 * MiB;
constexpr size_t WS_H = 96 * MiB;
constexpr size_t WS_X1 = 128 * MiB;
constexpr size_t WS_P = 192 * MiB;
constexpr size_t WS_VTA = 424 * MiB;
constexpr size_t WS_VTR = 428 * MiB;
constexpr size_t WS_KRT = 460 * MiB;
constexpr size_t WS_SC = 492 * MiB;
constexpr size_t WS_ST = 620 * MiB;
constexpr size_t WS_ATTN = 684 * MiB;
constexpr size_t WS_RET = 716 * MiB;
constexpr size_t WS_M1 = 748 * MiB;
constexpr size_t WS_MERGED = 812 * MiB;
constexpr size_t WS_XG = 192 * MiB;
constexpr size_t WS_HB = 320 * MiB;
constexpr size_t WS_Y = 384 * MiB;
constexpr size_t WS_RTOK = 848 * MiB;
constexpr size_t WS_END = 850 * MiB;

constexpr int CW_TMO = 0, CW_BAR = 4096, CW_CNT = 16384;

constexpr int RING_BYTES = 131072;
constexpr int MISC_OFF = 155648;
constexpr int MISC_BYTES = 8192;
constexpr int LDS_BYTES = MISC_OFF + MISC_BYTES;

#define GAS __attribute__((address_space(1)))
#define LAS __attribute__((address_space(3)))
typedef unsigned short bf16;
typedef unsigned v4u __attribute__((ext_vector_type(4)));
typedef unsigned v2u __attribute__((ext_vector_type(2)));
typedef float f32x4 __attribute__((ext_vector_type(4)));
typedef short bf16x8 __attribute__((ext_vector_type(8)));
typedef GAS unsigned gu32;
#define RLX_AGENT __ATOMIC_RELAXED, __HIP_MEMORY_SCOPE_AGENT
#define LDS_WAIT() asm volatile("s_waitcnt lgkmcnt(0)" ::: "memory")
#define VM_WAIT() asm volatile("s_waitcnt vmcnt(0)" ::: "memory")
__device__ __forceinline__ unsigned f2bf(float f) { unsigned u = __builtin_bit_cast(unsigned, f); return (u + 0x7fffu + ((u >> 16) & 1u)) >> 16; }
__device__ __forceinline__ unsigned pk2(float lo, float hi) { return f2bf(lo) | (f2bf(hi) << 16); }
__device__ __forceinline__ float bf2f(unsigned b) { return __builtin_bit_cast(float, b << 16); }
__device__ __forceinline__ float wave_sum(float v) {
#pragma unroll
    for (int o = 1; o < 64; o <<= 1) v += __shfl_xor(v, o);
    return v;
}
__device__ __forceinline__ float sum16(float v) {
#pragma unroll
    for (int o = 1; o < 16; o <<= 1) v += __shfl_xor(v, o);
    return v;
}
__device__ __forceinline__ float max16(float v) {
#pragma unroll
    for (int o = 1; o < 16; o <<= 1) v = fmaxf(v, __shfl_xor(v, o));
    return v;
}
__device__ __forceinline__ float sigmoidf_(float x) { return 1.0f / (1.0f + __expf(-x)); }
__device__ __forceinline__ float siluf_(float x) { return x / (1.0f + __expf(-x)); }

#define XB_TMO      128
#define XB_XCNT(j)  (256  + 64 * (j))
#define XB_XSUB(j)  (1280 + 64 * (j))
#define XB_XGEN(j)  (2304 + 64 * (j))
#define XB_TOP      3328
#define XB_TOPGEN   3392
#define XCD_BAR_WORDS 3456
#define XB_SPIN_CAP (1u << 18)

__device__ __forceinline__ unsigned xb_ld(unsigned* p)              { return __hip_atomic_load(p, __ATOMIC_RELAXED, __HIP_MEMORY_SCOPE_AGENT); }
__device__ __forceinline__ unsigned xb_add(unsigned* p, unsigned v) { return __hip_atomic_fetch_add(p, v, __ATOMIC_RELAXED, __HIP_MEMORY_SCOPE_AGENT); }
__device__ __forceinline__ unsigned xb_xcc_id() { return (unsigned)__builtin_amdgcn_s_getreg((3 << 11) | 20) & 0xFu; }
#define XB_SPIN(cond, bar) do { unsigned _sp = 0; while (cond) { __builtin_amdgcn_s_sleep(1); \
    if ((++_sp & 255u) == 0u) { if (xb_ld(&(bar)[XB_TMO])) break; if (_sp > XB_SPIN_CAP) { atomicAdd(&(bar)[XB_TMO], 1u); break; } } } } while (0)

struct XcdBarrier {
    unsigned* bar; unsigned x;
    volatile LAS unsigned* st;
};

__device__ __forceinline__ XcdBarrier xcd_barrier_post(unsigned* bar, volatile LAS unsigned* st) {
    XcdBarrier b; b.bar = bar; b.x = xb_xcc_id(); b.st = st;
    if (threadIdx.x == 0) (void)xb_add(&bar[XB_XCNT(b.x)], 1u);
    return b;
}
__device__ __forceinline__ void xcd_barrier_complete(unsigned* bar, unsigned x, unsigned& nloc, unsigned& nx) {
    const unsigned G = gridDim.x * gridDim.y * gridDim.z;
    unsigned sum, cnt, mine, sp = 0u;
    for (;;) {
        sum = 0u; cnt = 0u; mine = 0u;
#pragma unroll
        for (unsigned j = 0; j < 16; ++j) { const unsigned c = xb_ld(&bar[XB_XCNT(j)]); sum += c; cnt += (c > 0u) ? 1u : 0u; mine = (j == x) ? c : mine; }
        if (sum == G) break;
        __builtin_amdgcn_s_sleep(1);
        if ((++sp & 255u) == 0u) { if (xb_ld(&bar[XB_TMO])) break; if (sp > XB_SPIN_CAP) { atomicAdd(&bar[XB_TMO], 1u); break; } }
    }
    nloc = mine > 0u ? mine : 1u; nx = cnt > 0u ? cnt : 1u;
}

__device__ __forceinline__ void xcd_barrier(const XcdBarrier& b) {
    asm volatile("s_waitcnt vmcnt(0)" ::: "memory");
    __syncthreads();
    if (threadIdx.x == 0) {
        unsigned* bar = b.bar;
        __builtin_amdgcn_s_waitcnt(0);
        unsigned nloc = b.st[0], nx = b.st[1];
        if (nloc == 0u) { xcd_barrier_complete(bar, b.x, nloc, nx); b.st[0] = nloc; b.st[1] = nx; }
        const unsigned old = xb_add(&bar[XB_XSUB(b.x)], 1u);
        const unsigned gen = old / nloc;
        if (old + 1u == (gen + 1u) * nloc) {
            __builtin_amdgcn_fence(__ATOMIC_RELEASE, "agent");
            asm volatile("s_waitcnt vmcnt(0)" ::: "memory");
            const unsigned og = xb_add(&bar[XB_TOP], 1u);
            const unsigned tg = og / nx;
            if (og + 1u == (tg + 1u) * nx) xb_add(&bar[XB_TOPGEN], 1u);
            else XB_SPIN(xb_ld(&bar[XB_TOPGEN]) == tg, bar);
            __builtin_amdgcn_fence(__ATOMIC_ACQUIRE, "agent");
            xb_add(&bar[XB_XGEN(b.x)], 1u);
            asm volatile("s_waitcnt vmcnt(0)" ::: "memory");
        } else {
            XB_SPIN(xb_ld(&bar[XB_XGEN(b.x)]) == gen, bar);
            __builtin_amdgcn_fence(__ATOMIC_ACQUIRE, "agent");
            asm volatile("s_waitcnt vmcnt(0)" ::: "memory");
        }
    }
    __syncthreads();
}


struct Args { const void* in[21]; float* out; unsigned char* ws; int ph_lo, ph_hi, bar_region, pad; };

__device__ __forceinline__ f32x4 mma16(bf16x8 a, bf16x8 b, f32x4 c) { return __builtin_amdgcn_mfma_f32_16x16x32_bf16(a, b, c, 0, 0, 0); }
__device__ __forceinline__ bf16x8 ldg8(const bf16* p) { return *(const GAS bf16x8*)p; }

namespace pg8 {
struct EpiProj {
    static constexpr bool PERM = true, AFTER_DRAIN = false;
    bf16* P; bf16* Vta; bf16* Vtr; bf16* Krt; const float* cosT; const float* sinT;
    __device__ __forceinline__ void operator()(const f32x4 (&acc)[2][2][4][2], const Unit& u, int wr, int wc, int fr, int fq) const {
        const int pn = u.pn;
        const int row0 = u.pm * BM + wr * 64 + fr;
        const int cl = wc * 32 + 8 * fq;
        if (pn == 9 || (pn >= 26 && pn < 34)) {
            bf16* base; int chan0, nchan;
            if (pn == 9) { base = Vta; chan0 = 0; nchan = 256; } else { base = Vtr; chan0 = (pn - 26) * 256; nchan = 2048; }
#pragma unroll
            for (int ai = 0; ai < 2; ++ai)
#pragma unroll
                for (int m = 0; m < 4; ++m) {
                    const int row = row0 + ai * HALF + m * 16; const int b = row >> 12, s = row & 4095;
                    bf16* colp = base + ((size_t)(b * nchan + chan0 + cl) * 4096 + s);
#pragma unroll
                    for (int bj = 0; bj < 2; ++bj)
#pragma unroll
                        for (int n = 0; n < 2; ++n)
#pragma unroll
                            for (int i = 0; i < 4; ++i) colp[(size_t)(bj * HALF + 4 * n + i) * 4096] = (bf16)f2bf(acc[ai][bj][m][n][i]);
                }
            return;
        }
        const bool rot = (pn >= 10 && pn < 26);
        const bool isk = (pn >= 18 && pn < 26);
        float lg2 = 0.f;
        if (isk) { const int h = pn - 18; lg2 = log1pf(-exp2f(-5.0f - (float)h)) * LOG2E; }
#pragma unroll
        for (int ai = 0; ai < 2; ++ai)
#pragma unroll
            for (int m = 0; m < 4; ++m) {
                const int row = row0 + ai * HALF + m * 16;
                f32x4 v[2][2];
#pragma unroll
                for (int bj = 0; bj < 2; ++bj)
#pragma unroll
                    for (int n = 0; n < 2; ++n) v[bj][n] = acc[ai][bj][m][n];
                if (rot) {
                    const float* cp = cosT + (size_t)row * 128 + cl; const float* sp = sinT + (size_t)row * 128 + cl;
#pragma unroll
                    for (int n = 0; n < 2; ++n) {
                        const f32x4 c = *(const f32x4*)(cp + 4 * n), s = *(const f32x4*)(sp + 4 * n);
                        const f32x4 t1 = v[0][n], t2 = v[1][n];
                        v[0][n] = t1 * c - t2 * s; v[1][n] = t1 * s + t2 * c;
                    }
                    if (isk) {
#pragma unroll
                        for (int n = 0; n < 2; ++n) { v[0][n] = v[0][n] * 0.0625f; v[1][n] = v[1][n] * 0.0625f; }
                    }
                } else if (pn < 8) {
#pragma unroll
                    for (int bj = 0; bj < 2; ++bj)
#pragma unroll
                        for (int n = 0; n < 2; ++n) v[bj][n] = v[bj][n] * QA_SCALE;
                } else if (pn >= 34 && pn < 42) {
#pragma unroll
                    for (int bj = 0; bj < 2; ++bj)
#pragma unroll
                        for (int n = 0; n < 2; ++n)
#pragma unroll
                            for (int i = 0; i < 4; ++i) v[bj][n][i] = siluf_(v[bj][n][i]);
                } else if (pn >= 42) {
#pragma unroll
                    for (int bj = 0; bj < 2; ++bj)
#pragma unroll
                        for (int n = 0; n < 2; ++n)
#pragma unroll
                            for (int i = 0; i < 4; ++i) v[bj][n][i] = sigmoidf_(v[bj][n][i]);
                }
                bf16* rowp = P + (size_t)row * NPROJ + pn * BM + cl;
#pragma unroll
                for (int bj = 0; bj < 2; ++bj) {
                    u32x4 w; w.x = cvt_pk_bf16(v[bj][0][0], v[bj][0][1]); w.y = cvt_pk_bf16(v[bj][0][2], v[bj][0][3]); w.z = cvt_pk_bf16(v[bj][1][0], v[bj][1][1]); w.w = cvt_pk_bf16(v[bj][1][2], v[bj][1][3]);
                    *(u32x4*)(rowp + bj * HALF) = w;
                }
                if (isk) {
                    const int b = row >> 12, s = row & 4095;
                    const float dk = exp2f((float)(127 - (s & 127)) * lg2);
                    bf16* colp = Krt + ((size_t)(b * 2048 + (pn - 18) * 256 + cl) * 4096 + s);
#pragma unroll
                    for (int bj = 0; bj < 2; ++bj)
#pragma unroll
                        for (int n = 0; n < 2; ++n)
#pragma unroll
                            for (int i = 0; i < 4; ++i) colp[(size_t)(bj * HALF + 4 * n + i) * 4096] = (bf16)f2bf(v[bj][n][i] * dk);
                }
            }
    }
};
struct EpiBranchA {
    static constexpr bool PERM = true, AFTER_DRAIN = false;
    const bf16* P; float* M1;
    __device__ __forceinline__ void operator()(const f32x4 (&acc)[2][2][4][2], const Unit& u, int wr, int wc, int fr, int fq) const {
        const int row0 = u.pm * BM + wr * 64 + fr, col0 = u.pn * BM + wc * 32 + 8 * fq;
#pragma unroll
        for (int ai = 0; ai < 2; ++ai)
#pragma unroll
            for (int m = 0; m < 4; ++m) { const int row = row0 + ai * HALF + m * 16;
#pragma unroll
                for (int bj = 0; bj < 2; ++bj) { const int col = col0 + bj * HALF;
                    const u32x4 g = *(const u32x4*)(P + (size_t)row * NPROJ + C_GA + col);
                    f32x4 o0, o1;
                    o0[0] = bf2f(g.x & 0xffffu) * acc[ai][bj][m][0][0]; o0[1] = bf2f(g.x >> 16) * acc[ai][bj][m][0][1]; o0[2] = bf2f(g.y & 0xffffu) * acc[ai][bj][m][0][2]; o0[3] = bf2f(g.y >> 16) * acc[ai][bj][m][0][3];
                    o1[0] = bf2f(g.z & 0xffffu) * acc[ai][bj][m][1][0]; o1[1] = bf2f(g.z >> 16) * acc[ai][bj][m][1][1]; o1[2] = bf2f(g.w & 0xffffu) * acc[ai][bj][m][1][2]; o1[3] = bf2f(g.w >> 16) * acc[ai][bj][m][1][3];
                    float* op = M1 + (size_t)row * D + col; *(f32x4*)op = o0; *(f32x4*)(op + 4) = o1; } }
    }
};
struct EpiBranchR {
    static constexpr bool PERM = true, AFTER_DRAIN = false;
    const bf16* P; const float* M1; bf16* MG;
    __device__ __forceinline__ void operator()(const f32x4 (&acc)[2][2][4][2], const Unit& u, int wr, int wc, int fr, int fq) const {
        const int row0 = u.pm * BM + wr * 64 + fr, col0 = u.pn * BM + wc * 32 + 8 * fq;
#pragma unroll
        for (int ai = 0; ai < 2; ++ai)
#pragma unroll
            for (int m = 0; m < 4; ++m) { const int row = row0 + ai * HALF + m * 16;
#pragma unroll
                for (int bj = 0; bj < 2; ++bj) { const int col = col0 + bj * HALF;
                    const u32x4 g = *(const u32x4*)(P + (size_t)row * NPROJ + C_GT + col);
                    const float* ip = M1 + (size_t)row * D + col; const f32x4 a0 = *(const f32x4*)ip, a1 = *(const f32x4*)(ip + 4);
                    f32x4 o0, o1;
                    o0[0] = a0[0] + bf2f(g.x & 0xffffu) * acc[ai][bj][m][0][0]; o0[1] = a0[1] + bf2f(g.x >> 16) * acc[ai][bj][m][0][1]; o0[2] = a0[2] + bf2f(g.y & 0xffffu) * acc[ai][bj][m][0][2]; o0[3] = a0[3] + bf2f(g.y >> 16) * acc[ai][bj][m][0][3];
                    o1[0] = a1[0] + bf2f(g.z & 0xffffu) * acc[ai][bj][m][1][0]; o1[1] = a1[1] + bf2f(g.z >> 16) * acc[ai][bj][m][1][1]; o1[2] = a1[2] + bf2f(g.w & 0xffffu) * acc[ai][bj][m][1][2]; o1[3] = a1[3] + bf2f(g.w >> 16) * acc[ai][bj][m][1][3];
                    u32x4 w; w.x = cvt_pk_bf16(o0[0], o0[1]); w.y = cvt_pk_bf16(o0[2], o0[3]); w.z = cvt_pk_bf16(o1[0], o1[1]); w.w = cvt_pk_bf16(o1[2], o1[3]);
                    *(u32x4*)(MG + (size_t)row * D + col) = w; } }
    }
};
struct EpiOut {
    static constexpr bool PERM = false, AFTER_DRAIN = false;
    const float* x; const float* gate1; float* X1;
    __device__ __forceinline__ void operator()(const f32x4 (&acc)[2][2][4][2], const Unit& u, int wr, int wc, int fr, int fq) const {
        const int row0 = u.pm * BM + wr * 64 + fr, col0 = u.pn * BM + wc * 32 + 4 * fq;
        const int b = (u.pm * BM) >> 12;
        f32x4 gv[2][2];
#pragma unroll
        for (int bj = 0; bj < 2; ++bj)
#pragma unroll
            for (int n = 0; n < 2; ++n) gv[bj][n] = *(const f32x4*)(gate1 + (size_t)b * 12288 + col0 + bj * HALF + n * 16);
#pragma unroll
        for (int ai = 0; ai < 2; ++ai)
#pragma unroll
            for (int m = 0; m < 4; ++m) { const size_t off = (size_t)(row0 + ai * HALF + m * 16) * D + col0;
#pragma unroll
                for (int bj = 0; bj < 2; ++bj)
#pragma unroll
                    for (int n = 0; n < 2; ++n) { const f32x4 xv = *(const f32x4*)(x + off + bj * HALF + n * 16);
                        *(f32x4*)(X1 + off + bj * HALF + n * 16) = xv + gv[bj][n] * acc[ai][bj][m][n]; } }
    }
};
struct EpiFfn1 {
    static constexpr bool PERM = true, AFTER_DRAIN = false;
    bf16* HB;
    __device__ __forceinline__ void operator()(const f32x4 (&acc)[2][2][4][2], const Unit& u, int wr, int wc, int fr, int fq) const {
        const int row0 = u.pm * BM + wr * 64 + fr, col0 = (u.pn & 7) * 128 + wc * 32 + 8 * fq;
#pragma unroll
        for (int ai = 0; ai < 2; ++ai)
#pragma unroll
            for (int m = 0; m < 4; ++m) { const int row = row0 + ai * HALF + m * 16;
                float h[8];
#pragma unroll
                for (int n = 0; n < 2; ++n)
#pragma unroll
                    for (int i = 0; i < 4; ++i) h[4 * n + i] = siluf_(acc[ai][0][m][n][i]) * acc[ai][1][m][n][i];
                u32x4 w; w.x = cvt_pk_bf16(h[0], h[1]); w.y = cvt_pk_bf16(h[2], h[3]); w.z = cvt_pk_bf16(h[4], h[5]); w.w = cvt_pk_bf16(h[6], h[7]);
                *(u32x4*)(HB + (size_t)row * EDIM + col0) = w; }
    }
};
struct EpiFfn2 {
    static constexpr bool PERM = true, AFTER_DRAIN = false;
    bf16* Y;
    __device__ __forceinline__ void operator()(const f32x4 (&acc)[2][2][4][2], const Unit& u, int wr, int wc, int fr, int fq) const {
        const int row0 = u.pm * BM + wr * 64 + fr, col0 = (u.pn & 7) * BM + wc * 32 + 8 * fq;
#pragma unroll
        for (int ai = 0; ai < 2; ++ai)
#pragma unroll
            for (int m = 0; m < 4; ++m) { const int row = row0 + ai * HALF + m * 16;
#pragma unroll
                for (int bj = 0; bj < 2; ++bj) {
                    u32x4 w; w.x = cvt_pk_bf16(acc[ai][bj][m][0][0], acc[ai][bj][m][0][1]); w.y = cvt_pk_bf16(acc[ai][bj][m][0][2], acc[ai][bj][m][0][3]);
                    w.z = cvt_pk_bf16(acc[ai][bj][m][1][0], acc[ai][bj][m][1][1]); w.w = cvt_pk_bf16(acc[ai][bj][m][1][2], acc[ai][bj][m][1][3]);
                    *(u32x4*)(Y + (size_t)row * D + col0 + bj * HALF) = w; } }
    }
};
struct MoeOrder {
    const LAS int* blk_e; int nblk, NT, G, c;
    __device__ __forceinline__ bool next(int i, Unit& u) const {
        const int L = i * G + c; if (L >= nblk * NT) return false;
        const int blk = L / NT, j = L - blk * NT; u.pm = blk; u.pn = blk_e[blk] * NT + j; return true;
    }
    __device__ __forceinline__ void a_ready(const Unit&) const {}
    __device__ __forceinline__ void done(const Unit&) const {}
};
}


namespace moe {
constexpr int MT = 320, NIB = MT / 64, BK = 64, A_STAGE = MT * BK * 2, B_STAGE = 128 * BK * 2;
constexpr int LDS_A = 0, LDS_B = 3 * A_STAGE;
typedef float f32x2 __attribute__((ext_vector_type(2)));
template <int KIND, bool NOMMA = false, bool NOLOAD = false>
__device__ __forceinline__ void tile(LAS unsigned char* lds, const unsigned char* Abase, const unsigned (&arow)[5], const float* W0, const float* W1, int ldw,
                                     int nblk16, int mrows, bf16* Out, int ldo, int tid) {
    constexpr int NK = (KIND == 1) ? 32 : 16;
    const int lane = tid & 63, wave = __builtin_amdgcn_readfirstlane(tid >> 6), wm = wave & 3, wn = wave >> 2, fr = lane & 15, fq = lane >> 4;
    const int fo = pg8::lds_byte(fr, fq * 8);
    const float* bbase; unsigned bvoff; int n0, kc;
    if (KIND == 1) { const int mat = wave & 1, kq = wave >> 1, kg = lane >> 4, cq = lane & 15;
        bbase = (mat ? W1 : W0) + (size_t)(16 * kq) * ldw; bvoff = (unsigned)((4 * kg * ldw + 4 * cq) * 4);
        n0 = 64 * ((4 * cq) >> 5) + 32 * mat + ((4 * cq) & 31); kc = 16 * kq + 4 * kg; }
    else { const int kg = lane >> 5, cq = lane & 31;
        bbase = W0 + (size_t)(8 * wave) * ldw; bvoff = (unsigned)((4 * kg * ldw + 4 * cq) * 4); n0 = 4 * cq; kc = 8 * wave + 4 * kg; }
    int bw[4];
#pragma unroll
    for (int c = 0; c < 4; ++c) bw[c] = pg8::lds_byte(n0 + c, kc);
    const unsigned ldsw = (unsigned)wave * 1024u;
    const __amdgpu_buffer_rsrc_t brsrc = __builtin_amdgcn_make_buffer_rsrc((void*)bbase, (short)0, 0x7ffffff0, 0x00020000);
    const __amdgpu_buffer_rsrc_t arsrc = __builtin_amdgcn_make_buffer_rsrc((void*)Abase, (short)0, 0x7ffffff0, 0x00020000);
    f32x4 acc[NIB][4];
#pragma unroll
    for (int a = 0; a < NIB; ++a)
#pragma unroll
        for (int b = 0; b < 4; ++b) acc[a][b] = (f32x4){0.f, 0.f, 0.f, 0.f};
    f32x4 breg[4][4];
#define MOE_DMA1(kt, st, p) do { if (!NOLOAD) __builtin_amdgcn_raw_ptr_buffer_load_lds(arsrc, (LAS unsigned*)(lds + LDS_A + (st) * A_STAGE + ((p) >> 1) * 16384 + ((p) & 1) * 8192 + ldsw), 16, arow[p], (unsigned)(kt) * (unsigned)(BK * 2), 0, 0); } while (0)
#define MOE_DMA_A(kt, st) do { MOE_DMA1(kt, st, 0); MOE_DMA1(kt, st, 1); MOE_DMA1(kt, st, 2); MOE_DMA1(kt, st, 3); MOE_DMA1(kt, st, 4); } while (0)
#define MOE_LD1(kt, set, j) do { if (NOLOAD) breg[set][j] = (f32x4){1.f, 2.f, 3.f, 4.f}; else breg[set][j] = __builtin_bit_cast(f32x4, __builtin_amdgcn_raw_buffer_load_b128(brsrc, bvoff, (unsigned)(((kt) * BK + (j)) * ldw * 4), 2)); } while (0)
#define MOE_LD_B(kt, set) do { MOE_LD1(kt, set, 0); MOE_LD1(kt, set, 1); MOE_LD1(kt, set, 2); MOE_LD1(kt, set, 3); } while (0)
#define MOE_CVT_B(set, st) do { _Pragma("unroll") for (int _c = 0; _c < 4; ++_c) { v2u _o; _o.x = pg8::cvt_pk_bf16(breg[set][0][_c], breg[set][1][_c]); _o.y = pg8::cvt_pk_bf16(breg[set][2][_c], breg[set][3][_c]); \
        *(LAS v2u*)(lds + LDS_B + (st) * B_STAGE + bw[_c]) = _o; } } while (0)
#define MOE_FR(st, sa, ks) do { if (!NOMMA) { _Pragma("unroll") for (int _nb = 0; _nb < 4; ++_nb) bfr[_nb] = *(const LAS bf16x8*)(lds + LDS_B + (st) * B_STAGE + (4 * wn + _nb) * 2048 + (ks) * 1024 + fo); \
        _Pragma("unroll") for (int _ib = 0; _ib < NIB; ++_ib) afr[_ib] = *(const LAS bf16x8*)(lds + LDS_A + (sa) * A_STAGE + (wm + 4 * _ib) * 2048 + (ks) * 1024 + fo); } } while (0)
#define MOE_BLK(ib) do { if (!NOMMA) { _Pragma("unroll") for (int _nb = 0; _nb < 4; ++_nb) acc[ib][_nb] = __builtin_amdgcn_mfma_f32_16x16x32_bf16(bfr[_nb], afr[ib], acc[ib][_nb], 0, 0, 0); } } while (0)
#define MOE_STEP(kt, u, DO_LD, DO_DMA, DO_NEXT, WAITIMM) do { bf16x8 bfr[4], afr[NIB]; \
        if (DO_NEXT) MOE_CVT_B(((u) + 1) & 3, ((u) + 1) & 1); \
        MOE_FR((u) & 1, sa0, 0); \
        MOE_BLK(0); if (DO_DMA) MOE_DMA1((kt) + 2, sa2, 0); \
        MOE_BLK(1); if (DO_DMA) MOE_DMA1((kt) + 2, sa2, 1); \
        MOE_BLK(2); if (DO_DMA) MOE_DMA1((kt) + 2, sa2, 2); \
        MOE_BLK(3); if (DO_DMA) MOE_DMA1((kt) + 2, sa2, 3); \
        MOE_BLK(4); if (DO_DMA) MOE_DMA1((kt) + 2, sa2, 4); \
        MOE_FR((u) & 1, sa0, 1); \
        MOE_BLK(0); if (DO_LD) MOE_LD1((kt) + 4, (u), 0); \
        MOE_BLK(1); if (DO_LD) MOE_LD1((kt) + 4, (u), 1); \
        MOE_BLK(2); if (DO_LD) MOE_LD1((kt) + 4, (u), 2); \
        MOE_BLK(3); if (DO_LD) MOE_LD1((kt) + 4, (u), 3); \
        MOE_BLK(4); \
        __builtin_amdgcn_s_waitcnt(WAITIMM); \
        asm volatile("" ::: "memory"); __builtin_amdgcn_s_barrier(); asm volatile("" ::: "memory"); \
        { const int _t = sa0; sa0 = sa1; sa1 = sa2; sa2 = _t; } } while (0)
    int sa0 = 0, sa1 = 1, sa2 = 2;
    MOE_DMA_A(0, 0); MOE_DMA_A(1, 1); MOE_LD_B(0, 0); MOE_LD_B(1, 1); MOE_LD_B(2, 2); MOE_LD_B(3, 3);
    __builtin_amdgcn_s_waitcnt(0x0F74);
    MOE_CVT_B(0, 0);
    __builtin_amdgcn_s_waitcnt(0x0074);
    asm volatile("" ::: "memory"); __builtin_amdgcn_s_barrier(); asm volatile("" ::: "memory");
#pragma unroll 1
    for (int kt = 0; kt < NK - 4; kt += 4) { MOE_STEP(kt, 0, true, true, true, 0x007D); MOE_STEP(kt + 1, 1, true, true, true, 0x007D); MOE_STEP(kt + 2, 2, true, true, true, 0x007D); MOE_STEP(kt + 3, 3, true, true, true, 0x007D); }
    MOE_STEP(NK - 4, 0, false, true, true, 0x0079);
    MOE_STEP(NK - 3, 1, false, true, true, 0x0075);
    MOE_STEP(NK - 2, 2, false, false, true, 0x0070);
    MOE_STEP(NK - 1, 3, false, false, false, 0x0070);
#undef MOE_DMA1
#undef MOE_DMA_A
#undef MOE_LD1
#undef MOE_LD_B
#undef MOE_CVT_B
#undef MOE_BLK
#undef MOE_FR
#undef MOE_STEP
#pragma unroll
    for (int ib = 0; ib < NIB; ++ib) {
        const int row = 16 * (wm + 4 * ib) + fr;
        if (!NOMMA && row < mrows) {
            bf16* op = Out + (size_t)row * ldo;
            if (KIND == 1) {
#pragma unroll
                for (int nb = 0; nb < 2; ++nb) { float h[4];
#pragma unroll
                    for (int i = 0; i < 4; ++i) h[i] = siluf_(acc[ib][nb][i]) * acc[ib][nb + 2][i];
                    v2u w; w.x = pg8::cvt_pk_bf16(h[0], h[1]); w.y = pg8::cvt_pk_bf16(h[2], h[3]);
                    *(GAS v2u*)(op + 32 * wn + 16 * nb + 4 * fq) = w; }
            } else {
#pragma unroll
                for (int nb = 0; nb < 4; ++nb) { v2u w; w.x = pg8::cvt_pk_bf16(acc[ib][nb][0], acc[ib][nb][1]); w.y = pg8::cvt_pk_bf16(acc[ib][nb][2], acc[ib][nb][3]);
                    *(GAS v2u*)(op + 64 * wn + 16 * nb + 4 * fq) = w; }
            }
        }
    }
}
}


namespace moe2 {
constexpr int MT = 320, BK = 64, A_STAGE = MT * BK * 2, B_STAGE = 128 * BK * 2;
constexpr int LDS_A = 0, LDS_B = 3 * A_STAGE;
template <int KIND, class RowFn>
__device__ __forceinline__ void tile(LAS unsigned char* lds, const unsigned char* Abase, const RowFn& arowfn, const float* W0, const float* W1, int ldw,
                                     int nblk16, int mrows, bf16* Out, int ldo, int tid) {
    constexpr int NK = (KIND == 1) ? 32 : 16;
    const int lane = tid & 63, wave = __builtin_amdgcn_readfirstlane(tid >> 6);
    if (wave >= 4) {
        const int lw = wave - 4, ltid = tid - 256;
        unsigned arow[10];
#pragma unroll
        for (int q = 0; q < 10; ++q) { int R, C; pg8::stage_rc(ltid * 16 + (q & 3) * 4096, R, C); arow[q] = arowfn((q >> 2) * 128 + R) + (unsigned)(C * 2); }
        const float* bbase; unsigned bvoff; int n0, kc;
        if (KIND == 1) { const int mat = lw & 1, kh = lw >> 1, kg = lane >> 4, cq = lane & 15;
            bbase = (mat ? W1 : W0) + (size_t)(32 * kh) * ldw; bvoff = (unsigned)((8 * kg * ldw + 4 * cq) * 4);
            n0 = 64 * ((4 * cq) >> 5) + 32 * mat + ((4 * cq) & 31); kc = 32 * kh + 8 * kg; }
        else { const int kg = lane >> 5, cq = lane & 31;
            bbase = W0 + (size_t)(16 * lw) * ldw; bvoff = (unsigned)((8 * kg * ldw + 4 * cq) * 4); n0 = 4 * cq; kc = 16 * lw + 8 * kg; }
        int bw[4];
#pragma unroll
        for (int c = 0; c < 4; ++c) bw[c] = pg8::lds_byte(n0 + c, kc);
        const unsigned ldsw = (unsigned)lw * 1024u;
        f32x4 breg[4][8];
#define M2_DMA1(kt, st, q) __builtin_amdgcn_global_load_lds((const unsigned*)(Abase + (size_t)(arow[q] + (unsigned)(kt) * (unsigned)(BK * 2))), (LAS unsigned*)(lds + LDS_A + (st) * A_STAGE + ((q) >> 2) * 16384 + ((q) & 3) * 4096 + ldsw), 16, 0, 0)
#define M2_DMA_A(kt, st) do { M2_DMA1(kt, st, 0); M2_DMA1(kt, st, 1); M2_DMA1(kt, st, 2); M2_DMA1(kt, st, 3); M2_DMA1(kt, st, 4); M2_DMA1(kt, st, 5); M2_DMA1(kt, st, 6); M2_DMA1(kt, st, 7); M2_DMA1(kt, st, 8); M2_DMA1(kt, st, 9); } while (0)
#define M2_LD_B(kt, set) do { _Pragma("unroll") for (int _j = 0; _j < 8; ++_j) breg[set][_j] = __builtin_nontemporal_load((const GAS f32x4*)((const char*)(bbase + (size_t)((kt) * BK + _j) * ldw) + bvoff)); } while (0)
#define M2_CVT_B(set, st) do { _Pragma("unroll") for (int _c = 0; _c < 4; ++_c) { v4u _o; _o.x = pg8::cvt_pk_bf16(breg[set][0][_c], breg[set][1][_c]); _o.y = pg8::cvt_pk_bf16(breg[set][2][_c], breg[set][3][_c]); \
        _o.z = pg8::cvt_pk_bf16(breg[set][4][_c], breg[set][5][_c]); _o.w = pg8::cvt_pk_bf16(breg[set][6][_c], breg[set][7][_c]); *(LAS v4u*)(lds + LDS_B + (st) * B_STAGE + bw[_c]) = _o; } } while (0)
#define M2_LSTEP(kt, u, DO_LD, DO_DMA, DO_NEXT, WAITIMM) do { \
        if (DO_NEXT) M2_CVT_B(((u) + 1) & 3, ((u) + 1) & 1); \
        if (DO_DMA) M2_DMA_A((kt) + 2, sa2); \
        if (DO_LD) M2_LD_B((kt) + 4, (u)); \
        __builtin_amdgcn_s_waitcnt(WAITIMM); \
        asm volatile("" ::: "memory"); __builtin_amdgcn_s_barrier(); asm volatile("" ::: "memory"); \
        { const int _t = sa0; sa0 = sa1; sa1 = sa2; sa2 = _t; } } while (0)
        int sa0 = 0, sa1 = 1, sa2 = 2;
        M2_DMA_A(0, 0); M2_DMA_A(1, 1); M2_LD_B(0, 0); M2_LD_B(1, 1); M2_LD_B(2, 2); M2_LD_B(3, 3);
        __builtin_amdgcn_s_waitcnt(0x0F78);
        M2_CVT_B(0, 0);
        __builtin_amdgcn_s_waitcnt(0x0078);
        asm volatile("" ::: "memory"); __builtin_amdgcn_s_barrier(); asm volatile("" ::: "memory");
#pragma unroll 1
        for (int kt = 0; kt < NK - 4; kt += 4) { M2_LSTEP(kt, 0, true, true, true, 0x407A); M2_LSTEP(kt + 1, 1, true, true, true, 0x407A); M2_LSTEP(kt + 2, 2, true, true, true, 0x407A); M2_LSTEP(kt + 3, 3, true, true, true, 0x407A); }
        M2_LSTEP(NK - 4, 0, false, true, true, 0x4072);
        M2_LSTEP(NK - 3, 1, false, true, true, 0x007A);
        M2_LSTEP(NK - 2, 2, false, false, true, 0x0070);
        M2_LSTEP(NK - 1, 3, false, false, false, 0x0070);
#undef M2_DMA1
#undef M2_DMA_A
#undef M2_LD_B
#undef M2_CVT_B
#undef M2_LSTEP
    } else {
        const int wm = wave & 1, wn = wave >> 1, fr = lane & 15, fq = lane >> 4;
        const int fo = pg8::lds_byte(fr, fq * 8);
        f32x4 acc[10][4];
#pragma unroll
        for (int a = 0; a < 10; ++a)
#pragma unroll
            for (int b = 0; b < 4; ++b) acc[a][b] = (f32x4){0.f, 0.f, 0.f, 0.f};
        int sa0 = 0, sa1 = 1, sa2 = 2;
        __builtin_amdgcn_s_barrier(); asm volatile("" ::: "memory");
#pragma unroll 1
        for (int kt = 0; kt < NK; ++kt) {
            const LAS unsigned char* Ab = lds + LDS_A + sa0 * A_STAGE + fo; const LAS unsigned char* Bb = lds + LDS_B + (kt & 1) * B_STAGE + (4 * wn) * 2048 + fo;
#pragma unroll
            for (int ks = 0; ks < 2; ++ks) { bf16x8 bfr[4];
#pragma unroll
                for (int nb = 0; nb < 4; ++nb) bfr[nb] = *(const LAS bf16x8*)(Bb + nb * 2048 + ks * 1024);
#pragma unroll
                for (int ib = 0; ib < 10; ++ib) if (wm + 2 * ib < nblk16) { const bf16x8 a = *(const LAS bf16x8*)(Ab + (wm + 2 * ib) * 2048 + ks * 1024);
#pragma unroll
                    for (int nb = 0; nb < 4; ++nb) acc[ib][nb] = __builtin_amdgcn_mfma_f32_16x16x32_bf16(bfr[nb], a, acc[ib][nb], 0, 0, 0); } }
            __builtin_amdgcn_s_waitcnt(0xC07F);
            asm volatile("" ::: "memory"); __builtin_amdgcn_s_barrier(); asm volatile("" ::: "memory");
            { const int t = sa0; sa0 = sa1; sa1 = sa2; sa2 = t; }
        }
#pragma unroll
        for (int ib = 0; ib < 10; ++ib) {
            const int row = 16 * (wm + 2 * ib) + fr;
            if (row < mrows) {
                bf16* op = Out + (size_t)row * ldo;
                if (KIND == 1) {
#pragma unroll
                    for (int nb = 0; nb < 2; ++nb) { float h[4];
#pragma unroll
                        for (int i = 0; i < 4; ++i) h[i] = siluf_(acc[ib][nb][i]) * acc[ib][nb + 2][i];
                        v2u w; w.x = pg8::cvt_pk_bf16(h[0], h[1]); w.y = pg8::cvt_pk_bf16(h[2], h[3]);
                        *(GAS v2u*)(op + 32 * wn + 16 * nb + 4 * fq) = w; }
                } else {
#pragma unroll
                    for (int nb = 0; nb < 4; ++nb) { v2u w; w.x = pg8::cvt_pk_bf16(acc[ib][nb][0], acc[ib][nb][1]); w.y = pg8::cvt_pk_bf16(acc[ib][nb][2], acc[ib][nb][3]);
                        *(GAS v2u*)(op + 64 * wn + 16 * nb + 4 * fq) = w; }
                }
            }
        }
    }
}
}

__device__ __forceinline__ void transpose_item(const float* W, int K, int N, int k0, int n0, bf16* dst  , LAS float* scr, int lane) {
#pragma unroll 8
    for (int i = 0; i < 32; ++i) { const int kk = 2 * i + (lane >> 5); scr[kk * 33 + (lane & 31)] = W[(size_t)(k0 + kk) * N + n0 + (lane & 31)]; }
    LDS_WAIT();
    const int c = lane & 7;
#pragma unroll
    for (int j = 0; j < 4; ++j) { const int n = (lane >> 3) + 8 * j; const LAS float* s = scr + (8 * c) * 33 + n;
        v4u o; o.x = pk2(s[0 * 33], s[1 * 33]); o.y = pk2(s[2 * 33], s[3 * 33]); o.z = pk2(s[4 * 33], s[5 * 33]); o.w = pk2(s[6 * 33], s[7 * 33]);
        *(GAS v4u*)(dst + (size_t)n * K + k0 + 8 * c) = o; }
    LDS_WAIT();
}

__global__ void __launch_bounds__(NTHR, 2) fwd_kernel(Args args) {
    extern __shared__ __attribute__((aligned(16))) unsigned char lds_raw[];
    LAS unsigned char* lds = (LAS unsigned char*)lds_raw;
    volatile LAS unsigned* MISC = (volatile LAS unsigned*)(lds + MISC_OFF);
    const int tid = threadIdx.x, lane = tid & 63, wave = __builtin_amdgcn_readfirstlane(tid >> 6);
    const int G = gridDim.x, bid = blockIdx.x;
    unsigned char* ws = args.ws;
    gu32* ctl = (gu32*)(ws + WS_CTL);
    const int lo = args.ph_lo, hi = args.ph_hi;

    const float* x = (const float*)args.in[0];
    const float* cvec = (const float*)args.in[1];
    const int* positions = (const int*)args.in[2];
    const float* norm1_gain = (const float*)args.in[3];
    const float* norm2_gain = (const float*)args.in[4];
    const float* final_gain = (const float*)args.in[5];
    const float* w_ada = (const float*)args.in[6];
    const float* b_ada = (const float*)args.in[7];
    const float* w_in = (const float*)args.in[8];
    const float* attn_sinks = (const float*)args.in[9];
    const float* ret_gain = (const float*)args.in[10];
    const float* w_ba = (const float*)args.in[11];
    const float* w_br = (const float*)args.in[12];
    const float* w_out = (const float*)args.in[13];
    const float* w_rg = (const float*)args.in[14];
    const float* b_rg = (const float*)args.in[15];
    const float* w_re = (const float*)args.in[16];
    const float* b_re = (const float*)args.in[17];
    const float* w_eg = (const float*)args.in[18];
    const float* w_eu = (const float*)args.in[19];
    const float* w_ed = (const float*)args.in[20];

    float* mod = (float*)(ws + WS_MOD);
    float* cosT = (float*)(ws + WS_ROPE); float* sinT = cosT + (size_t)T * 128;
    bf16* Win_t = (bf16*)(ws + WS_WIN); bf16* Wba_t = (bf16*)(ws + WS_WBA); bf16* Wbr_t = (bf16*)(ws + WS_WBR); bf16* Wout_t = (bf16*)(ws + WS_WOUT);
    bf16* Wrt = (bf16*)(ws + WS_WRT);
    bf16* Hb = (bf16*)(ws + WS_H);
    float* X1 = (float*)(ws + WS_X1);
    bf16* P = (bf16*)(ws + WS_P);
    bf16* Vta = (bf16*)(ws + WS_VTA); bf16* Vtr = (bf16*)(ws + WS_VTR); bf16* Krt = (bf16*)(ws + WS_KRT);
    float* SC = (float*)(ws + WS_SC); bf16* ST = (bf16*)(ws + WS_ST);
    bf16* ATT = (bf16*)(ws + WS_ATTN); bf16* RET = (bf16*)(ws + WS_RET);
    float* M1 = (float*)(ws + WS_M1); bf16* MG = (bf16*)(ws + WS_MERGED);
    bf16* HB = (bf16*)(ws + WS_HB); bf16* YB = (bf16*)(ws + WS_Y);
    int* rowtok = (int*)(ws + WS_RTOK);
    int* route = (int*)(ws + WS_ROUTE);
    gu32* ecnt = ctl + CW_CNT;

    for (int u = tid; u < MISC_BYTES / 4; u += NTHR) ((LAS unsigned*)(lds + MISC_OFF))[u] = 0u;
    __syncthreads();
    XcdBarrier bar = xcd_barrier_post((unsigned*)(ctl + CW_BAR) + args.bar_region * XCD_BAR_WORDS, MISC + 8);

#define IN(k) (lo <= (k) && (k) < hi)
#define SEAM(k) do { if (IN(k) && IN((k) + 1)) xcd_barrier(bar); } while (0)

    if (IN(0)) {
        {
            LAS float* sc = (LAS float*)lds;
            LAS float* red = (LAS float*)(lds + 16384);
            bool have = false;
            for (int it = bid; it < 192; it += G) {
                if (!have) { for (int i = tid; i < 2 * D; i += NTHR) sc[i] = siluf_(cvec[i]); have = true; __syncthreads(); }
                const int n0 = it * 64, cg = tid & 15, rg = tid >> 4;
                f32x4 a0 = {0.f, 0.f, 0.f, 0.f}, a1 = {0.f, 0.f, 0.f, 0.f};
                for (int k = rg; k < D; k += 32) { const f32x4 w = *(const GAS f32x4*)(w_ada + (size_t)k * 12288 + n0 + 4 * cg); a0 += w * sc[k]; a1 += w * sc[D + k]; }
#pragma unroll
                for (int i = 0; i < 4; ++i) { red[tid * 8 + i] = a0[i]; red[tid * 8 + 4 + i] = a1[i]; }
                __syncthreads();
                if (tid < 128) { const int b = tid >> 6, col = tid & 63, cgi = col >> 2, ci = col & 3; float s = 0.f;
                    for (int r = 0; r < 32; ++r) s += red[(r * 16 + cgi) * 8 + b * 4 + ci];
                    mod[b * 12288 + n0 + col] = s + b_ada[n0 + col]; }
                __syncthreads();
            }
            __syncthreads();
        }
        for (int i = bid * NTHR + tid; i < T * 128; i += G * NTHR) {
            const int tok = i >> 7, f = i & 127;
            const double inv = exp2(-(double)f * (13.287712379549449 / 128.0));
            double rv = (double)positions[tok] * inv * 0.15915494309189535;
            rv -= floor(rv);
            const float rf = (float)rv;
            cosT[i] = __builtin_amdgcn_cosf(rf); sinT[i] = __builtin_amdgcn_sinf(rf);
        }
        for (int i = bid * NTHR + tid; i < 80 * D; i += G * NTHR) {
            const int n = i >> 11, k = i & 2047; float v = 0.f;
            if (n < 64) v = w_re[(size_t)k * 64 + n]; else if (n < 68) v = w_rg[(size_t)k * 4 + (n - 64)];
            Wrt[i] = (bf16)f2bf(v);
        }
        {
            LAS float* scr = (LAS float*)(lds + 32768 + wave * 8704);
            const int gw = bid * NWAVES + wave, NGW = G * NWAVES;
            constexpr int I_IN = 32 * (NPROJ / 32), I_SQ = 32 * 64;
            constexpr int NIT = I_IN + 3 * I_SQ;
            for (int it = gw; it < NIT; it += NGW) {
                int r = it;
                if (r < I_IN) { const int nb = NPROJ / 32, kb = r / nb, n0 = (r % nb) * 32; transpose_item(w_in, D, NPROJ, kb * 64, n0, Win_t + (size_t)n0 * D, scr, lane); continue; } r -= I_IN;
                { const int w = r / I_SQ; r -= w * I_SQ; const int kb = r / 64, n0 = (r % 64) * 32;
                    const float* src = w == 0 ? w_ba : (w == 1 ? w_br : w_out); bf16* dst = w == 0 ? Wba_t : (w == 1 ? Wbr_t : Wout_t);
                    transpose_item(src, D, D, kb * 64, n0, dst + (size_t)n0 * D, scr, lane); }
            }
        }
    }
    SEAM(0);

    if (IN(1)) {
        const int gw = bid * NWAVES + wave, NGW = G * NWAVES;
        for (int row = gw; row < T; row += NGW) {
            const int b = row >> 12;
            const GAS f32x4* xr = (const GAS f32x4*)(x + (size_t)row * D) + lane;
            f32x4 v[8]; float ss = 0.f;
#pragma unroll
            for (int j = 0; j < 8; ++j) { v[j] = xr[64 * j]; ss += (v[j].x * v[j].x + v[j].y * v[j].y) + (v[j].z * v[j].z + v[j].w * v[j].w); }
            const float r = 1.0f / sqrtf(wave_sum(ss) * (1.0f / D) + EPS);
            GAS v2u* o8 = (GAS v2u*)(Hb + (size_t)row * D) + lane;
#pragma unroll
            for (int j = 0; j < 8; ++j) { const int k = 4 * lane + 256 * j;
                const f32x4 g = *(const GAS f32x4*)(norm1_gain + k), sh = *(const GAS f32x4*)(mod + b * 12288 + k), scl = *(const GAS f32x4*)(mod + b * 12288 + 2048 + k);
                const f32x4 hv = v[j] * r * g * (scl + 1.0f) + sh;
                v2u o; o.x = pk2(hv.x, hv.y); o.y = pk2(hv.z, hv.w); o8[64 * j] = o; }
        }
    }
    SEAM(1);

    if (IN(2)) {
        pg8::Gemm g{Hb, Win_t, T, NPROJ, D}; pg8::StaticOrder S; S.init(T, NPROJ, G, bid);
        pg8::EpiProj E{P, Vta, Vtr, Krt, cosT, sinT};
        pg8::gemm_phase<pg8::EpiProj, pg8::StaticOrder, true, true>(lds, g, S, E);
    }
    SEAM(2);

    if (IN(3)) {
        const int r16 = lane & 15, q4 = lane >> 4;
        for (int unit = bid; unit < 256 + 512; unit += G) {
            if (unit < 256) {
                const int b = unit >> 7, kvh = (unit >> 5) & 3, nb = unit & 31, head = kvh * 8 + wave;
                const float sink2 = attn_sinks[head] * LOG2E;
                const int tq0 = nb * 128, ks = (nb - 1) * 128;
                const bf16* Qb = P + (size_t)(b * SEQ + tq0) * NPROJ + C_QA + head * 64;
                const bf16* Kb = P + (size_t)(b * SEQ) * NPROJ + C_KA + kvh * 64;
                const bf16* Vb = Vta + (size_t)(b * 256 + kvh * 64) * 4096;
                LAS bf16* Kl = (LAS bf16*)lds;
                LAS bf16* Vl = (LAS bf16*)(lds + 36864);
                LAS bf16* Pl = (LAS bf16*)(lds + 70656 + wave * 5376);
#pragma unroll
                for (int j = 0; j < 4; ++j) { const int p = tid + 512 * j, row = p >> 3, ch = p & 7; int tk = ks + row; tk = tk < 0 ? 0 : tk;
                    *(LAS v4u*)(Kl + row * 72 + ch * 8) = *(const GAS v4u*)(Kb + (size_t)tk * NPROJ + ch * 8); }
#pragma unroll
                for (int j = 0; j < 4; ++j) { const int p = tid + 512 * j, row = p >> 5, ch = p & 31; int tk0 = ks + 8 * ch; tk0 = tk0 < 0 ? 8 * ch : tk0;
                    *(LAS v4u*)(Vl + row * 264 + ch * 8) = *(const GAS v4u*)(Vb + (size_t)row * 4096 + tk0); }
                __syncthreads();
                for (int t = 0; t < 8; ++t) {
                    bf16x8 qa[2];
#pragma unroll
                    for (int s = 0; s < 2; ++s) qa[s] = ldg8(Qb + (size_t)(16 * t + r16) * NPROJ + 32 * s + 8 * q4);
                    f32x4 sc[10];
#pragma unroll
                    for (int n = 0; n < 10; ++n) {
                        const int kb = (t + n) < 16 ? (t + n) : 15;
                        f32x4 a = {0.f, 0.f, 0.f, 0.f};
#pragma unroll
                        for (int s = 0; s < 2; ++s) a = mma16(qa[s], *(const LAS bf16x8*)(Kl + (16 * kb + r16) * 72 + 32 * s + 8 * q4), a);
                        sc[n] = a;
                    }
                    float sm[4];
#pragma unroll
                    for (int reg = 0; reg < 4; ++reg) {
                        const int tq = tq0 + 16 * t + 4 * q4 + reg; float m = -INFINITY;
#pragma unroll
                        for (int n = 0; n < 10; ++n) { const int tk = ks + 16 * (t + n) + r16; const bool ok = (t + n < 16) && (tk >= 0) && (tk <= tq) && (tk + 128 > tq);
                            sc[n][reg] = ok ? sc[n][reg] : -INFINITY; m = fmaxf(m, sc[n][reg]); }
                        m = fmaxf(max16(m), sink2); float s = 0.f;
#pragma unroll
                        for (int n = 0; n < 10; ++n) { const float p = exp2f(sc[n][reg] - m); sc[n][reg] = p; s += p; }
                        sm[reg] = 1.0f / (sum16(s) + exp2f(sink2 - m));
                    }
#pragma unroll
                    for (int n = 0; n < 10; ++n)
#pragma unroll
                        for (int reg = 0; reg < 4; ++reg) Pl[(4 * q4 + reg) * 168 + 16 * n + r16] = (bf16)f2bf(sc[n][reg] * sm[reg]);
                    LDS_WAIT();
                    f32x4 o[4];
#pragma unroll
                    for (int nd = 0; nd < 4; ++nd) o[nd] = (f32x4){0.f, 0.f, 0.f, 0.f};
#pragma unroll
                    for (int s = 0; s < 5; ++s) {
                        const bf16x8 pa = *(const LAS bf16x8*)(Pl + r16 * 168 + 32 * s + 8 * q4);
                        const int n = 2 * s + (q4 >> 1); const int kb = (t + n) < 16 ? (t + n) : 15;
#pragma unroll
                        for (int nd = 0; nd < 4; ++nd) o[nd] = mma16(*(const LAS bf16x8*)(Vl + (16 * nd + r16) * 264 + 16 * kb + 8 * (q4 & 1)), pa, o[nd]);
                    }
#pragma unroll
                    for (int nd = 0; nd < 4; ++nd) { v2u w; w.x = pk2(o[nd][0], o[nd][1]); w.y = pk2(o[nd][2], o[nd][3]);
                        *(GAS v2u*)(ATT + (size_t)(b * SEQ + tq0 + 16 * t + r16) * D + head * 64 + 16 * nd + 4 * q4) = w; }
                    LDS_WAIT();
                }
                __syncthreads();
            } else {
                const int u = unit - 256, bh = u >> 5, c = u & 31, b = bh >> 3, h = bh & 7;
                const bf16* Ag = Vtr + (size_t)(b * 2048 + h * 256) * 4096 + c * 128;
                const bf16* Bg = Krt + (size_t)(b * 2048 + h * 256) * 4096 + c * 128;
                LAS bf16* Al = (LAS bf16*)lds;
                LAS bf16* Bl = (LAS bf16*)(lds + 69632);
#pragma unroll
                for (int j = 0; j < 8; ++j) { const int p = tid + 512 * j, row = p >> 4, ch = p & 15;
                    *(LAS v4u*)(Al + row * 136 + ch * 8) = *(const GAS v4u*)(Ag + (size_t)row * 4096 + ch * 8);
                    *(LAS v4u*)(Bl + row * 136 + ch * 8) = *(const GAS v4u*)(Bg + (size_t)row * 4096 + ch * 8); }
                __syncthreads();
#pragma unroll 1
                for (int nh = 0; nh < 2; ++nh) {
                    f32x4 acc[2][8];
#pragma unroll
                    for (int m = 0; m < 2; ++m)
#pragma unroll
                        for (int n = 0; n < 8; ++n) acc[m][n] = (f32x4){0.f, 0.f, 0.f, 0.f};
#pragma unroll
                    for (int s = 0; s < 4; ++s) {
                        bf16x8 a[2];
#pragma unroll
                        for (int m = 0; m < 2; ++m) a[m] = *(const LAS bf16x8*)(Al + (32 * wave + 16 * m + r16) * 136 + 32 * s + 8 * q4);
#pragma unroll
                        for (int n = 0; n < 8; ++n) { const bf16x8 bb = *(const LAS bf16x8*)(Bl + (128 * nh + 16 * n + r16) * 136 + 32 * s + 8 * q4);
                            acc[0][n] = mma16(bb, a[0], acc[0][n]); acc[1][n] = mma16(bb, a[1], acc[1][n]); }
                    }
                    float* out = SC + (size_t)u * 65536;
#pragma unroll
                    for (int m = 0; m < 2; ++m)
#pragma unroll
                        for (int n = 0; n < 8; ++n) *(GAS f32x4*)(out + (size_t)(32 * wave + 16 * m + r16) * 256 + 128 * nh + 16 * n + 4 * q4) = acc[m][n];
                }
                __syncthreads();
            }
        }
    }
    SEAM(3);

    if (IN(4)) {
        for (int i = bid * NTHR + tid; i < 16 * 16384; i += G * NTHR) {
            const int bh = i >> 14, e4 = i & 16383, h = bh & 7;
            const float dc = expf(128.0f * log1pf(-exp2f(-5.0f - (float)h)));
            f32x4 st = {0.f, 0.f, 0.f, 0.f};
            for (int c = 0; c < 32; ++c) {
                const size_t off = (size_t)(bh * 32 + c) * 65536 + 4 * e4;
                v2u o; o.x = pk2(st.x, st.y); o.y = pk2(st.z, st.w); *(GAS v2u*)(ST + off) = o;
                const f32x4 s = *(const GAS f32x4*)(SC + off);
                st = st * dc + s;
            }
        }
    }
    SEAM(4);

    if (IN(5)) {
        const int r16 = lane & 15, q4 = lane >> 4;
        for (int u = bid; u < 512; u += G) {
            const int bh = u >> 5, c = u & 31, b = bh >> 3, h = bh & 7;
            const float lg2 = log1pf(-exp2f(-5.0f - (float)h)) * LOG2E;
            const int tok0 = b * SEQ + c * 128;
            const bf16* Qg = P + (size_t)tok0 * NPROJ + C_QR + h * 256;
            const bf16* Kg = P + (size_t)tok0 * NPROJ + C_KR + h * 256;
            const bf16* Vg = Vtr + (size_t)(b * 2048 + h * 256 + 32 * wave) * 4096 + c * 128;
            const bf16* Sg = ST + (size_t)u * 65536 + (size_t)(32 * wave) * 256;
            LAS bf16* Kl = (LAS bf16*)lds;
            LAS bf16* Il = (LAS bf16*)lds;
            LAS bf16* Ql = (LAS bf16*)(lds + 67584);
            LAS float* red = (LAS float*)(lds + 135168);
#pragma unroll
            for (int j = 0; j < 8; ++j) { const int p = tid + 512 * j, row = p >> 5, ch = p & 31;
                *(LAS v4u*)(Kl + row * 264 + ch * 8) = *(const GAS v4u*)(Kg + (size_t)row * NPROJ + ch * 8);
                *(LAS v4u*)(Ql + row * 264 + ch * 8) = *(const GAS v4u*)(Qg + (size_t)row * NPROJ + ch * 8); }
            __syncthreads();
            f32x4 sc[8];
            {
                bf16x8 qa[8];
#pragma unroll
                for (int s = 0; s < 8; ++s) qa[s] = *(const LAS bf16x8*)(Ql + (16 * wave + r16) * 264 + 32 * s + 8 * q4);
#pragma unroll
                for (int n = 0; n < 8; ++n) {
                    f32x4 a = {0.f, 0.f, 0.f, 0.f};
                    if (n <= wave) {
#pragma unroll
                        for (int s = 0; s < 8; ++s) a = mma16(qa[s], *(const LAS bf16x8*)(Kl + (16 * n + r16) * 264 + 32 * s + 8 * q4), a);
                    }
#pragma unroll
                    for (int reg = 0; reg < 4; ++reg) { const int df = (16 * wave + 4 * q4 + reg) - (16 * n + r16); a[reg] = df >= 0 ? a[reg] * exp2f((float)df * lg2) : 0.f; }
                    sc[n] = a;
                }
            }
            __syncthreads();
#pragma unroll
            for (int n = 0; n < 8; ++n)
#pragma unroll
                for (int reg = 0; reg < 4; ++reg) Il[(16 * wave + 4 * q4 + reg) * 136 + 16 * n + r16] = (bf16)f2bf(sc[n][reg]);
            __syncthreads();
            f32x4 O1[8][2];
#pragma unroll
            for (int qb = 0; qb < 8; ++qb)
#pragma unroll
                for (int n2 = 0; n2 < 2; ++n2) O1[qb][n2] = (f32x4){0.f, 0.f, 0.f, 0.f};
#pragma unroll
            for (int s = 0; s < 8; ++s) {
                bf16x8 sf[2];
#pragma unroll
                for (int n2 = 0; n2 < 2; ++n2) sf[n2] = ldg8(Sg + (size_t)(16 * n2 + r16) * 256 + 32 * s + 8 * q4);
#pragma unroll
                for (int qb = 0; qb < 8; ++qb) { const bf16x8 qf = *(const LAS bf16x8*)(Ql + (16 * qb + r16) * 264 + 32 * s + 8 * q4);
                    O1[qb][0] = mma16(sf[0], qf, O1[qb][0]); O1[qb][1] = mma16(sf[1], qf, O1[qb][1]); }
            }
#pragma unroll
            for (int qb = 0; qb < 8; ++qb) { const float dq = exp2f((float)(16 * qb + r16 + 1) * lg2);
#pragma unroll
                for (int n2 = 0; n2 < 2; ++n2) O1[qb][n2] = O1[qb][n2] * dq; }
#pragma unroll
            for (int s = 0; s < 4; ++s) {
                bf16x8 vf[2];
#pragma unroll
                for (int n2 = 0; n2 < 2; ++n2) vf[n2] = ldg8(Vg + (size_t)(16 * n2 + r16) * 4096 + 32 * s + 8 * q4);
#pragma unroll
                for (int qb = 0; qb < 8; ++qb) if (2 * s <= qb) { const bf16x8 pf = *(const LAS bf16x8*)(Il + (16 * qb + r16) * 136 + 32 * s + 8 * q4);
                    O1[qb][0] = mma16(vf[0], pf, O1[qb][0]); O1[qb][1] = mma16(vf[1], pf, O1[qb][1]); }
            }
#pragma unroll
            for (int qb = 0; qb < 8; ++qb) { float ss = 0.f;
#pragma unroll
                for (int n2 = 0; n2 < 2; ++n2)
#pragma unroll
                    for (int reg = 0; reg < 4; ++reg) { const float v = O1[qb][n2][reg]; ss += v * v; }
                ss += __shfl_xor(ss, 16); ss += __shfl_xor(ss, 32);
                if (q4 == 0) red[(16 * qb + r16) * 8 + wave] = ss; }
            __syncthreads();
#pragma unroll
            for (int qb = 0; qb < 8; ++qb) { const int q = 16 * qb + r16; float tot = 0.f;
#pragma unroll
                for (int w2 = 0; w2 < 8; ++w2) tot += red[q * 8 + w2];
                const float rs = 1.0f / sqrtf(tot * (1.0f / 256.0f) + EPS);
                const size_t tok = (size_t)(tok0 + q);
#pragma unroll
                for (int n2 = 0; n2 < 2; ++n2) { const int ch = h * 256 + 32 * wave + 16 * n2 + 4 * q4;
                    const f32x4 gn = *(const GAS f32x4*)(ret_gain + ch); const v2u sg = *(const GAS v2u*)(P + tok * NPROJ + C_GR + ch);
                    const float o0 = O1[qb][n2][0] * rs * gn[0] * bf2f(sg.x & 0xffffu), o1 = O1[qb][n2][1] * rs * gn[1] * bf2f(sg.x >> 16);
                    const float o2 = O1[qb][n2][2] * rs * gn[2] * bf2f(sg.y & 0xffffu), o3 = O1[qb][n2][3] * rs * gn[3] * bf2f(sg.y >> 16);
                    v2u w; w.x = pk2(o0, o1); w.y = pk2(o2, o3); *(GAS v2u*)(RET + tok * D + ch) = w; } }
            __syncthreads();
        }
    }
    SEAM(5);

    if (IN(6)) {
        { pg8::Gemm g{ATT, Wba_t, T, D, D}; pg8::StaticOrder S; S.init(T, D, G, bid); pg8::EpiBranchA E{P, M1};
          pg8::gemm_phase<pg8::EpiBranchA, pg8::StaticOrder, true, true>(lds, g, S, E); }
        VM_WAIT(); __syncthreads();
        { pg8::Gemm g{RET, Wbr_t, T, D, D}; pg8::StaticOrder S; S.init(T, D, G, bid); pg8::EpiBranchR E{P, M1, MG};
          pg8::gemm_phase<pg8::EpiBranchR, pg8::StaticOrder, true, true>(lds, g, S, E); }
    }
    SEAM(6);

    if (IN(7)) {
        pg8::Gemm g{MG, Wout_t, T, D, D}; pg8::StaticOrder S; S.init(T, D, G, bid); pg8::EpiOut E{x, mod + 2 * 2048, X1};
        pg8::gemm_phase<pg8::EpiOut, pg8::StaticOrder, true, true>(lds, g, S, E);
    }
    SEAM(7);

    if (IN(8)) {
        const int r16 = lane & 15, q4 = lane >> 4;
        LAS bf16* Al = (LAS bf16*)lds;
        LAS float* Lg = (LAS float*)(lds + RING_BYTES);
        for (int t0 = bid * 32; t0 < T; t0 += G * 32) {
            for (int rr = 0; rr < 4; ++rr) {
                const int lrow = 4 * wave + rr, row = t0 + lrow, b = row >> 12;
                const GAS f32x4* xr = (const GAS f32x4*)(X1 + (size_t)row * D) + lane;
                f32x4 v[8]; float ss = 0.f;
#pragma unroll
                for (int j = 0; j < 8; ++j) { v[j] = xr[64 * j]; ss += (v[j].x * v[j].x + v[j].y * v[j].y) + (v[j].z * v[j].z + v[j].w * v[j].w); }
                const float r = 1.0f / sqrtf(wave_sum(ss) * (1.0f / D) + EPS);
                GAS v2u* o8 = (GAS v2u*)(Hb + (size_t)row * D) + lane;
#pragma unroll
                for (int j = 0; j < 8; ++j) { const int k = 4 * lane + 256 * j;
                    const f32x4 g = *(const GAS f32x4*)(norm2_gain + k), sh = *(const GAS f32x4*)(mod + b * 12288 + 3 * 2048 + k), scl = *(const GAS f32x4*)(mod + b * 12288 + 4 * 2048 + k);
                    const f32x4 hv = v[j] * r * g * (scl + 1.0f) + sh;
                    v2u o; o.x = pk2(hv.x, hv.y); o.y = pk2(hv.z, hv.w); o8[64 * j] = o;
                    *(LAS v2u*)(Al + lrow * 2048 + k) = o; }
            }
            __syncthreads();
            if (wave < 5) {
                f32x4 a0 = {0.f, 0.f, 0.f, 0.f}, a1 = {0.f, 0.f, 0.f, 0.f};
                const bf16* Bb = Wrt + (size_t)(16 * wave + r16) * D + 8 * q4;
                for (int s = 0; s < 64; ++s) {
                    const bf16x8 bb = ldg8(Bb + 32 * s);
                    const bf16x8 x0 = *(const LAS bf16x8*)(Al + r16 * 2048 + 32 * s + 8 * q4), x1v = *(const LAS bf16x8*)(Al + (16 + r16) * 2048 + 32 * s + 8 * q4);
                    a0 = mma16(x0, bb, a0); a1 = mma16(x1v, bb, a1);
                }
#pragma unroll
                for (int reg = 0; reg < 4; ++reg) { Lg[(4 * q4 + reg) * 80 + 16 * wave + r16] = a0[reg]; Lg[(16 + 4 * q4 + reg) * 80 + 16 * wave + r16] = a1[reg]; }
            }
            __syncthreads();
            if (tid < 32) {
                const int row = t0 + tid; const LAS float* L = Lg + tid * 80;
                float gl[4]; int gs = 0;
#pragma unroll
                for (int j = 0; j < 4; ++j) gl[j] = L[64 + j] + b_rg[j];
#pragma unroll
                for (int j = 1; j < 4; ++j) if (gl[j] > gl[gs]) gs = j;
                float den = 0.f;
#pragma unroll
                for (int j = 0; j < 4; ++j) den += expf(gl[j] - gl[gs]);
                const float gw = 1.0f / den;
                int i0 = 0; float v0 = -INFINITY;
                for (int j = 0; j < 16; ++j) { const float v = L[gs * 16 + j] + b_re[gs * 16 + j]; if (v > v0) { v0 = v; i0 = j; } }
                int i1 = 0; float v1 = -INFINITY;
                for (int j = 0; j < 16; ++j) { const float v = L[gs * 16 + j] + b_re[gs * 16 + j]; if (j != i0 && v > v1) { v1 = v; i1 = j; } }
                const float e1 = expf(v1 - v0); const float w0 = gw / (1.0f + e1), w1 = gw * e1 / (1.0f + e1);
                const int ex0 = gs * 16 + i0, ex1 = gs * 16 + i1;
                const int p0 = (int)__hip_atomic_fetch_add(ecnt + ex0, 1u, RLX_AGENT), p1 = (int)__hip_atomic_fetch_add(ecnt + ex1, 1u, RLX_AGENT);
                int* rt = route + (size_t)row * 8;
                rt[0] = ex0; rt[1] = p0; rt[2] = ex1; rt[3] = p1; rt[4] = __builtin_bit_cast(int, w0); rt[5] = __builtin_bit_cast(int, w1);
                rowtok[ex0 * 8192 + p0] = row; rowtok[ex1 * 8192 + p1] = row;
            }
            __syncthreads();
        }
    }
    SEAM(8);

    LAS int* ecl = (LAS int*)(lds + MISC_OFF + 1024);
    LAS int* bstart = (LAS int*)(lds + MISC_OFF + 1536);
    LAS int* ptab = (LAS int*)(lds + MISC_OFF + 2048);
    LAS int* npass_p = (LAS int*)(lds + MISC_OFF + 2560);
    if (hi > 9 && lo <= 12) {
        if (tid == 0) { int nb = 0, np = 0;
            for (int e = 0; e < NEXP; ++e) { const int cnt = (int)__hip_atomic_load(ecnt + e, RLX_AGENT); ecl[e] = cnt; bstart[e] = nb; nb += cnt;
                for (int q = 0; q * moe::MT < cnt; ++q) ptab[np++] = e | (q << 8); }
            npass_p[0] = np; }
        __syncthreads();
    }
    const int vwg = (G & 7) == 0 ? (bid & 7) * (G >> 3) + (bid >> 3) : bid;

    if (IN(10)) {
        const int nitem = npass_p[0] * 16;
        for (int I = vwg; I < nitem; I += G) {
            const int pe = ptab[I >> 4], j = I & 15, e = pe & 255, p0 = (pe >> 8) * moe::MT;
            const int Me = ecl[e], rb = bstart[e];
            const int mrows = (Me - p0) < moe::MT ? (Me - p0) : moe::MT;
            unsigned arow[5];
#pragma unroll
            for (int q = 0; q < 5; ++q) { int R, C; pg8::stage_rc(tid * 16 + (q & 1) * 8192, R, C); int rr = p0 + (q >> 1) * 128 + R; rr = rr < Me ? rr : Me - 1;
                arow[q] = (unsigned)rowtok[e * 8192 + rr] * (unsigned)(D * 2) + (unsigned)(C * 2); }
            moe::tile<1>(lds, (const unsigned char*)Hb, arow, w_eg + (size_t)e * D * EDIM + j * 64, w_eu + (size_t)e * D * EDIM + j * 64, EDIM,
                         (mrows + 15) >> 4, mrows, HB + (size_t)(rb + p0) * EDIM + j * 64, EDIM, tid);
        }
    }
    SEAM(10);

    if (IN(11)) {
        const int nitem = npass_p[0] * 16;
        for (int I = vwg; I < nitem; I += G) {
            const int pe = ptab[I >> 4], j = I & 15, e = pe & 255, p0 = (pe >> 8) * moe::MT;
            const int Me = ecl[e], rb = bstart[e];
            const int mrows = (Me - p0) < moe::MT ? (Me - p0) : moe::MT;
            unsigned arow[5];
#pragma unroll
            for (int q = 0; q < 5; ++q) { int R, C; pg8::stage_rc(tid * 16 + (q & 1) * 8192, R, C); int rr = p0 + (q >> 1) * 128 + R; rr = rr < Me ? rr : Me - 1;
                arow[q] = (unsigned)(rb + rr) * (unsigned)(EDIM * 2) + (unsigned)(C * 2); }
            moe::tile<2>(lds, (const unsigned char*)HB, arow, w_ed + (size_t)e * EDIM * D + j * 128, nullptr, D,
                         (mrows + 15) >> 4, mrows, YB + (size_t)(rb + p0) * D + j * 128, D, tid);
        }
    }
    SEAM(11);

    if (IN(12)) {
        const int gw = bid * NWAVES + wave, NGW = G * NWAVES;
        for (int row = gw; row < T; row += NGW) {
            const int b = row >> 12; const int* rt = route + (size_t)row * 8;
            const int r0 = bstart[rt[0]] + rt[1], r1 = bstart[rt[2]] + rt[3];
            const float w0 = __builtin_bit_cast(float, rt[4]), w1 = __builtin_bit_cast(float, rt[5]);
            const GAS f32x4* xr = (const GAS f32x4*)(X1 + (size_t)row * D) + lane;
            const GAS v2u* y0 = (const GAS v2u*)(YB + (size_t)r0 * D) + lane; const GAS v2u* y1 = (const GAS v2u*)(YB + (size_t)r1 * D) + lane;
            f32x4 v[8]; float ss = 0.f;
#pragma unroll
            for (int j = 0; j < 8; ++j) { const int k = 4 * lane + 256 * j;
                const f32x4 g2 = *(const GAS f32x4*)(mod + b * 12288 + 5 * 2048 + k);
                const v2u a = y0[64 * j], bq = y1[64 * j];
                f32x4 f; f.x = w0 * bf2f(a.x & 0xffffu) + w1 * bf2f(bq.x & 0xffffu); f.y = w0 * bf2f(a.x >> 16) + w1 * bf2f(bq.x >> 16);
                f.z = w0 * bf2f(a.y & 0xffffu) + w1 * bf2f(bq.y & 0xffffu); f.w = w0 * bf2f(a.y >> 16) + w1 * bf2f(bq.y >> 16);
#ifdef DBG_SKIP_MOE
                v[j] = xr[64 * j];
#else
                v[j] = xr[64 * j] + g2 * f;
#endif
                ss += (v[j].x * v[j].x + v[j].y * v[j].y) + (v[j].z * v[j].z + v[j].w * v[j].w); }
            const float r = 1.0f / sqrtf(wave_sum(ss) * (1.0f / D) + EPS);
            GAS f32x4* o = (GAS f32x4*)(args.out + (size_t)row * D) + lane;
#pragma unroll
            for (int j = 0; j < 8; ++j) { const f32x4 g = *(const GAS f32x4*)(final_gain + 4 * lane + 256 * j); o[64 * j] = v[j] * r * g; }
        }
    }
#undef IN
#undef SEAM
}


#ifdef DBG_TAP
__global__ void tap_kernel(unsigned char* ws, float* out, int mode) {
    const bf16* Hb = (const bf16*)(ws + WS_H); const bf16* P = (const bf16*)(ws + WS_P);
    const bf16* Vta = (const bf16*)(ws + WS_VTA); const bf16* Vtr = (const bf16*)(ws + WS_VTR); const bf16* Krt = (const bf16*)(ws + WS_KRT);
    const float* SC = (const float*)(ws + WS_SC); const bf16* ST = (const bf16*)(ws + WS_ST);
    const bf16* ATT = (const bf16*)(ws + WS_ATTN); const bf16* RET = (const bf16*)(ws + WS_RET); const bf16* MG = (const bf16*)(ws + WS_MERGED);
    const float* X1 = (const float*)(ws + WS_X1); const float* mod = (const float*)(ws + WS_MOD);
    for (size_t i = (size_t)blockIdx.x * blockDim.x + threadIdx.x; i < (size_t)T * D; i += (size_t)gridDim.x * blockDim.x) {
        const int row = (int)(i >> 11), c = (int)(i & 2047), b = row >> 12, s = row & 4095; float v = 0.f;
        if (mode == 0) v = mod[(i % 24576)];
        if (mode == 1) v = bf2f(Hb[i]);
        if (mode == 2) { v = bf2f(P[(size_t)row * NPROJ + c]) + bf2f(P[(size_t)row * NPROJ + C_QR + c]) + bf2f(P[(size_t)row * NPROJ + C_KR + c]) + bf2f(P[(size_t)row * NPROJ + C_GR + c]) + bf2f(P[(size_t)row * NPROJ + C_GA + c]) + bf2f(P[(size_t)row * NPROJ + C_GT + c])
                 + bf2f(P[(size_t)row * NPROJ + C_KA + (c & 255)]) + bf2f(Vtr[(size_t)(b * 2048 + c) * 4096 + s]) + bf2f(Krt[(size_t)(b * 2048 + c) * 4096 + s]) + bf2f(Vta[(size_t)(b * 256 + (c & 255)) * 4096 + s]); }
        if (mode == 3) { v = bf2f(ATT[i]); for (int j = 0; j < 4; ++j) v += SC[i * 4 + j] * 0.01f; }
        if (mode == 4) { for (int j = 0; j < 2; ++j) v += bf2f(ST[i * 2 + j]); }
        if (mode == 5) v = bf2f(RET[i]);
        if (mode == 6) v = bf2f(MG[i]);
        if (mode == 7) v = X1[i];
        out[i] = v;
    }
}
#endif

#ifdef DBG_STREAM
__global__ void __launch_bounds__(512, 2) probe_stream(const float* w_eg, const float* w_eu, float* dump, const bf16* hb) {
    const int tid = threadIdx.x, lane = tid & 63, wave = tid >> 6, bid = blockIdx.x, G = gridDim.x;
    f32x4 s = {0.f, 0.f, 0.f, 0.f};
    for (int L = bid; L < 1024; L += G) {
        const int lx = L & 7, li = (L >> 3) & 31, r = L >> 8; const int e = 8 * lx + 2 * r + (li >> 4), j = li & 15;
        const int mat = wave & 1, kq = wave >> 1, kg = lane >> 4, cq = lane & 15;
        const float* base = (mat ? w_eu : w_eg) + (size_t)e * D * EDIM + j * 64 + (size_t)(16 * kq + 4 * kg) * EDIM + 4 * cq;
#if DBG_STREAM == 2
        { extern __shared__ __attribute__((aligned(16))) unsigned char plds[]; unsigned arow[5];
#pragma unroll
          for (int q = 0; q < 5; ++q) { int R, C; pg8::stage_rc(tid * 16 + (q & 1) * 8192, R, C); const int rr = (q >> 1) * 128 + R; arow[q] = (unsigned)(((e * 131 + rr * 7 + j) & 8191)) * 4096u + (unsigned)(C * 2); }
          moe::tile<1, DBG_NOMMA, DBG_NOLOAD>((LAS unsigned char*)plds, (const unsigned char*)hb, arow, w_eg + (size_t)e * D * EDIM + j * 64, w_eu + (size_t)e * D * EDIM + j * 64, EDIM, 17, 272, (bf16*)dump + (size_t)bid * 320 * 1024, 1024, tid); }
#endif
#if DBG_STREAM == 1
        for (int kt = 0; kt < 32; kt += DBG_DEPTH) {
            f32x4 v[DBG_DEPTH][4];
#pragma unroll
            for (int t = 0; t < DBG_DEPTH; ++t)
#pragma unroll
                for (int q = 0; q < 4; ++q) v[t][q] = __builtin_nontemporal_load((const GAS f32x4*)(base + (size_t)((kt + t) * 64 + q) * EDIM));
#pragma unroll
            for (int t = 0; t < DBG_DEPTH; ++t)
#pragma unroll
                for (int q = 0; q < 4; ++q) s += v[t][q];
        }
#endif
    }
    if (s.x + s.y + s.z + s.w == 12345.678f) dump[tid] = s.x;
}
#endif
constexpr int NPHASES = 13;
#ifndef MK_ONE_LAUNCH
#define MK_ONE_LAUNCH 0
#endif
extern "C" void kernel_launch(void* const* d_in, const int* in_sizes, int n_in, void* d_out, int out_size, void* d_ws, size_t ws_size, hipStream_t stream) {
    static int grid = 0;
    if (grid == 0) {
        if (n_in != 21 || out_size != T * D || ws_size < WS_END) { fprintf(stderr, "kernel_launch: unexpected shapes (n_in %d out %d ws %zu)\n", n_in, out_size, ws_size); grid = -1; return; }
        int dev = 0, cus = 0, per_cu = 0;
        if (hipGetDevice(&dev) != hipSuccess || hipDeviceGetAttribute(&cus, hipDeviceAttributeMultiprocessorCount, dev) != hipSuccess) { grid = -1; return; }
        if (hipFuncSetAttribute((const void*)fwd_kernel, hipFuncAttributeMaxDynamicSharedMemorySize, LDS_BYTES) != hipSuccess) { fprintf(stderr, "kernel_launch: hipFuncSetAttribute failed\n"); grid = -1; return; }
        if (hipOccupancyMaxActiveBlocksPerMultiprocessor(&per_cu, (const void*)fwd_kernel, NTHR, LDS_BYTES) != hipSuccess || per_cu < 1) { fprintf(stderr, "kernel_launch: occupancy query says %d\n", per_cu); }
        (void)hipGetLastError();
        grid = cus;
    }
    if (grid < 0) return;
    if (hipMemsetAsync((char*)d_ws + WS_CTL, 0, CTL_ZERO_BYTES, stream) != hipSuccess) return;
    Args a{};
    for (int i = 0; i < 21; ++i) a.in[i] = d_in[i];
    a.out = (float*)d_out; a.ws = (unsigned char*)d_ws;
#if MK_ONE_LAUNCH
#ifdef DBG_REP
    a.ph_lo = 0; a.ph_hi = DBG_REP_HI + 1; a.bar_region = 0; hipLaunchKernelGGL(fwd_kernel, dim3(grid), dim3(NTHR), LDS_BYTES, stream, a);
    a.ph_lo = DBG_REP; a.ph_hi = DBG_REP_HI + 1; a.bar_region = 1; hipLaunchKernelGGL(fwd_kernel, dim3(grid), dim3(NTHR), LDS_BYTES, stream, a);
    if (DBG_REP_HI + 1 < NPHASES) { a.ph_lo = DBG_REP_HI + 1; a.ph_hi = NPHASES; a.bar_region = 2; hipLaunchKernelGGL(fwd_kernel, dim3(grid), dim3(NTHR), LDS_BYTES, stream, a); }
#else
    a.ph_lo = 0; a.ph_hi = NPHASES;
    hipLaunchKernelGGL(fwd_kernel, dim3(grid), dim3(NTHR), LDS_BYTES, stream, a);
#ifdef DBG_STREAM
    { static bool once = false; if (!once) { once = true; (void)hipFuncSetAttribute((const void*)probe_stream, hipFuncAttributeMaxDynamicSharedMemorySize, LDS_BYTES); }
      hipLaunchKernelGGL(probe_stream, dim3(grid), dim3(512), (DBG_STREAM == 2 ? LDS_BYTES : 0), stream, (const float*)d_in[18], (const float*)d_in[19], (float*)((char*)d_ws + WS_END), (const bf16*)((char*)d_ws + WS_H)); }
#endif
#endif
#else
#ifdef DBG_TAP
    for (int p = 0; p <= DBG_TAP; ++p) { a.ph_lo = p; a.ph_hi = p + 1; hipLaunchKernelGGL(fwd_kernel, dim3(grid), dim3(NTHR), LDS_BYTES, stream, a); }
    hipLaunchKernelGGL(tap_kernel, dim3(2048), dim3(256), 0, stream, (unsigned char*)d_ws, (float*)d_out, (int)DBG_TAPMODE);
#else
    for (int p = 0; p < NPHASES; ++p) { a.ph_lo = p; a.ph_hi = p + 1; hipLaunchKernelGGL(fwd_kernel, dim3(grid), dim3(NTHR), LDS_BYTES, stream, a); }
#endif
#endif
}
```

```cpp
#define MK_ONE_LAUNCH 1
#include <hip/hip_runtime.h>
#include <cstdio>
#include <cstdint>
#include <cmath>
namespace pg8 {
#define PG8_LAS __attribute__((address_space(3)))
typedef unsigned short bf16_t;
typedef short bf16x8 __attribute__((ext_vector_type(8)));
typedef float f32x4 __attribute__((ext_vector_type(4)));
typedef unsigned u32x4 __attribute__((ext_vector_type(4)));
constexpr int BM = 256, BK = 64, HALF = 128, HTB = HALF * BK * 2  , STAGE_BYTES = 8 * HTB, NXCD = 8, WGM = 8;

__host__ __device__ __forceinline__ int lds_byte(int r, int c) { const int st = (r >> 4) * 2 + (c >> 5), rr = r & 15, cc = c & 31, ob = rr * 64 + cc * 2; return st * 1024 + (ob ^ (((ob >> 9) & 1) << 5)); }
__host__ __device__ __forceinline__ void stage_rc(int b, int& R, int& C) { const int st = b / 1024, sb = b % 1024, swz = sb ^ (((sb >> 9) & 1) << 5); R = (st >> 1) * 16 + swz / 64; C = (st & 1) * 32 + (swz % 64) / 2; }
__host__ __device__ __forceinline__ int perm32(int rho) { const int n = rho >> 4, i = rho & 15; return 8 * (i >> 2) + 4 * n + (i & 3); }

struct Unit { int pm, pn; };
struct Gemm { const bf16_t* A; const bf16_t* Bt; int M, N, K; };

struct StaticOrder {
    int nM, nN, nwg, G, c, wgm;
    __host__ __device__ void init(int M, int N, int G_, int c_, int wgm_ = WGM) { nM = M / BM; nN = N / BM; nwg = nM * nN; G = G_; c = c_; wgm = wgm_; }
    __host__ __device__ bool next(int i, Unit& u) const {
        const long L = (long)i * G + c; if (L >= nwg) return false;
        int wgid = (int)L; { const int q = nwg / NXCD, r = nwg % NXCD, xcd = wgid % NXCD, off = wgid / NXCD; wgid = (xcd < r ? xcd * (q + 1) : r * (q + 1) + (xcd - r) * q) + off; }
        const int nig = wgm * nN, gid = wgid / nig, fm = gid * wgm, gsz = (nM - fm) < wgm ? (nM - fm) : wgm;
        u.pm = fm + ((wgid % nig) % gsz); u.pn = (wgid % nig) / gsz; return true;
    }
    __device__ __forceinline__ void a_ready(const Unit&) const {}
    __device__ __forceinline__ void done(const Unit&) const {}
};

typedef float cvt_f32x2_t __attribute__((ext_vector_type(2))); typedef __bf16 cvt_bf16x2_t __attribute__((ext_vector_type(2)));
__device__ __forceinline__ unsigned cvt_pk_bf16(float lo, float hi) { cvt_f32x2_t v = {lo, hi}; cvt_bf16x2_t b = __builtin_convertvector(v, cvt_bf16x2_t); return __builtin_bit_cast(unsigned, b); }
template <class Epi, class Sched, bool ALIGN_EPI = false, bool SP2 = false>
__device__ __forceinline__ void gemm_phase(PG8_LAS unsigned char* lds, const Gemm g, const Sched& S, const Epi& E) {
    const int tid = threadIdx.x, wid = __builtin_amdgcn_readfirstlane(tid >> 6), lane = tid & 63, wr = wid >> 2, wc = wid & 3, fr = lane & 15, fq = lane >> 4;
    const int K = g.K, nt = K / BK;
    unsigned voffA[2], voffB[2];
#pragma unroll
    for (int i = 0; i < 2; ++i) { int R, C; stage_rc(tid * 16 + i * 8192, R, C); const int Rb = Epi::PERM ? ((R & ~31) + perm32(R & 31)) : R;
        voffA[i] = (unsigned)(R * K + C) * 2u; voffB[i] = (unsigned)(Rb * K + C) * 2u; }
    const size_t kstep = (size_t)(BK * 2);
    const size_t hstep = (size_t)HALF * K * 2;
    const size_t tstep = 2 * hstep;
    const unsigned ldsw = (unsigned)wid * 1024u;
    const int aoff = lds_byte(wr * 64 + fr, fq * 8), boff = lds_byte(wc * 32 + fr, fq * 8);
#define PG8_SA(b, h) (((b) * 2 + (h)) * HTB)
#define PG8_SB(b, h) ((4 + (b) * 2 + (h)) * HTB)
#define PG8_STAGE(bufoff, gbase, voff) do { _Pragma("unroll") for (int _i = 0; _i < 2; ++_i) \
        __builtin_amdgcn_global_load_lds((const unsigned*)((const char*)(gbase) + (voff)[_i]), (PG8_LAS unsigned*)(lds + (bufoff) + ldsw + _i * 8192), 16, 0, 0); } while (0)
#define PG8_LDA(dst, b, h) do { _Pragma("unroll") for (int m = 0; m < 4; ++m) _Pragma("unroll") for (int k = 0; k < 2; ++k) dst[m][k] = *(const PG8_LAS bf16x8*)(lds + PG8_SA(b, h) + aoff + m * 2048 + k * 1024); } while (0)
#define PG8_LDB(dst, b, h) do { _Pragma("unroll") for (int n = 0; n < 2; ++n) _Pragma("unroll") for (int k = 0; k < 2; ++k) dst[n][k] = *(const PG8_LAS bf16x8*)(lds + PG8_SB(b, h) + boff + n * 2048 + k * 1024); } while (0)
#define PG8_MMA(ai, bj, At, Bt) do { __builtin_amdgcn_s_setprio(1); _Pragma("unroll") for (int m = 0; m < 4; ++m) _Pragma("unroll") for (int n = 0; n < 2; ++n) _Pragma("unroll") for (int k = 0; k < 2; ++k) \
        acc[ai][bj][m][n] = __builtin_amdgcn_mfma_f32_16x16x32_bf16(Bt[n][k], At[m][k], acc[ai][bj][m][n], 0, 0, 0); __builtin_amdgcn_s_setprio(0); } while (0)
#define PG8_WAIT_V(n) asm volatile("s_waitcnt vmcnt(" #n ")" ::: "memory")
#define PG8_WAIT_L(n) asm volatile("s_waitcnt lgkmcnt(" #n ")" ::: "memory")
#define PG8_BAR __builtin_amdgcn_s_barrier()
#define PG8_SCHED __builtin_amdgcn_sched_barrier(0)
    Unit cur, nxt; int ui = 0;
    if (!S.next(0, cur)) return;
    f32x4 acc[2][2][4][2];
#pragma unroll
    for (int a = 0; a < 2; ++a)
#pragma unroll
        for (int b = 0; b < 2; ++b)
#pragma unroll
            for (int m = 0; m < 4; ++m)
#pragma unroll
                for (int n = 0; n < 2; ++n) acc[a][b][m][n] = (f32x4){0.f, 0.f, 0.f, 0.f};
    bf16x8 At[4][2], B0[2][2], B1[2][2];
    const char* cA = (const char*)g.A + (size_t)cur.pm * tstep; const char* cB = (const char*)g.Bt + (size_t)cur.pn * tstep;
    S.a_ready(cur);
    if constexpr (SP2) {
        PG8_STAGE(PG8_SB(0, 0), cB, voffB); PG8_STAGE(PG8_SB(0, 1), cB + hstep, voffB); PG8_STAGE(PG8_SA(0, 0), cA, voffA); PG8_STAGE(PG8_SA(0, 1), cA + hstep, voffA);
        if (wr == 1) PG8_BAR;
        PG8_WAIT_V(2); PG8_BAR;
        PG8_STAGE(PG8_SB(1, 0), cB + kstep, voffB); PG8_STAGE(PG8_SA(1, 0), cA + kstep, voffA); PG8_STAGE(PG8_SB(1, 1), cB + hstep + kstep, voffB);
        PG8_WAIT_V(6); PG8_BAR;
    } else {
        PG8_STAGE(PG8_SB(0, 0), cB, voffB); PG8_STAGE(PG8_SA(0, 0), cA, voffA); PG8_STAGE(PG8_SB(0, 1), cB + hstep, voffB); PG8_STAGE(PG8_SA(0, 1), cA + hstep, voffA);
        if (wr == 1) PG8_BAR;
        PG8_WAIT_V(4); PG8_BAR;
        PG8_STAGE(PG8_SB(1, 0), cB + kstep, voffB); PG8_STAGE(PG8_SA(1, 0), cA + kstep, voffA); PG8_STAGE(PG8_SB(1, 1), cB + hstep + kstep, voffB);
        PG8_WAIT_V(6); PG8_BAR;
    }
    for (;;) {
        const bool has_next = S.next(ui + 1, nxt);
        const char* nA = has_next ? (const char*)g.A + (size_t)nxt.pm * tstep : cA; const char* nB = has_next ? (const char*)g.Bt + (size_t)nxt.pn * tstep : cB;
        for (int t = 0; t < nt; t += 2) {
            const bool last = (t == nt - 2);
            const char* a1 = cA + (size_t)(t + 1) * kstep;
            const char* a2 = last ? nA : cA + (size_t)(t + 2) * kstep; const char* b2 = last ? nB : cB + (size_t)(t + 2) * kstep;
            const char* a3 = a2 + kstep; const char* b3 = b2 + kstep;
            if (last && has_next) S.a_ready(nxt);
            if constexpr (SP2) {
            PG8_LDB(B0, 0, 0); PG8_LDB(B1, 0, 1); PG8_SCHED; PG8_LDA(At, 0, 0); PG8_STAGE(PG8_SA(1, 1), a1 + hstep, voffA);
            PG8_WAIT_V(8); PG8_WAIT_L(0); PG8_BAR; PG8_MMA(0, 0, At, B0); PG8_MMA(0, 1, At, B1); PG8_BAR; PG8_SCHED;
            PG8_LDA(At, 0, 1); PG8_STAGE(PG8_SB(0, 0), b2, voffB); PG8_STAGE(PG8_SB(0, 1), b2 + hstep, voffB); PG8_STAGE(PG8_SA(0, 0), a2, voffA);
            PG8_WAIT_V(8); PG8_WAIT_L(0); PG8_BAR; PG8_MMA(1, 0, At, B0); PG8_MMA(1, 1, At, B1); PG8_BAR; PG8_SCHED;
            PG8_LDB(B0, 1, 0); PG8_LDB(B1, 1, 1); PG8_SCHED; PG8_LDA(At, 1, 0); PG8_STAGE(PG8_SA(0, 1), a2 + hstep, voffA);
            PG8_WAIT_V(8); PG8_WAIT_L(0); PG8_BAR; PG8_MMA(0, 0, At, B0); PG8_MMA(0, 1, At, B1); PG8_BAR; PG8_SCHED;
            PG8_LDA(At, 1, 1); PG8_STAGE(PG8_SB(1, 0), b3, voffB); PG8_STAGE(PG8_SB(1, 1), b3 + hstep, voffB); PG8_STAGE(PG8_SA(1, 0), a3, voffA);
            PG8_WAIT_V(8); PG8_WAIT_L(0); PG8_BAR; PG8_MMA(1, 0, At, B0); PG8_MMA(1, 1, At, B1); PG8_BAR; PG8_SCHED;
            } else {
            PG8_LDB(B0, 0, 0); PG8_SCHED; PG8_LDA(At, 0, 0); PG8_STAGE(PG8_SA(1, 1), a1 + hstep, voffA);
            PG8_WAIT_L(8); PG8_BAR; PG8_WAIT_L(0); PG8_MMA(0, 0, At, B0); PG8_BAR; PG8_SCHED;
            PG8_LDB(B1, 0, 1); PG8_STAGE(PG8_SB(0, 0), b2, voffB);
            PG8_BAR; PG8_WAIT_L(0); PG8_MMA(0, 1, At, B1); PG8_BAR;
            PG8_LDA(At, 0, 1); PG8_STAGE(PG8_SA(0, 0), a2, voffA);
            PG8_BAR; PG8_WAIT_L(0); PG8_MMA(1, 0, At, B0); PG8_BAR; PG8_SCHED;
            PG8_STAGE(PG8_SB(0, 1), b2 + hstep, voffB);
            PG8_WAIT_V(6); PG8_BAR; PG8_MMA(1, 1, At, B1); PG8_BAR;
            PG8_LDB(B0, 1, 0); PG8_SCHED; PG8_LDA(At, 1, 0); PG8_STAGE(PG8_SA(0, 1), a2 + hstep, voffA);
            PG8_WAIT_L(8); PG8_BAR; PG8_WAIT_L(0); PG8_MMA(0, 0, At, B0); PG8_BAR; PG8_SCHED;
            PG8_LDB(B1, 1, 1); PG8_STAGE(PG8_SB(1, 0), b3, voffB);
            PG8_BAR; PG8_WAIT_L(0); PG8_MMA(0, 1, At, B1); PG8_BAR;
            PG8_LDA(At, 1, 1); PG8_STAGE(PG8_SA(1, 0), a3, voffA);
            PG8_BAR; PG8_WAIT_L(0); PG8_MMA(1, 0, At, B0); PG8_BAR; PG8_SCHED;
            PG8_STAGE(PG8_SB(1, 1), b3 + hstep, voffB);
            PG8_WAIT_V(6); PG8_BAR; PG8_MMA(1, 1, At, B1); PG8_BAR;
            }
        }
        if constexpr (ALIGN_EPI) { if (wr == 0) PG8_BAR; }
        if constexpr (!Epi::AFTER_DRAIN) { E(acc, cur, wr, wc, fr, fq); S.done(cur); }
        if (!has_next) break;
#pragma unroll
        for (int a = 0; a < 2; ++a)
#pragma unroll
            for (int b = 0; b < 2; ++b)
#pragma unroll
                for (int m = 0; m < 4; ++m)
#pragma unroll
                    for (int n = 0; n < 2; ++n) acc[a][b][m][n] = (f32x4){0.f, 0.f, 0.f, 0.f};
        cur = nxt; cA = nA; cB = nB; ++ui;
        if constexpr (ALIGN_EPI) { if (wr == 1) PG8_BAR; }
    }
    PG8_WAIT_V(0);
    if constexpr (!ALIGN_EPI) { if (wr == 0) PG8_BAR; }
    PG8_BAR;
    if constexpr (Epi::AFTER_DRAIN) { E.fused(acc, cur, wr, wc, fr, fq, lds, wid, lane); S.done(cur); }
#undef PG8_SA
#undef PG8_SB
#undef PG8_STAGE
#undef PG8_LDA
#undef PG8_LDB
#undef PG8_MMA
#undef PG8_WAIT_V
#undef PG8_WAIT_L
#undef PG8_BAR
#undef PG8_SCHED
}
}

#ifndef WGM_PROJ
#define WGM_PROJ 2
#endif
#ifndef WGM_SQ
#define WGM_SQ 4
#endif
#ifndef GK_ALIGN
#define GK_ALIGN true
#endif
#ifndef GK_ALIGN1
#define GK_ALIGN1 true
#endif
#ifndef GK_SP2
#define GK_SP2 true
#endif
constexpr int NWAVES = 8, NTHR = 512;
constexpr int BATCH = 2, SEQ = 4096, T = BATCH * SEQ, D = 2048;
constexpr int NPROJ = 14848;
constexpr int C_QA = 0, C_KA = 2048, C_VA = 2304, C_QR = 2560, C_KR = 4608, C_VR = 6656, C_GR = 8704, C_GA = 10752, C_GT = 12800;
constexpr int NEXP = 64, EDIM = 1024;
constexpr float EPS = 1e-6f;
constexpr float LOG2E = 1.4426950408889634f;
constexpr float QA_SCALE = 0.125f * LOG2E;

constexpr size_t MiB = 1u << 20;
constexpr size_t WS_CTL = 0, CTL_ZERO_BYTES = 1 * MiB;
constexpr size_t WS_MOD = 1 * MiB;
constexpr size_t WS_ROPE = 2 * MiB;
constexpr size_t WS_WIN = 10 * MiB;
constexpr size_t WS_WBA = 68 * MiB, WS_WBR = 76 * MiB, WS_WOUT = 84 * MiB;
constexpr size_t WS_ROUTE = 92 * MiB;
constexpr size_t WS_WRT = 94 * MiB;
constexpr size_t WS_H = 96 * MiB;
constexpr size_t WS_X1 = 128 * MiB;
constexpr size_t WS_P = 192 * MiB;
constexpr size_t WS_VTA = 424 * MiB;
constexpr size_t WS_VTR = 428 * MiB;
constexpr size_t WS_KRT = 460 * MiB;
constexpr size_t WS_SC = 492 * MiB;
constexpr size_t WS_ST = 620 * MiB;
constexpr size_t WS_ATTN = 684 * MiB;
constexpr size_t WS_RET = 716 * MiB;
constexpr size_t WS_M1 = 748 * MiB;
constexpr size_t WS_MERGED = 812 * MiB;
constexpr size_t WS_XG = 192 * MiB;
constexpr size_t WS_HB = 320 * MiB;
constexpr size_t WS_Y = 384 * MiB;
constexpr size_t WS_RTOK = 848 * MiB;
constexpr size_t WS_END = 850 * MiB;

constexpr int CW_TMO = 0, CW_BAR = 4096, CW_CNT = 16384, CW_PCNT = 20480, CW_QHEAD = 24576;

constexpr int RING_BYTES = 131072;
constexpr int MISC_OFF = 155648;
constexpr int MISC_BYTES = 8192;
constexpr int LDS_BYTES = MISC_OFF + MISC_BYTES;

#define GAS __attribute__((address_space(1)))
#define LAS __attribute__((address_space(3)))
typedef unsigned short bf16;
typedef unsigned v4u __attribute__((ext_vector_type(4)));
typedef unsigned v2u __attribute__((ext_vector_type(2)));
typedef float f32x4 __attribute__((ext_vector_type(4)));
typedef short bf16x8 __attribute__((ext_vector_type(8)));
typedef GAS unsigned gu32;
#define RLX_AGENT __ATOMIC_RELAXED, __HIP_MEMORY_SCOPE_AGENT
#define LDS_WAIT() asm volatile("s_waitcnt lgkmcnt(0)" ::: "memory")
#define VM_WAIT() asm volatile("s_waitcnt vmcnt(0)" ::: "memory")
__device__ __forceinline__ unsigned pk2(float lo, float hi) { return pg8::cvt_pk_bf16(lo, hi); }
__device__ __forceinline__ unsigned f2bf(float f) { return pg8::cvt_pk_bf16(f, f) & 0xffffu; }
__device__ __forceinline__ float bf2f(unsigned b) { return __builtin_bit_cast(float, b << 16); }
__device__ __forceinline__ float wave_sum(float v) {
#pragma unroll
    for (int o = 1; o < 64; o <<= 1) v += __shfl_xor(v, o);
    return v;
}
#define DPP_F(v, ctrl) __builtin_bit_cast(float, __builtin_amdgcn_update_dpp(0, __builtin_bit_cast(int, (v)), (ctrl), 0xF, 0xF, true))
__device__ __forceinline__ float sum16(float v) { v += DPP_F(v, 0xB1); v += DPP_F(v, 0x4E); v += DPP_F(v, 0x141); v += DPP_F(v, 0x140); return v; }
__device__ __forceinline__ float max16(float v) { v = fmaxf(v, DPP_F(v, 0xB1)); v = fmaxf(v, DPP_F(v, 0x4E)); v = fmaxf(v, DPP_F(v, 0x141)); v = fmaxf(v, DPP_F(v, 0x140)); return v; }
__device__ __forceinline__ float sigmoidf_(float x) { return __builtin_amdgcn_rcpf(1.0f + __builtin_amdgcn_exp2f(-1.4426950408889634f * x)); }
__device__ __forceinline__ float siluf_(float x) { return x * sigmoidf_(x); }

#define XB_TMO      128
#define XB_XCNT(j)  (256  + 64 * (j))
#define XB_XSUB(j)  (1280 + 64 * (j))
#define XB_XGEN(j)  (2304 + 64 * (j))
#define XB_TOP      3328
#define XB_TOPGEN   3392
#define XCD_BAR_WORDS 3456
#define XB_SPIN_CAP (1u << 18)

__device__ __forceinline__ unsigned xb_ld(unsigned* p)              { return __hip_atomic_load(p, __ATOMIC_RELAXED, __HIP_MEMORY_SCOPE_AGENT); }
__device__ __forceinline__ unsigned xb_add(unsigned* p, unsigned v) { return __hip_atomic_fetch_add(p, v, __ATOMIC_RELAXED, __HIP_MEMORY_SCOPE_AGENT); }
__device__ __forceinline__ unsigned xb_xcc_id() { return (unsigned)__builtin_amdgcn_s_getreg((3 << 11) | 20) & 0xFu; }
#define XB_SPIN(cond, bar) do { unsigned _sp = 0; while (cond) { __builtin_amdgcn_s_sleep(1); \
    if ((++_sp & 255u) == 0u) { if (xb_ld(&(bar)[XB_TMO])) break; if (_sp > XB_SPIN_CAP) { atomicAdd(&(bar)[XB_TMO], 1u); break; } } } } while (0)

struct XcdBarrier {
    unsigned* bar; unsigned x;
    volatile LAS unsigned* st;
};

__device__ __forceinline__ XcdBarrier xcd_barrier_post(unsigned* bar, volatile LAS unsigned* st) {
    XcdBarrier b; b.bar = bar; b.x = xb_xcc_id(); b.st = st;
    if (threadIdx.x == 0) (void)xb_add(&bar[XB_XCNT(b.x)], 1u);
    return b;
}
__device__ __forceinline__ void xcd_barrier_complete(unsigned* bar, unsigned x, unsigned& nloc, unsigned& nx) {
    const unsigned G = gridDim.x * gridDim.y * gridDim.z;
    unsigned sum, cnt, mine, sp = 0u;
    for (;;) {
        sum = 0u; cnt = 0u; mine = 0u;
#pragma unroll
        for (unsigned j = 0; j < 16; ++j) { const unsigned c = xb_ld(&bar[XB_XCNT(j)]); sum += c; cnt += (c > 0u) ? 1u : 0u; mine = (j == x) ? c : mine; }
        if (sum == G) break;
        __builtin_amdgcn_s_sleep(1);
        if ((++sp & 255u) == 0u) { if (xb_ld(&bar[XB_TMO])) break; if (sp > XB_SPIN_CAP) { atomicAdd(&bar[XB_TMO], 1u); break; } }
    }
    nloc = mine > 0u ? mine : 1u; nx = cnt > 0u ? cnt : 1u;
}

__device__ __forceinline__ void xcd_barrier(const XcdBarrier& b) {
    asm volatile("s_waitcnt vmcnt(0)" ::: "memory");
    __syncthreads();
    if (threadIdx.x == 0) {
        unsigned* bar = b.bar;
        __builtin_amdgcn_s_waitcnt(0);
        unsigned nloc = b.st[0], nx = b.st[1];
        if (nloc == 0u) { xcd_barrier_complete(bar, b.x, nloc, nx); b.st[0] = nloc; b.st[1] = nx; }
        const unsigned old = xb_add(&bar[XB_XSUB(b.x)], 1u);
        const unsigned gen = old / nloc;
        if (old + 1u == (gen + 1u) * nloc) {
            __builtin_amdgcn_fence(__ATOMIC_RELEASE, "agent");
            asm volatile("s_waitcnt vmcnt(0)" ::: "memory");
            const unsigned og = xb_add(&bar[XB_TOP], 1u);
            const unsigned tg = og / nx;
            if (og + 1u == (tg + 1u) * nx) xb_add(&bar[XB_TOPGEN], 1u);
            else XB_SPIN(xb_ld(&bar[XB_TOPGEN]) == tg, bar);
            __builtin_amdgcn_fence(__ATOMIC_ACQUIRE, "agent");
            xb_add(&bar[XB_XGEN(b.x)], 1u);
            asm volatile("s_waitcnt vmcnt(0)" ::: "memory");
        } else {
            XB_SPIN(xb_ld(&bar[XB_XGEN(b.x)]) == gen, bar);
            __builtin_amdgcn_fence(__ATOMIC_ACQUIRE, "agent");
            asm volatile("s_waitcnt vmcnt(0)" ::: "memory");
        }
    }
    __syncthreads();
}


struct Args { const void* in[21]; float* out; unsigned char* ws; int ph_lo, ph_hi, bar_region, pad; };

__device__ __forceinline__ f32x4 mma16(bf16x8 a, bf16x8 b, f32x4 c) { return __builtin_amdgcn_mfma_f32_16x16x32_bf16(a, b, c, 0, 0, 0); }
__device__ __forceinline__ bf16x8 ldg8(const bf16* p) { return *(const GAS bf16x8*)p; }

namespace pg8 {
__device__ __forceinline__ void tstore4(bf16* colp_even_tok  , f32x4 v, int odd) {
    const unsigned w01 = cvt_pk_bf16(v[0], v[1]), w23 = cvt_pk_bf16(v[2], v[3]);
    const unsigned snd = odd ? w01 : w23;
    const unsigned rcv = (unsigned)__builtin_amdgcn_update_dpp(0, (int)snd, 0xB1, 0xF, 0xF, true);
    const unsigned own = odd ? w23 : w01;
    const unsigned a = odd ? rcv : own, b = odd ? own : rcv;
    const unsigned p0 = (a & 0xffffu) | (b << 16), p1 = (a >> 16) | (b & 0xffff0000u);
    bf16* cp = colp_even_tok + (size_t)(odd ? 2 : 0) * 4096;
    *(unsigned*)cp = p0; *(unsigned*)(cp + 4096) = p1;
}
struct EpiProj {
    static constexpr bool PERM = true, AFTER_DRAIN = false;
    bf16* P; bf16* Vta; bf16* Vtr; bf16* Krt; const float* cosT; const float* sinT;
    __device__ __forceinline__ void operator()(const f32x4 (&acc)[2][2][4][2], const Unit& u, int wr, int wc, int fr, int fq) const {
        const int pn = u.pn;
        const int row0 = u.pm * BM + wr * 64 + fr;
        const int cl = wc * 32 + 8 * fq;
        if (pn == 9 || (pn >= 26 && pn < 34)) {
            bf16* base; int chan0, nchan;
            if (pn == 9) { base = Vta; chan0 = 0; nchan = 256; } else { base = Vtr; chan0 = (pn - 26) * 256; nchan = 2048; }
#pragma unroll
            for (int ai = 0; ai < 2; ++ai)
#pragma unroll
                for (int m = 0; m < 4; ++m) {
                    const int row = row0 + ai * HALF + m * 16; const int b = row >> 12, s = row & 4095;
                    bf16* colp = base + ((size_t)(b * nchan + chan0 + cl) * 4096 + (s & ~1));
#pragma unroll
                    for (int bj = 0; bj < 2; ++bj)
#pragma unroll
                        for (int n = 0; n < 2; ++n) tstore4(colp + (size_t)(bj * HALF + 4 * n) * 4096, acc[ai][bj][m][n], fr & 1);
                }
            return;
        }
        const bool rot = (pn >= 10 && pn < 26);
        const bool isk = (pn >= 18 && pn < 26);
        float lg2 = 0.f;
        if (isk) { const int h = pn - 18; lg2 = log1pf(-exp2f(-5.0f - (float)h)) * LOG2E; }
#pragma unroll
        for (int ai = 0; ai < 2; ++ai)
#pragma unroll
            for (int m = 0; m < 4; ++m) {
                const int row = row0 + ai * HALF + m * 16;
                f32x4 v[2][2];
#pragma unroll
                for (int bj = 0; bj < 2; ++bj)
#pragma unroll
                    for (int n = 0; n < 2; ++n) v[bj][n] = acc[ai][bj][m][n];
                if (rot) {
                    const float* cp = cosT + (size_t)row * 128 + cl; const float* sp = sinT + (size_t)row * 128 + cl;
#pragma unroll
                    for (int n = 0; n < 2; ++n) {
                        const f32x4 c = *(const f32x4*)(cp + 4 * n), s = *(const f32x4*)(sp + 4 * n);
                        const f32x4 t1 = v[0][n], t2 = v[1][n];
                        v[0][n] = t1 * c - t2 * s; v[1][n] = t1 * s + t2 * c;
                    }
                    if (isk) {
#pragma unroll
                        for (int n = 0; n < 2; ++n) { v[0][n] = v[0][n] * 0.0625f; v[1][n] = v[1][n] * 0.0625f; }
                    }
                } else if (pn < 8) {
#pragma unroll
                    for (int bj = 0; bj < 2; ++bj)
#pragma unroll
                        for (int n = 0; n < 2; ++n) v[bj][n] = v[bj][n] * QA_SCALE;
                } else if (pn >= 34 && pn < 42) {
#pragma unroll
                    for (int bj = 0; bj < 2; ++bj)
#pragma unroll
                        for (int n = 0; n < 2; ++n)
#pragma unroll
                            for (int i = 0; i < 4; ++i) v[bj][n][i] = siluf_(v[bj][n][i]);
                } else if (pn >= 42) {
#pragma unroll
                    for (int bj = 0; bj < 2; ++bj)
#pragma unroll
                        for (int n = 0; n < 2; ++n)
#pragma unroll
                            for (int i = 0; i < 4; ++i) v[bj][n][i] = sigmoidf_(v[bj][n][i]);
                }
                bf16* rowp = P + (size_t)row * NPROJ + pn * BM + cl;
#pragma unroll
                for (int bj = 0; bj < 2; ++bj) {
                    u32x4 w; w.x = cvt_pk_bf16(v[bj][0][0], v[bj][0][1]); w.y = cvt_pk_bf16(v[bj][0][2], v[bj][0][3]); w.z = cvt_pk_bf16(v[bj][1][0], v[bj][1][1]); w.w = cvt_pk_bf16(v[bj][1][2], v[bj][1][3]);
                    __builtin_nontemporal_store(w, (u32x4*)(rowp + bj * HALF));
                }
                if (isk) {
                    const int b = row >> 12, s = row & 4095;
                    const float dk = exp2f((float)(127 - (s & 127)) * lg2);
                    bf16* colp = Krt + ((size_t)(b * 2048 + (pn - 18) * 256 + cl) * 4096 + (s & ~1));
#pragma unroll
                    for (int bj = 0; bj < 2; ++bj)
#pragma unroll
                        for (int n = 0; n < 2; ++n) tstore4(colp + (size_t)(bj * HALF + 4 * n) * 4096, v[bj][n] * dk, fr & 1);
                }
            }
    }
};
struct EpiBranchA {
    static constexpr bool PERM = true, AFTER_DRAIN = false;
    const bf16* P; bf16* M1;
    __device__ __forceinline__ void operator()(const f32x4 (&acc)[2][2][4][2], const Unit& u, int wr, int wc, int fr, int fq) const {
        const int row0 = u.pm * BM + wr * 64 + fr, col0 = u.pn * BM + wc * 32 + 8 * fq;
#pragma unroll
        for (int ai = 0; ai < 2; ++ai)
#pragma unroll
            for (int m = 0; m < 4; ++m) { const int row = row0 + ai * HALF + m * 16;
#pragma unroll
                for (int bj = 0; bj < 2; ++bj) { const int col = col0 + bj * HALF;
                    const u32x4 g = *(const u32x4*)(P + (size_t)row * NPROJ + C_GA + col);
                    f32x4 o0, o1;
                    o0[0] = bf2f(g.x & 0xffffu) * acc[ai][bj][m][0][0]; o0[1] = bf2f(g.x >> 16) * acc[ai][bj][m][0][1]; o0[2] = bf2f(g.y & 0xffffu) * acc[ai][bj][m][0][2]; o0[3] = bf2f(g.y >> 16) * acc[ai][bj][m][0][3];
                    o1[0] = bf2f(g.z & 0xffffu) * acc[ai][bj][m][1][0]; o1[1] = bf2f(g.z >> 16) * acc[ai][bj][m][1][1]; o1[2] = bf2f(g.w & 0xffffu) * acc[ai][bj][m][1][2]; o1[3] = bf2f(g.w >> 16) * acc[ai][bj][m][1][3];
                    u32x4 w; w.x = cvt_pk_bf16(o0[0], o0[1]); w.y = cvt_pk_bf16(o0[2], o0[3]); w.z = cvt_pk_bf16(o1[0], o1[1]); w.w = cvt_pk_bf16(o1[2], o1[3]);
                    *(u32x4*)(M1 + (size_t)row * D + col) = w; } }
    }
};
struct EpiBranchR {
    static constexpr bool PERM = true, AFTER_DRAIN = false;
    const bf16* P; const bf16* M1; bf16* MG;
    __device__ __forceinline__ void operator()(const f32x4 (&acc)[2][2][4][2], const Unit& u, int wr, int wc, int fr, int fq) const {
        const int row0 = u.pm * BM + wr * 64 + fr, col0 = u.pn * BM + wc * 32 + 8 * fq;
#pragma unroll
        for (int ai = 0; ai < 2; ++ai)
#pragma unroll
            for (int m = 0; m < 4; ++m) { const int row = row0 + ai * HALF + m * 16;
#pragma unroll
                for (int bj = 0; bj < 2; ++bj) { const int col = col0 + bj * HALF;
                    const u32x4 g = *(const u32x4*)(P + (size_t)row * NPROJ + C_GT + col);
                    const u32x4 mb = *(const u32x4*)(M1 + (size_t)row * D + col);
                    const f32x4 a0 = {bf2f(mb.x & 0xffffu), bf2f(mb.x >> 16), bf2f(mb.y & 0xffffu), bf2f(mb.y >> 16)}, a1 = {bf2f(mb.z & 0xffffu), bf2f(mb.z >> 16), bf2f(mb.w & 0xffffu), bf2f(mb.w >> 16)};
                    f32x4 o0, o1;
                    o0[0] = a0[0] + bf2f(g.x & 0xffffu) * acc[ai][bj][m][0][0]; o0[1] = a0[1] + bf2f(g.x >> 16) * acc[ai][bj][m][0][1]; o0[2] = a0[2] + bf2f(g.y & 0xffffu) * acc[ai][bj][m][0][2]; o0[3] = a0[3] + bf2f(g.y >> 16) * acc[ai][bj][m][0][3];
                    o1[0] = a1[0] + bf2f(g.z & 0xffffu) * acc[ai][bj][m][1][0]; o1[1] = a1[1] + bf2f(g.z >> 16) * acc[ai][bj][m][1][1]; o1[2] = a1[2] + bf2f(g.w & 0xffffu) * acc[ai][bj][m][1][2]; o1[3] = a1[3] + bf2f(g.w >> 16) * acc[ai][bj][m][1][3];
                    u32x4 w; w.x = cvt_pk_bf16(o0[0], o0[1]); w.y = cvt_pk_bf16(o0[2], o0[3]); w.z = cvt_pk_bf16(o1[0], o1[1]); w.w = cvt_pk_bf16(o1[2], o1[3]);
                    *(u32x4*)(MG + (size_t)row * D + col) = w; } }
    }
};
struct EpiOut {
    static constexpr bool PERM = true, AFTER_DRAIN = false;
    const float* x; const float* gate1; bf16* X1;
    __device__ __forceinline__ void operator()(const f32x4 (&acc)[2][2][4][2], const Unit& u, int wr, int wc, int fr, int fq) const {
        const int row0 = u.pm * BM + wr * 64 + fr, col0 = u.pn * BM + wc * 32 + 8 * fq;
        const int b = (u.pm * BM) >> 12;
        f32x4 gv[2][2];
#pragma unroll
        for (int bj = 0; bj < 2; ++bj)
#pragma unroll
            for (int n = 0; n < 2; ++n) gv[bj][n] = *(const f32x4*)(gate1 + (size_t)b * 12288 + col0 + bj * HALF + 4 * n);
#pragma unroll
        for (int ai = 0; ai < 2; ++ai)
#pragma unroll
            for (int m = 0; m < 4; ++m) { const size_t off = (size_t)(row0 + ai * HALF + m * 16) * D + col0;
#pragma unroll
                for (int bj = 0; bj < 2; ++bj) { const f32x4 x0 = *(const f32x4*)(x + off + bj * HALF), x1v = *(const f32x4*)(x + off + bj * HALF + 4);
                    const f32x4 o0 = x0 + gv[bj][0] * acc[ai][bj][m][0], o1 = x1v + gv[bj][1] * acc[ai][bj][m][1];
                    u32x4 w; w.x = cvt_pk_bf16(o0[0], o0[1]); w.y = cvt_pk_bf16(o0[2], o0[3]); w.z = cvt_pk_bf16(o1[0], o1[1]); w.w = cvt_pk_bf16(o1[2], o1[3]);
                    *(u32x4*)(X1 + off + bj * HALF) = w; } }
    }
};
struct EpiFfn1 {
    static constexpr bool PERM = true, AFTER_DRAIN = false;
    bf16* HB;
    __device__ __forceinline__ void operator()(const f32x4 (&acc)[2][2][4][2], const Unit& u, int wr, int wc, int fr, int fq) const {
        const int row0 = u.pm * BM + wr * 64 + fr, col0 = (u.pn & 7) * 128 + wc * 32 + 8 * fq;
#pragma unroll
        for (int ai = 0; ai < 2; ++ai)
#pragma unroll
            for (int m = 0; m < 4; ++m) { const int row = row0 + ai * HALF + m * 16;
                float h[8];
#pragma unroll
                for (int n = 0; n < 2; ++n)
#pragma unroll
                    for (int i = 0; i < 4; ++i) h[4 * n + i] = siluf_(acc[ai][0][m][n][i]) * acc[ai][1][m][n][i];
                u32x4 w; w.x = cvt_pk_bf16(h[0], h[1]); w.y = cvt_pk_bf16(h[2], h[3]); w.z = cvt_pk_bf16(h[4], h[5]); w.w = cvt_pk_bf16(h[6], h[7]);
                *(u32x4*)(HB + (size_t)row * EDIM + col0) = w; }
    }
};
struct EpiFfn2 {
    static constexpr bool PERM = true, AFTER_DRAIN = false;
    bf16* Y;
    __device__ __forceinline__ void operator()(const f32x4 (&acc)[2][2][4][2], const Unit& u, int wr, int wc, int fr, int fq) const {
        const int row0 = u.pm * BM + wr * 64 + fr, col0 = (u.pn & 7) * BM + wc * 32 + 8 * fq;
#pragma unroll
        for (int ai = 0; ai < 2; ++ai)
#pragma unroll
            for (int m = 0; m < 4; ++m) { const int row = row0 + ai * HALF + m * 16;
#pragma unroll
                for (int bj = 0; bj < 2; ++bj) {
                    u32x4 w; w.x = cvt_pk_bf16(acc[ai][bj][m][0][0], acc[ai][bj][m][0][1]); w.y = cvt_pk_bf16(acc[ai][bj][m][0][2], acc[ai][bj][m][0][3]);
                    w.z = cvt_pk_bf16(acc[ai][bj][m][1][0], acc[ai][bj][m][1][1]); w.w = cvt_pk_bf16(acc[ai][bj][m][1][2], acc[ai][bj][m][1][3]);
                    *(u32x4*)(Y + (size_t)row * D + col0 + bj * HALF) = w; } }
    }
};
struct MoeOrder {
    const LAS int* blk_e; int nblk, NT, G, c;
    __device__ __forceinline__ bool next(int i, Unit& u) const {
        const int L = i * G + c; if (L >= nblk * NT) return false;
        const int blk = L / NT, j = L - blk * NT; u.pm = blk; u.pn = blk_e[blk] * NT + j; return true;
    }
    __device__ __forceinline__ void a_ready(const Unit&) const {}
    __device__ __forceinline__ void done(const Unit&) const {}
};
}


namespace moe {
constexpr int MT = 320, NIB = MT / 64, BK = 64, A_STAGE = MT * BK * 2, B_STAGE = 128 * BK * 2;
constexpr int LDS_A = 0, LDS_B = 3 * A_STAGE;
typedef float f32x2 __attribute__((ext_vector_type(2)));
template <int KIND, bool NOMMA = false, bool NOLOAD = false>
__device__ __forceinline__ void tile(LAS unsigned char* lds, const unsigned char* Abase, const unsigned (&arow)[5], const float* W0, const float* W1, int ldw,
                                     int nblk16, int mrows, bf16* Out, int ldo, int tid) {
    constexpr int NK = (KIND == 1) ? 32 : 16;
    const int lane = tid & 63, wave = __builtin_amdgcn_readfirstlane(tid >> 6), wm = wave & 3, wn = wave >> 2, fr = lane & 15, fq = lane >> 4;
    const int fo = pg8::lds_byte(fr, fq * 8);
    const float* bbase; unsigned bvoff; int n0, kc;
    if (KIND == 1) { const int mat = wave & 1, kq = wave >> 1, kg = lane >> 4, cq = lane & 15;
        bbase = (mat ? W1 : W0) + (size_t)(16 * kq) * ldw; bvoff = (unsigned)((4 * kg * ldw + 4 * cq) * 4);
        n0 = 64 * ((4 * cq) >> 5) + 32 * mat + ((4 * cq) & 31); kc = 16 * kq + 4 * kg; }
    else { const int kg = lane >> 5, cq = lane & 31;
        bbase = W0 + (size_t)(8 * wave) * ldw; bvoff = (unsigned)((4 * kg * ldw + 4 * cq) * 4); n0 = 4 * cq; kc = 8 * wave + 4 * kg; }
    int bw[4];
#pragma unroll
    for (int c = 0; c < 4; ++c) bw[c] = pg8::lds_byte(n0 + c, kc);
    const unsigned ldsw = (unsigned)wave * 1024u;
    const __amdgpu_buffer_rsrc_t brsrc = __builtin_amdgcn_make_buffer_rsrc((void*)bbase, (short)0, 0x7ffffff0, 0x00020000);
    const __amdgpu_buffer_rsrc_t arsrc = __builtin_amdgcn_make_buffer_rsrc((void*)Abase, (short)0, 0x7ffffff0, 0x00020000);
    f32x4 acc[NIB][4];
#pragma unroll
    for (int a = 0; a < NIB; ++a)
#pragma unroll
        for (int b = 0; b < 4; ++b) acc[a][b] = (f32x4){0.f, 0.f, 0.f, 0.f};
    f32x4 breg[4][4];
#define MOE_DMA1(kt, st, p) do { if (!NOLOAD) __builtin_amdgcn_raw_ptr_buffer_load_lds(arsrc, (LAS unsigned*)(lds + LDS_A + (st) * A_STAGE + ((p) >> 1) * 16384 + ((p) & 1) * 8192 + ldsw), 16, arow[p], (unsigned)(kt) * (unsigned)(BK * 2), 0, 0); } while (0)
#define MOE_DMA_A(kt, st) do { MOE_DMA1(kt, st, 0); MOE_DMA1(kt, st, 1); MOE_DMA1(kt, st, 2); MOE_DMA1(kt, st, 3); MOE_DMA1(kt, st, 4); } while (0)
#define MOE_LD1(kt, set, j) do { if (NOLOAD) breg[set][j] = (f32x4){1.f, 2.f, 3.f, 4.f}; else breg[set][j] = __builtin_bit_cast(f32x4, __builtin_amdgcn_raw_buffer_load_b128(brsrc, bvoff, (unsigned)(((kt) * BK + (j)) * ldw * 4), 2)); } while (0)
#define MOE_LD_B(kt, set) do { MOE_LD1(kt, set, 0); MOE_LD1(kt, set, 1); MOE_LD1(kt, set, 2); MOE_LD1(kt, set, 3); } while (0)
#define MOE_CVT_B(set, st) do { _Pragma("unroll") for (int _c = 0; _c < 4; ++_c) { v2u _o; _o.x = pg8::cvt_pk_bf16(breg[set][0][_c], breg[set][1][_c]); _o.y = pg8::cvt_pk_bf16(breg[set][2][_c], breg[set][3][_c]); \
        *(LAS v2u*)(lds + LDS_B + (st) * B_STAGE + bw[_c]) = _o; } } while (0)
#define MOE_FR(st, sa, ks) do { if (!NOMMA) { _Pragma("unroll") for (int _nb = 0; _nb < 4; ++_nb) bfr[_nb] = *(const LAS bf16x8*)(lds + LDS_B + (st) * B_STAGE + (4 * wn + _nb) * 2048 + (ks) * 1024 + fo); \
        _Pragma("unroll") for (int _ib = 0; _ib < NIB; ++_ib) afr[_ib] = *(const LAS bf16x8*)(lds + LDS_A + (sa) * A_STAGE + (wm + 4 * _ib) * 2048 + (ks) * 1024 + fo); } } while (0)
#define MOE_BLK(ib) do { if (!NOMMA) { _Pragma("unroll") for (int _nb = 0; _nb < 4; ++_nb) acc[ib][_nb] = __builtin_amdgcn_mfma_f32_16x16x32_bf16(bfr[_nb], afr[ib], acc[ib][_nb], 0, 0, 0); } } while (0)
#define MOE_STEP(kt, u, DO_LD, DO_DMA, DO_NEXT, WAITIMM) do { bf16x8 bfr[4], afr[NIB]; \
        if (DO_NEXT) MOE_CVT_B(((u) + 1) & 3, ((u) + 1) & 1); \
        MOE_FR((u) & 1, sa0, 0); \
        MOE_BLK(0); if (DO_DMA) MOE_DMA1((kt) + 2, sa2, 0); \
        MOE_BLK(1); if (DO_DMA) MOE_DMA1((kt) + 2, sa2, 1); \
        MOE_BLK(2); if (DO_DMA) MOE_DMA1((kt) + 2, sa2, 2); \
        MOE_BLK(3); if (DO_DMA) MOE_DMA1((kt) + 2, sa2, 3); \
        MOE_BLK(4); if (DO_DMA) MOE_DMA1((kt) + 2, sa2, 4); \
        MOE_FR((u) & 1, sa0, 1); \
        MOE_BLK(0); if (DO_LD) MOE_LD1((kt) + 4, (u), 0); \
        MOE_BLK(1); if (DO_LD) MOE_LD1((kt) + 4, (u), 1); \
        MOE_BLK(2); if (DO_LD) MOE_LD1((kt) + 4, (u), 2); \
        MOE_BLK(3); if (DO_LD) MOE_LD1((kt) + 4, (u), 3); \
        MOE_BLK(4); \
        __builtin_amdgcn_s_waitcnt(WAITIMM); \
        asm volatile("" ::: "memory"); __builtin_amdgcn_s_barrier(); asm volatile("" ::: "memory"); \
        { const int _t = sa0; sa0 = sa1; sa1 = sa2; sa2 = _t; } } while (0)
    int sa0 = 0, sa1 = 1, sa2 = 2;
    MOE_DMA_A(0, 0); MOE_DMA_A(1, 1); MOE_LD_B(0, 0); MOE_LD_B(1, 1); MOE_LD_B(2, 2); MOE_LD_B(3, 3);
    __builtin_amdgcn_s_waitcnt(0x0F74);
    MOE_CVT_B(0, 0);
    __builtin_amdgcn_s_waitcnt(0x0074);
    asm volatile("" ::: "memory"); __builtin_amdgcn_s_barrier(); asm volatile("" ::: "memory");
#pragma unroll 1
    for (int kt = 0; kt < NK - 4; kt += 4) { MOE_STEP(kt, 0, true, true, true, 0x007D); MOE_STEP(kt + 1, 1, true, true, true, 0x007D); MOE_STEP(kt + 2, 2, true, true, true, 0x007D); MOE_STEP(kt + 3, 3, true, true, true, 0x007D); }
    MOE_STEP(NK - 4, 0, false, true, true, 0x0079);
    MOE_STEP(NK - 3, 1, false, true, true, 0x0075);
    MOE_STEP(NK - 2, 2, false, false, true, 0x0070);
    MOE_STEP(NK - 1, 3, false, false, false, 0x0070);
#undef MOE_DMA1
#undef MOE_DMA_A
#undef MOE_LD1
#undef MOE_LD_B
#undef MOE_CVT_B
#undef MOE_BLK
#undef MOE_FR
#undef MOE_STEP
#pragma unroll
    for (int ib = 0; ib < NIB; ++ib) {
        const int row = 16 * (wm + 4 * ib) + fr;
        if (!NOMMA && row < mrows) {
            bf16* op = Out + (size_t)row * ldo;
            if (KIND == 1) {
#pragma unroll
                for (int nb = 0; nb < 2; ++nb) { float h[4];
#pragma unroll
                    for (int i = 0; i < 4; ++i) h[i] = siluf_(acc[ib][nb][i]) * acc[ib][nb + 2][i];
                    v2u w; w.x = pg8::cvt_pk_bf16(h[0], h[1]); w.y = pg8::cvt_pk_bf16(h[2], h[3]);
                    *(GAS v2u*)(op + 32 * wn + 16 * nb + 4 * fq) = w; }
            } else {
#pragma unroll
                for (int nb = 0; nb < 4; ++nb) { v2u w; w.x = pg8::cvt_pk_bf16(acc[ib][nb][0], acc[ib][nb][1]); w.y = pg8::cvt_pk_bf16(acc[ib][nb][2], acc[ib][nb][3]);
                    *(GAS v2u*)(op + 64 * wn + 16 * nb + 4 * fq) = w; }
            }
        }
    }
}
}


#ifndef M2_AUX
#define M2_AUX 2
#endif
namespace moe2 {
constexpr int MT = 320, BK = 64, A_STAGE = MT * BK * 2, B_STAGE = 128 * BK * 2;
constexpr int LDS_A = 0, LDS_B = 3 * A_STAGE;
template <int KIND, bool NOMMA = false, bool NOLOAD = false, class RowFn>
__device__ __forceinline__ void tile(LAS unsigned char* lds, const unsigned char* Abase, const RowFn& arowfn, const float* W0, const float* W1, int ldw,
                                     int nblk16, int mrows, bf16* Out, int ldo, int tid, gu32* done_cnt = nullptr) {
    constexpr int NK = (KIND == 1) ? 32 : 16;
    const int lane = tid & 63, wave = __builtin_amdgcn_readfirstlane(tid >> 6);
    if (wave >= 4) {
        const int lw = wave - 4, ltid = tid - 256;
        unsigned arow[10];
#pragma unroll
        for (int q = 0; q < 10; ++q) { int R, C; pg8::stage_rc(ltid * 16 + (q & 3) * 4096, R, C); arow[q] = arowfn((q >> 2) * 128 + R) + (unsigned)(C * 2); }
        const float* bbase; unsigned bvoff; int n0, kc;
        if (KIND == 1) { const int mat = lw & 1, kh = lw >> 1, kg = lane >> 4, cq = lane & 15;
            bbase = (mat ? W1 : W0) + (size_t)(32 * kh) * ldw; bvoff = (unsigned)((8 * kg * ldw + 4 * cq) * 4);
            n0 = 64 * ((4 * cq) >> 5) + 32 * mat + ((4 * cq) & 31); kc = 32 * kh + 8 * kg; }
        else { const int kg = lane >> 5, cq = lane & 31;
            bbase = W0 + (size_t)(16 * lw) * ldw; bvoff = (unsigned)((8 * kg * ldw + 4 * cq) * 4); n0 = 4 * cq; kc = 16 * lw + 8 * kg; }
        int bw[4];
#pragma unroll
        for (int c = 0; c < 4; ++c) bw[c] = pg8::lds_byte(n0 + ((c + (n0 >> 2)) & 3), kc);
        const unsigned ldsw = (unsigned)lw * 1024u;
        const __amdgpu_buffer_rsrc_t brsrc = __builtin_amdgcn_make_buffer_rsrc((void*)bbase, (short)0, 0x7ffffff0, 0x00020000);
        const __amdgpu_buffer_rsrc_t arsrc = __builtin_amdgcn_make_buffer_rsrc((void*)Abase, (short)0, 0x7ffffff0, 0x00020000);
        f32x4 breg[4][8];
#define M2_DMA1(kt, st, q) if (!NOLOAD) __builtin_amdgcn_raw_ptr_buffer_load_lds(arsrc, (LAS unsigned*)(lds + LDS_A + (st) * A_STAGE + ((q) >> 2) * 16384 + ((q) & 3) * 4096 + ldsw), 16, arow[q], (unsigned)(kt) * (unsigned)(BK * 2), 0, 0)
#define M2_DMA_A(kt, st) do { M2_DMA1(kt, st, 0); M2_DMA1(kt, st, 1); M2_DMA1(kt, st, 2); M2_DMA1(kt, st, 3); M2_DMA1(kt, st, 4); M2_DMA1(kt, st, 5); M2_DMA1(kt, st, 6); M2_DMA1(kt, st, 7); M2_DMA1(kt, st, 8); M2_DMA1(kt, st, 9); } while (0)
#define M2_LD_B(kt, set) do { _Pragma("unroll") for (int _j = 0; _j < 8; ++_j) { if (NOLOAD) breg[set][_j] = (f32x4){1.f, 2.f, 3.f, 4.f}; else breg[set][_j] = __builtin_bit_cast(f32x4, __builtin_amdgcn_raw_buffer_load_b128(brsrc, bvoff, (unsigned)(((kt) * BK + _j) * ldw * 4), M2_AUX)); } } while (0)
#define M2_CVT_B(set, st) do { _Pragma("unroll") for (int _c = 0; _c < 4; ++_c) { v4u _o; _o.x = pg8::cvt_pk_bf16(breg[set][0][_c], breg[set][1][_c]); _o.y = pg8::cvt_pk_bf16(breg[set][2][_c], breg[set][3][_c]); \
        _o.z = pg8::cvt_pk_bf16(breg[set][4][_c], breg[set][5][_c]); _o.w = pg8::cvt_pk_bf16(breg[set][6][_c], breg[set][7][_c]); *(LAS v4u*)(lds + LDS_B + (st) * B_STAGE + bw[_c]) = _o; } } while (0)
#define M2_LSTEP(kt, u, DO_LD, DO_DMA, DO_NEXT, WAITIMM) do { \
        if (DO_NEXT) M2_CVT_B(((u) + 1) & 3, ((u) + 1) & 1); \
        if (DO_DMA) M2_DMA_A((kt) + 2, sa2); \
        if (DO_LD) M2_LD_B((kt) + 4, (u)); \
        __builtin_amdgcn_s_waitcnt(WAITIMM); \
        asm volatile("" ::: "memory"); __builtin_amdgcn_s_barrier(); asm volatile("" ::: "memory"); \
        { const int _t = sa0; sa0 = sa1; sa1 = sa2; sa2 = _t; } } while (0)
        int sa0 = 0, sa1 = 1, sa2 = 2;
        M2_DMA_A(0, 0); M2_DMA_A(1, 1); M2_LD_B(0, 0); M2_LD_B(1, 1); M2_LD_B(2, 2); M2_LD_B(3, 3);
        __builtin_amdgcn_s_waitcnt(0x0F78);
        M2_CVT_B(0, 0);
        __builtin_amdgcn_s_waitcnt(0x0078);
        asm volatile("" ::: "memory"); __builtin_amdgcn_s_barrier(); asm volatile("" ::: "memory");
#pragma unroll 1
        for (int kt = 0; kt < NK - 4; kt += 4) { M2_LSTEP(kt, 0, true, true, true, 0x407A); M2_LSTEP(kt + 1, 1, true, true, true, 0x407A); M2_LSTEP(kt + 2, 2, true, true, true, 0x407A); M2_LSTEP(kt + 3, 3, true, true, true, 0x407A); }
        M2_LSTEP(NK - 4, 0, false, true, true, 0x4072);
        M2_LSTEP(NK - 3, 1, false, true, true, 0x007A);
        M2_LSTEP(NK - 2, 2, false, false, true, 0x0070);
        M2_LSTEP(NK - 1, 3, false, false, false, 0x0070);
#undef M2_DMA1
#undef M2_DMA_A
#undef M2_LD_B
#undef M2_CVT_B
#undef M2_LSTEP
    } else {
        const int wm = wave & 1, wn = wave >> 1, fr = lane & 15, fq = lane >> 4;
        const int fo = pg8::lds_byte(fr, fq * 8);
        f32x4 acc[10][4];
#pragma unroll
        for (int a = 0; a < 10; ++a)
#pragma unroll
            for (int b = 0; b < 4; ++b) acc[a][b] = (f32x4){0.f, 0.f, 0.f, 0.f};
        int sa0 = 0, sa1 = 1, sa2 = 2;
        __builtin_amdgcn_s_barrier(); asm volatile("" ::: "memory");
#pragma unroll 1
        for (int kt = 0; kt < NK; ++kt) {
            const LAS unsigned char* Ab = lds + LDS_A + sa0 * A_STAGE + fo; const LAS unsigned char* Bb = lds + LDS_B + (kt & 1) * B_STAGE + (4 * wn) * 2048 + fo;
#pragma unroll
            for (int ks = 0; ks < 2; ++ks) { bf16x8 bfr[4], afr[5];
#pragma unroll
                for (int nb = 0; nb < 4; ++nb) bfr[nb] = *(const LAS bf16x8*)(Bb + nb * 2048 + ks * 1024);
#pragma unroll
                for (int hb = 0; hb < 2; ++hb) {
#pragma unroll
                    for (int i5 = 0; i5 < 5; ++i5) afr[i5] = *(const LAS bf16x8*)(Ab + (wm + 2 * (5 * hb + i5)) * 2048 + ks * 1024);
#pragma unroll
                    for (int i5 = 0; i5 < 5; ++i5)
#pragma unroll
                        for (int nb = 0; nb < 4; ++nb) if (!NOMMA) acc[5 * hb + i5][nb] = __builtin_amdgcn_mfma_f32_16x16x32_bf16(bfr[nb], afr[i5], acc[5 * hb + i5][nb], 0, 0, 0);
                } }
            __builtin_amdgcn_s_waitcnt(0xC07F);
            asm volatile("" ::: "memory"); __builtin_amdgcn_s_barrier(); asm volatile("" ::: "memory");
            { const int t = sa0; sa0 = sa1; sa1 = sa2; sa2 = t; }
        }
#define M2_UNROT(dst, src) do { float _t[4]; _Pragma("unroll") for (int _c = 0; _c < 4; ++_c) _t[_c] = (fq & 1) ? src[(_c + 1) & 3] : src[_c]; \
        _Pragma("unroll") for (int _c = 0; _c < 4; ++_c) dst[_c] = (fq & 2) ? _t[(_c + 2) & 3] : _t[_c]; } while (0)
#pragma unroll
        for (int ib = 0; ib < 10; ++ib) {
            const int row = 16 * (wm + 2 * ib) + fr;
            if (row < mrows) {
                bf16* op = Out + (size_t)row * ldo;
                if (KIND == 1) {
#pragma unroll
                    for (int nb = 0; nb < 2; ++nb) { float hr[4], h[4];
#pragma unroll
                        for (int i = 0; i < 4; ++i) hr[i] = siluf_(acc[ib][nb][i]) * acc[ib][nb + 2][i];
                        M2_UNROT(h, hr);
                        const unsigned long long w = (unsigned long long)pg8::cvt_pk_bf16(h[0], h[1]) | ((unsigned long long)pg8::cvt_pk_bf16(h[2], h[3]) << 32);
                        __hip_atomic_store((GAS unsigned long long*)(op + 32 * wn + 16 * nb + 4 * fq), w, RLX_AGENT); }
                } else {
#pragma unroll
                    for (int nb = 0; nb < 4; ++nb) { float ar[4], a[4];
#pragma unroll
                        for (int i = 0; i < 4; ++i) ar[i] = acc[ib][nb][i];
                        M2_UNROT(a, ar);
                        v2u w; w.x = pg8::cvt_pk_bf16(a[0], a[1]); w.y = pg8::cvt_pk_bf16(a[2], a[3]);
                        __builtin_nontemporal_store(w, (GAS v2u*)(op + 64 * wn + 16 * nb + 4 * fq)); }
                }
            }
        }
        if (KIND == 1 && done_cnt) {
            asm volatile("s_waitcnt vmcnt(0)" ::: "memory");
            if (lane == 0) __hip_atomic_fetch_add(done_cnt, 1u, RLX_AGENT);
        }
    }
}
}

__device__ __forceinline__ void transpose_item(const float* W, int K, int N, int k0, int n0, bf16* dst  , LAS float* scr, int lane) {
    const int kq = lane >> 4, nq = lane & 15;
#pragma unroll 8
    for (int i = 0; i < 16; ++i) { const int kk = 4 * i + kq; const f32x4 v = *(const GAS f32x4*)(W + (size_t)(k0 + kk) * N + n0 + 4 * nq);
        LAS float* d = scr + kk * 65 + 4 * nq; d[0] = v.x; d[1] = v.y; d[2] = v.z; d[3] = v.w; }
    LDS_WAIT();
    const int c = lane & 7, nb = lane >> 3;
#pragma unroll
    for (int j = 0; j < 8; ++j) { const int n = nb + 8 * j; const LAS float* s = scr + (8 * c) * 65 + n;
        v4u o; o.x = pk2(s[0 * 65], s[1 * 65]); o.y = pk2(s[2 * 65], s[3 * 65]); o.z = pk2(s[4 * 65], s[5 * 65]); o.w = pk2(s[6 * 65], s[7 * 65]);
        *(GAS v4u*)(dst + (size_t)n * K + k0 + 8 * c) = o; }
    LDS_WAIT();
}
__device__ __forceinline__ void ada_item(const float* w_ada, const float* b_ada, float* mod, const LAS float* sc, LAS float* red, int n0, int tid) {
    const int cg = tid & 7, rg = tid >> 3;
    f32x4 a0 = {0.f, 0.f, 0.f, 0.f}, a1 = {0.f, 0.f, 0.f, 0.f};
#pragma unroll 4
    for (int k = rg; k < D; k += 64) { const f32x4 w = *(const GAS f32x4*)(w_ada + (size_t)k * 12288 + n0 + 4 * cg); a0 += w * sc[k]; a1 += w * sc[D + k]; }
#pragma unroll
    for (int i = 0; i < 4; ++i) { red[tid * 8 + i] = a0[i]; red[tid * 8 + 4 + i] = a1[i]; }
    __syncthreads();
    if (tid < 64) { const int b = tid >> 5, col = tid & 31, cgi = col >> 2, ci = col & 3; float s = 0.f;
        for (int r = 0; r < 64; ++r) s += red[(r * 8 + cgi) * 8 + b * 4 + ci];
        mod[b * 12288 + n0 + col] = s + b_ada[n0 + col]; }
    __syncthreads();
}

__global__ void __launch_bounds__(NTHR, 2) fwd_kernel(Args args) {
    extern __shared__ __attribute__((aligned(16))) unsigned char lds_raw[];
    LAS unsigned char* lds = (LAS unsigned char*)lds_raw;
    volatile LAS unsigned* MISC = (volatile LAS unsigned*)(lds + MISC_OFF);
    const int tid = threadIdx.x, lane = tid & 63, wave = __builtin_amdgcn_readfirstlane(tid >> 6);
    const int G = gridDim.x, bid = blockIdx.x;
    unsigned char* ws = args.ws;
    gu32* ctl = (gu32*)(ws + WS_CTL);
    const int lo = args.ph_lo, hi = args.ph_hi;

    const float* x = (const float*)args.in[0];
    const float* cvec = (const float*)args.in[1];
    const int* positions = (const int*)args.in[2];
    const float* norm1_gain = (const float*)args.in[3];
    const float* norm2_gain = (const float*)args.in[4];
    const float* final_gain = (const float*)args.in[5];
    const float* w_ada = (const float*)args.in[6];
    const float* b_ada = (const float*)args.in[7];
    const float* w_in = (const float*)args.in[8];
    const float* attn_sinks = (const float*)args.in[9];
    const float* ret_gain = (const float*)args.in[10];
    const float* w_ba = (const float*)args.in[11];
    const float* w_br = (const float*)args.in[12];
    const float* w_out = (const float*)args.in[13];
    const float* w_rg = (const float*)args.in[14];
    const float* b_rg = (const float*)args.in[15];
    const float* w_re = (const float*)args.in[16];
    const float* b_re = (const float*)args.in[17];
    const float* w_eg = (const float*)args.in[18];
    const float* w_eu = (const float*)args.in[19];
    const float* w_ed = (const float*)args.in[20];

    float* mod = (float*)(ws + WS_MOD);
    float* cosT = (float*)(ws + WS_ROPE); float* sinT = cosT + (size_t)T * 128;
    bf16* Win_t = (bf16*)(ws + WS_WIN); bf16* Wba_t = (bf16*)(ws + WS_WBA); bf16* Wbr_t = (bf16*)(ws + WS_WBR); bf16* Wout_t = (bf16*)(ws + WS_WOUT);
    bf16* Wrt = (bf16*)(ws + WS_WRT);
    bf16* Hb = (bf16*)(ws + WS_H);
    bf16* X1 = (bf16*)(ws + WS_X1);
    bf16* P = (bf16*)(ws + WS_P);
    bf16* Vta = (bf16*)(ws + WS_VTA); bf16* Vtr = (bf16*)(ws + WS_VTR); bf16* Krt = (bf16*)(ws + WS_KRT);
    bf16* SC = (bf16*)(ws + WS_SC); bf16* ST = (bf16*)(ws + WS_ST);
    bf16* ATT = (bf16*)(ws + WS_ATTN); bf16* RET = (bf16*)(ws + WS_RET);
    bf16* M1 = (bf16*)(ws + WS_M1); bf16* MG = (bf16*)(ws + WS_MERGED);
    bf16* HB = (bf16*)(ws + WS_HB); bf16* YB = (bf16*)(ws + WS_Y);
    int* rowtok = (int*)(ws + WS_RTOK);
    int* route = (int*)(ws + WS_ROUTE);
    gu32* ecnt = ctl + CW_CNT;

    for (int u = tid; u < MISC_BYTES / 4; u += NTHR) ((LAS unsigned*)(lds + MISC_OFF))[u] = 0u;
    __syncthreads();
    XcdBarrier bar = xcd_barrier_post((unsigned*)(ctl + CW_BAR) + args.bar_region * XCD_BAR_WORDS, MISC + 8);

#define IN(k) (lo <= (k) && (k) < hi)
#define SEAM(k) do { if (IN(k) && IN((k) + 1)) xcd_barrier(bar); } while (0)

    if (IN(0)) {
        {
            LAS float* sc = (LAS float*)lds;
            LAS float* red = (LAS float*)(lds + 16384);
            if (bid < 128) { for (int i = tid; i < 2 * D; i += NTHR) sc[i] = siluf_(cvec[i]); __syncthreads(); }
            for (int it = bid; it < 128; it += G) ada_item(w_ada, b_ada, mod, sc, red, it * 32, tid);
            __syncthreads();
        }
        for (int i = bid * NTHR + tid; i < T * 128; i += G * NTHR) {
            const int tok = i >> 7, f = i & 127;
            const double inv = exp2(-(double)f * (13.287712379549449 / 128.0));
            double rv = (double)positions[tok] * inv * 0.15915494309189535;
            rv -= floor(rv);
            const float rf = (float)rv;
            cosT[i] = __builtin_amdgcn_cosf(rf); sinT[i] = __builtin_amdgcn_sinf(rf);
        }
        for (int i = bid * NTHR + tid; i < 80 * D; i += G * NTHR) {
            const int n = i >> 11, k = i & 2047; float v = 0.f;
            if (n < 64) v = w_re[(size_t)k * 64 + n]; else if (n < 68) v = w_rg[(size_t)k * 4 + (n - 64)];
            Wrt[i] = (bf16)f2bf(v);
        }
        {
            LAS float* scr = (LAS float*)(lds + wave * 16640);
            const int gw = bid * NWAVES + wave, NGW = G * NWAVES;
            constexpr int NB = NPROJ / 64, NIT = 32 * NB;
            for (int it = gw; it < NIT; it += NGW) { const int kb = it / NB, n0 = (it % NB) * 64; transpose_item(w_in, D, NPROJ, kb * 64, n0, Win_t + (size_t)n0 * D, scr, lane); }
        }
    }
    SEAM(0);

    if (IN(1)) {
        const int gw = bid * NWAVES + wave, NGW = G * NWAVES;
        int curb = -1; f32x4 ca[8], cs[8];
        f32x4 v[8], vn[8];
        int row = gw;
        if (row < T) {
            const GAS f32x4* xr = (const GAS f32x4*)(x + (size_t)row * D) + lane;
#pragma unroll
            for (int j = 0; j < 8; ++j) v[j] = xr[64 * j];
        }
        for (; row < T; row += NGW) {
            const int b = row >> 12, nrow = row + NGW;
            if (nrow < T) {
                const GAS f32x4* xr = (const GAS f32x4*)(x + (size_t)nrow * D) + lane;
#pragma unroll
                for (int j = 0; j < 8; ++j) vn[j] = xr[64 * j];
            }
            if (b != curb) { curb = b;
#pragma unroll
                for (int j = 0; j < 8; ++j) { const int k = 4 * lane + 256 * j;
                    const f32x4 g = *(const GAS f32x4*)(norm1_gain + k), scl = *(const GAS f32x4*)(mod + b * 12288 + 2048 + k);
                    ca[j] = g * (scl + 1.0f); cs[j] = *(const GAS f32x4*)(mod + b * 12288 + k); } }
            float ss = 0.f;
#pragma unroll
            for (int j = 0; j < 8; ++j) ss += (v[j].x * v[j].x + v[j].y * v[j].y) + (v[j].z * v[j].z + v[j].w * v[j].w);
            const float r = 1.0f / sqrtf(wave_sum(ss) * (1.0f / D) + EPS);
            GAS v2u* o8 = (GAS v2u*)(Hb + (size_t)row * D) + lane;
#pragma unroll
            for (int j = 0; j < 8; ++j) { const f32x4 hv = v[j] * r * ca[j] + cs[j];
                v2u o; o.x = pk2(hv.x, hv.y); o.y = pk2(hv.z, hv.w); o8[64 * j] = o; }
#pragma unroll
            for (int j = 0; j < 8; ++j) v[j] = vn[j];
        }
    }
    SEAM(1);

    if (IN(2)) {
        pg8::Gemm g{Hb, Win_t, T, NPROJ, D}; pg8::StaticOrder S; S.init(T, NPROJ, G, bid, WGM_PROJ);
        pg8::EpiProj E{P, Vta, Vtr, Krt, cosT, sinT};
        pg8::gemm_phase<pg8::EpiProj, pg8::StaticOrder, GK_ALIGN, GK_SP2>(lds, g, S, E);
        {
            const int nun = (T / 256) * (NPROJ / 256), rem = nun % G;
            const int nidle = rem ? G - rem : G, ii = rem ? bid - rem : bid;
            if (ii >= 0) {
                LAS float* sc = (LAS float*)lds; LAS float* red = (LAS float*)(lds + 16384);
                for (int i = tid; i < 2 * D; i += NTHR) sc[i] = siluf_(cvec[i]);
                __syncthreads();
                for (int it = ii; it < 256; it += nidle) ada_item(w_ada, b_ada, mod, sc, red, 4096 + it * 32, tid);
                __syncthreads();
                LAS float* scr = (LAS float*)(lds + wave * 16640);
                for (int it = ii * NWAVES + wave; it < 3 * 1024; it += nidle * NWAVES) { const int w = it >> 10, r = it & 1023, kb = r >> 5, n0 = (r & 31) * 64;
                    const float* src = w == 0 ? w_ba : (w == 1 ? w_br : w_out); bf16* dst = w == 0 ? Wba_t : (w == 1 ? Wbr_t : Wout_t);
                    transpose_item(src, D, D, kb * 64, n0, dst + (size_t)n0 * D, scr, lane); }
            }
        }
    }
    SEAM(2);

    if (IN(3)) {
        const int r16 = lane & 15, q4 = lane >> 4;
        const int vw3 = (G & 7) == 0 ? (bid & 7) * (G >> 3) + (bid >> 3) : bid;
        for (int unit = vw3; unit < 256 + 512; unit += G) {
#ifdef DBG_VARIANT
            if (args.pad == 3 && unit < 256) continue;
            if (args.pad == 4 && unit >= 256) continue;
#endif
            if (unit < 256) {
                const int b = unit >> 7, kvh = (unit >> 5) & 3, nb = unit & 31, head = kvh * 8 + wave;
                const float sink2 = attn_sinks[head] * LOG2E;
                const int tq0 = nb * 128, ks = (nb - 1) * 128;
                const bf16* Qb = P + (size_t)(b * SEQ + tq0) * NPROJ + C_QA + head * 64;
                const bf16* Kb = P + (size_t)(b * SEQ) * NPROJ + C_KA + kvh * 64;
                const bf16* Vb = Vta + (size_t)(b * 256 + kvh * 64) * 4096;
                LAS bf16* Kl = (LAS bf16*)lds;
                LAS bf16* Vl = (LAS bf16*)(lds + 36864);
                LAS bf16* Pl = (LAS bf16*)(lds + 70656 + wave * 5376);
#pragma unroll
                for (int j = 0; j < 4; ++j) { const int p = tid + 512 * j, row = p >> 3, ch = p & 7; int tk = ks + row; tk = tk < 0 ? 0 : tk;
                    *(LAS v4u*)(Kl + row * 72 + ch * 8) = *(const GAS v4u*)(Kb + (size_t)tk * NPROJ + ch * 8); }
#pragma unroll
                for (int j = 0; j < 4; ++j) { const int p = tid + 512 * j, row = p >> 5, ch = p & 31; int tk0 = ks + 8 * ch; tk0 = tk0 < 0 ? 8 * ch : tk0;
                    *(LAS v4u*)(Vl + row * 264 + ch * 8) = *(const GAS v4u*)(Vb + (size_t)row * 4096 + tk0); }
                bf16x8 qall[8][2];
#pragma unroll
                for (int t = 0; t < 8; ++t)
#pragma unroll
                    for (int s = 0; s < 2; ++s) qall[t][s] = ldg8(Qb + (size_t)(16 * t + r16) * NPROJ + 32 * s + 8 * q4);
                *(LAS v4u*)(Pl + r16 * 168 + 144 + 8 * (q4 & 1)) = (v4u){0u, 0u, 0u, 0u};
                __syncthreads();
                const int e16 = 4 * q4;
#pragma unroll
                for (int t = 0; t < 8; ++t) {
                    f32x4 sc[9];
#pragma unroll
                    for (int n = 0; n < 9; ++n) {
                        f32x4 a = {0.f, 0.f, 0.f, 0.f};
                        if (!(nb == 0 && t + n < 8)) {
#pragma unroll
                            for (int s = 0; s < 2; ++s) a = mma16(*(const LAS bf16x8*)(Kl + (16 * (t + n) + r16) * 72 + 32 * s + 8 * q4), qall[t][s], a);
                        }
                        sc[n] = a;
                    }
                    float m = -INFINITY;
#pragma unroll
                    for (int n = 0; n < 9; ++n)
#pragma unroll
                        for (int reg = 0; reg < 4; ++reg) { bool ok = !(nb == 0 && t + n < 8);
                            if (n == 0) ok = ok && (e16 + reg > r16); if (n == 8) ok = ok && (e16 + reg <= r16);
                            sc[n][reg] = ok ? sc[n][reg] : -INFINITY; m = fmaxf(m, sc[n][reg]); }
                    m = fmaxf(m, __shfl_xor(m, 16)); m = fmaxf(m, __shfl_xor(m, 32)); m = fmaxf(m, sink2);
                    float sum = 0.f;
#pragma unroll
                    for (int n = 0; n < 9; ++n) {
#pragma unroll
                        for (int reg = 0; reg < 4; ++reg) { const float pv = __builtin_amdgcn_exp2f(sc[n][reg] - m); sc[n][reg] = pv; sum += pv; }
                        v2u w; w.x = pg8::cvt_pk_bf16(sc[n][0], sc[n][1]); w.y = pg8::cvt_pk_bf16(sc[n][2], sc[n][3]);
                        *(LAS v2u*)(Pl + r16 * 168 + 16 * n + e16) = w; }
                    sum += __shfl_xor(sum, 16); sum += __shfl_xor(sum, 32);
                    const float inv = 1.0f / (sum + __builtin_amdgcn_exp2f(sink2 - m));
                    LDS_WAIT();
                    f32x4 o[4];
#pragma unroll
                    for (int nd = 0; nd < 4; ++nd) o[nd] = (f32x4){0.f, 0.f, 0.f, 0.f};
#pragma unroll
                    for (int s = 0; s < 5; ++s) {
                        const bf16x8 pa = *(const LAS bf16x8*)(Pl + r16 * 168 + 32 * s + 8 * q4);
                        const int n = 2 * s + (q4 >> 1); const int kb = (t + n) < 16 ? (t + n) : 15;
#pragma unroll
                        for (int nd = 0; nd < 4; ++nd) o[nd] = mma16(*(const LAS bf16x8*)(Vl + (16 * nd + r16) * 264 + 16 * kb + 8 * (q4 & 1)), pa, o[nd]);
                    }
#pragma unroll
                    for (int nd = 0; nd < 4; ++nd) { v2u w; w.x = pg8::cvt_pk_bf16(o[nd][0] * inv, o[nd][1] * inv); w.y = pg8::cvt_pk_bf16(o[nd][2] * inv, o[nd][3] * inv);
                        *(GAS v2u*)(ATT + (size_t)(b * SEQ + tq0 + 16 * t + r16) * D + head * 64 + 16 * nd + 4 * q4) = w; }
                    LDS_WAIT();
                }
                __syncthreads();
            } else {
                const int u = unit - 256, bh = u >> 5, c = u & 31, b = bh >> 3, h = bh & 7;
                const bf16* Ag = Vtr + (size_t)(b * 2048 + h * 256) * 4096 + c * 128;
                const bf16* Bg = Krt + (size_t)(b * 2048 + h * 256) * 4096 + c * 128;
                LAS bf16* Al = (LAS bf16*)lds;
                LAS bf16* Bl = (LAS bf16*)(lds + 69632);
#pragma unroll
                for (int j = 0; j < 8; ++j) { const int p = tid + 512 * j, row = p >> 4, ch = p & 15;
                    *(LAS v4u*)(Al + row * 136 + ch * 8) = *(const GAS v4u*)(Ag + (size_t)row * 4096 + ch * 8);
                    *(LAS v4u*)(Bl + row * 136 + ch * 8) = *(const GAS v4u*)(Bg + (size_t)row * 4096 + ch * 8); }
                __syncthreads();
#pragma unroll 1
                for (int nh = 0; nh < 2; ++nh) {
                    f32x4 acc[2][8];
#pragma unroll
                    for (int m = 0; m < 2; ++m)
#pragma unroll
                        for (int n = 0; n < 8; ++n) acc[m][n] = (f32x4){0.f, 0.f, 0.f, 0.f};
#pragma unroll
                    for (int s = 0; s < 4; ++s) {
                        bf16x8 a[2];
#pragma unroll
                        for (int m = 0; m < 2; ++m) a[m] = *(const LAS bf16x8*)(Al + (32 * wave + 16 * m + r16) * 136 + 32 * s + 8 * q4);
#pragma unroll
                        for (int n = 0; n < 8; ++n) { const bf16x8 bb = *(const LAS bf16x8*)(Bl + (128 * nh + 16 * n + r16) * 136 + 32 * s + 8 * q4);
                            acc[0][n] = mma16(bb, a[0], acc[0][n]); acc[1][n] = mma16(bb, a[1], acc[1][n]); }
                    }
                    bf16* out = SC + (size_t)u * 65536;
#pragma unroll
                    for (int m = 0; m < 2; ++m)
#pragma unroll
                        for (int n = 0; n < 8; ++n) { v2u w; w.x = pk2(acc[m][n][0], acc[m][n][1]); w.y = pk2(acc[m][n][2], acc[m][n][3]);
                            *(GAS v2u*)(out + (size_t)(32 * wave + 16 * m + r16) * 256 + 128 * nh + 16 * n + 4 * q4) = w; }
                }
                __syncthreads();
            }
        }
    }
    SEAM(3);

    if (IN(4)) {
        for (int i = bid * NTHR + tid; i < 16 * 16384; i += G * NTHR) {
            const int bh = i >> 14, e4 = i & 16383, h = bh & 7;
            const float dc = expf(128.0f * log1pf(-exp2f(-5.0f - (float)h)));
            f32x4 st = {0.f, 0.f, 0.f, 0.f};
            for (int c = 0; c < 32; ++c) {
                const size_t off = (size_t)(bh * 32 + c) * 65536 + 4 * e4;
                v2u o; o.x = pk2(st.x, st.y); o.y = pk2(st.z, st.w); *(GAS v2u*)(ST + off) = o;
                const v2u sb = *(const GAS v2u*)(SC + off);
                const f32x4 s = {bf2f(sb.x & 0xffffu), bf2f(sb.x >> 16), bf2f(sb.y & 0xffffu), bf2f(sb.y >> 16)};
                st = st * dc + s;
            }
        }
    }
    SEAM(4);

    if (IN(5)) {
        const int r16 = lane & 15, q4 = lane >> 4;
        for (int u = bid; u < 512; u += G) {
            const int bh = u >> 5, c = u & 31, b = bh >> 3, h = bh & 7;
            const float lg2 = log1pf(-exp2f(-5.0f - (float)h)) * LOG2E;
            const int tok0 = b * SEQ + c * 128;
            const bf16* Qg = P + (size_t)tok0 * NPROJ + C_QR + h * 256;
            const bf16* Kg = P + (size_t)tok0 * NPROJ + C_KR + h * 256;
            const bf16* Vg = Vtr + (size_t)(b * 2048 + h * 256 + 32 * wave) * 4096 + c * 128;
            const bf16* Sg = ST + (size_t)u * 65536 + (size_t)(32 * wave) * 256;
            LAS bf16* Kl = (LAS bf16*)lds;
            LAS bf16* Il = (LAS bf16*)lds;
            LAS bf16* Ql = (LAS bf16*)(lds + 67584);
            LAS float* red = (LAS float*)(lds + 135168);
#pragma unroll
            for (int j = 0; j < 8; ++j) { const int p = tid + 512 * j, row = p >> 5, ch = p & 31;
                *(LAS v4u*)(Kl + row * 264 + ch * 8) = *(const GAS v4u*)(Kg + (size_t)row * NPROJ + ch * 8);
                *(LAS v4u*)(Ql + row * 264 + ch * 8) = *(const GAS v4u*)(Qg + (size_t)row * NPROJ + ch * 8); }
            __syncthreads();
            f32x4 sc[8];
            {
                bf16x8 qa[8];
#pragma unroll
                for (int s = 0; s < 8; ++s) qa[s] = *(const LAS bf16x8*)(Ql + (16 * wave + r16) * 264 + 32 * s + 8 * q4);
#pragma unroll
                for (int n = 0; n < 8; ++n) {
                    f32x4 a = {0.f, 0.f, 0.f, 0.f};
                    if (n <= wave) {
#pragma unroll
                        for (int s = 0; s < 8; ++s) a = mma16(*(const LAS bf16x8*)(Kl + (16 * n + r16) * 264 + 32 * s + 8 * q4), qa[s], a);
                    }
#pragma unroll
                    for (int reg = 0; reg < 4; ++reg) { const int df = (16 * wave + r16) - (16 * n + 4 * q4 + reg); a[reg] = df >= 0 ? a[reg] * __builtin_amdgcn_exp2f((float)df * lg2) : 0.f; }
                    sc[n] = a;
                }
            }
            bf16x8 sfr[4][2], vfr[3][2];
#pragma unroll
            for (int s = 0; s < 3; ++s)
#pragma unroll
                for (int n2 = 0; n2 < 2; ++n2) sfr[s][n2] = ldg8(Sg + (size_t)(16 * n2 + r16) * 256 + 32 * s + 8 * q4);
            __syncthreads();
#pragma unroll
            for (int n = 0; n < 8; ++n) { v2u w; w.x = pk2(sc[n][0], sc[n][1]); w.y = pk2(sc[n][2], sc[n][3]); *(LAS v2u*)(Il + (16 * wave + r16) * 136 + 16 * n + 4 * q4) = w; }
            __syncthreads();
            f32x4 O1[8][2];
#pragma unroll
            for (int qb = 0; qb < 8; ++qb)
#pragma unroll
                for (int n2 = 0; n2 < 2; ++n2) O1[qb][n2] = (f32x4){0.f, 0.f, 0.f, 0.f};
#pragma unroll
            for (int s = 0; s < 8; ++s) {
                if (s + 3 < 8) {
#pragma unroll
                    for (int n2 = 0; n2 < 2; ++n2) sfr[(s + 3) & 3][n2] = ldg8(Sg + (size_t)(16 * n2 + r16) * 256 + 32 * (s + 3) + 8 * q4); }
                if (s >= 6) {
#pragma unroll
                    for (int n2 = 0; n2 < 2; ++n2) vfr[s - 6][n2] = ldg8(Vg + (size_t)(16 * n2 + r16) * 4096 + 32 * (s - 6) + 8 * q4); }
                bf16x8 sf[2]; sf[0] = sfr[s & 3][0]; sf[1] = sfr[s & 3][1];
#pragma unroll
                for (int qb = 0; qb < 8; ++qb) { const bf16x8 qf = *(const LAS bf16x8*)(Ql + (16 * qb + r16) * 264 + 32 * s + 8 * q4);
                    O1[qb][0] = mma16(sf[0], qf, O1[qb][0]); O1[qb][1] = mma16(sf[1], qf, O1[qb][1]); }
            }
#pragma unroll
            for (int qb = 0; qb < 8; ++qb) { const float dq = __builtin_amdgcn_exp2f((float)(16 * qb + r16 + 1) * lg2);
#pragma unroll
                for (int n2 = 0; n2 < 2; ++n2) O1[qb][n2] = O1[qb][n2] * dq; }
#pragma unroll
            for (int s = 0; s < 4; ++s) {
                if (s + 2 < 4) {
#pragma unroll
                    for (int n2 = 0; n2 < 2; ++n2) vfr[(s + 2) % 3][n2] = ldg8(Vg + (size_t)(16 * n2 + r16) * 4096 + 32 * (s + 2) + 8 * q4); }
                bf16x8 vf[2]; vf[0] = vfr[s % 3][0]; vf[1] = vfr[s % 3][1];
#pragma unroll
                for (int qb = 0; qb < 8; ++qb) if (2 * s <= qb) { const bf16x8 pf = *(const LAS bf16x8*)(Il + (16 * qb + r16) * 136 + 32 * s + 8 * q4);
                    O1[qb][0] = mma16(vf[0], pf, O1[qb][0]); O1[qb][1] = mma16(vf[1], pf, O1[qb][1]); }
            }
#pragma unroll
            for (int qb = 0; qb < 8; ++qb) { float ss = 0.f;
#pragma unroll
                for (int n2 = 0; n2 < 2; ++n2)
#pragma unroll
                    for (int reg = 0; reg < 4; ++reg) { const float v = O1[qb][n2][reg]; ss += v * v; }
                ss += __shfl_xor(ss, 16); ss += __shfl_xor(ss, 32);
                if (q4 == 0) red[(16 * qb + r16) * 8 + wave] = ss; }
            __syncthreads();
#pragma unroll
            for (int qb = 0; qb < 8; ++qb) { const int q = 16 * qb + r16; float tot = 0.f;
#pragma unroll
                for (int w2 = 0; w2 < 8; ++w2) tot += red[q * 8 + w2];
                const float rs = 1.0f / sqrtf(tot * (1.0f / 256.0f) + EPS);
                const size_t tok = (size_t)(tok0 + q);
#pragma unroll
                for (int n2 = 0; n2 < 2; ++n2) { const int ch = h * 256 + 32 * wave + 16 * n2 + 4 * q4;
                    const f32x4 gn = *(const GAS f32x4*)(ret_gain + ch); const v2u sg = *(const GAS v2u*)(P + tok * NPROJ + C_GR + ch);
                    const float o0 = O1[qb][n2][0] * rs * gn[0] * bf2f(sg.x & 0xffffu), o1 = O1[qb][n2][1] * rs * gn[1] * bf2f(sg.x >> 16);
                    const float o2 = O1[qb][n2][2] * rs * gn[2] * bf2f(sg.y & 0xffffu), o3 = O1[qb][n2][3] * rs * gn[3] * bf2f(sg.y >> 16);
                    v2u w; w.x = pk2(o0, o1); w.y = pk2(o2, o3); *(GAS v2u*)(RET + tok * D + ch) = w; } }
            __syncthreads();
        }
    }
    SEAM(5);

    if (IN(6)) {
        { pg8::Gemm g{ATT, Wba_t, T, D, D}; pg8::StaticOrder S; S.init(T, D, G, bid, WGM_SQ); pg8::EpiBranchA E{P, M1};
          pg8::gemm_phase<pg8::EpiBranchA, pg8::StaticOrder, GK_ALIGN1, GK_SP2>(lds, g, S, E); }
        VM_WAIT(); __syncthreads();
        { pg8::Gemm g{RET, Wbr_t, T, D, D}; pg8::StaticOrder S; S.init(T, D, G, bid, WGM_SQ); pg8::EpiBranchR E{P, M1, MG};
          pg8::gemm_phase<pg8::EpiBranchR, pg8::StaticOrder, GK_ALIGN1, GK_SP2>(lds, g, S, E); }
    }
    SEAM(6);

    if (IN(7)) {
        pg8::Gemm g{MG, Wout_t, T, D, D}; pg8::StaticOrder S; S.init(T, D, G, bid, WGM_SQ); pg8::EpiOut E{x, mod + 2 * 2048, X1};
        pg8::gemm_phase<pg8::EpiOut, pg8::StaticOrder, GK_ALIGN1, GK_SP2>(lds, g, S, E);
    }
    SEAM(7);

    if (IN(8)) {
        const int r16 = lane & 15, q4 = lane >> 4;
        constexpr int AP = 2056;
        LAS bf16* Al = (LAS bf16*)lds;
        LAS float* Lg = (LAS float*)(lds + 135168);
        LAS float* Bs = (LAS float*)(lds + MISC_OFF + 3072);
        LAS unsigned* Lc = (LAS unsigned*)(lds + MISC_OFF + 3584);
        LAS unsigned* Lb = (LAS unsigned*)(lds + MISC_OFF + 3840);
        if (tid < 64) { Bs[tid] = b_re[tid]; Lc[tid] = 0u; } else if (tid < 68) Bs[tid] = b_rg[tid - 64];
        for (int t0 = bid * 32; t0 < T; t0 += G * 32) {
            f32x4 ca[8], cs[8];
            { const int b0 = t0 >> 12;
#pragma unroll
              for (int j = 0; j < 8; ++j) { const int k = 4 * lane + 256 * j;
                  const f32x4 g = *(const GAS f32x4*)(norm2_gain + k), scl = *(const GAS f32x4*)(mod + b0 * 12288 + 4 * 2048 + k);
                  ca[j] = g * (scl + 1.0f); cs[j] = *(const GAS f32x4*)(mod + b0 * 12288 + 3 * 2048 + k); } }
            for (int rr = 0; rr < 4; ++rr) {
                const int lrow = 4 * wave + rr, row = t0 + lrow;
                const GAS v2u* xr = (const GAS v2u*)(X1 + (size_t)row * D) + lane;
                f32x4 v[8]; float ss = 0.f;
#pragma unroll
                for (int j = 0; j < 8; ++j) { const v2u xb = xr[64 * j]; v[j] = (f32x4){bf2f(xb.x & 0xffffu), bf2f(xb.x >> 16), bf2f(xb.y & 0xffffu), bf2f(xb.y >> 16)};
                    ss += (v[j].x * v[j].x + v[j].y * v[j].y) + (v[j].z * v[j].z + v[j].w * v[j].w); }
                const float r = 1.0f / sqrtf(wave_sum(ss) * (1.0f / D) + EPS);
                GAS v2u* o8 = (GAS v2u*)(Hb + (size_t)row * D) + lane;
#pragma unroll
                for (int j = 0; j < 8; ++j) { const int k = 4 * lane + 256 * j;
                    const f32x4 hv = v[j] * r * ca[j] + cs[j];
                    v2u o; o.x = pk2(hv.x, hv.y); o.y = pk2(hv.z, hv.w); o8[64 * j] = o;
                    *(LAS v2u*)(Al + lrow * AP + k) = o; }
            }
            __syncthreads();
            if (wave < 5) {
                f32x4 a0 = {0.f, 0.f, 0.f, 0.f}, a1 = {0.f, 0.f, 0.f, 0.f};
                const bf16* Bb = Wrt + (size_t)(16 * wave + r16) * D + 8 * q4;
#pragma unroll 4
                for (int s = 0; s < 64; ++s) {
                    const bf16x8 bb = ldg8(Bb + 32 * s);
                    const bf16x8 x0 = *(const LAS bf16x8*)(Al + r16 * AP + 32 * s + 8 * q4), x1v = *(const LAS bf16x8*)(Al + (16 + r16) * AP + 32 * s + 8 * q4);
                    a0 = mma16(x0, bb, a0); a1 = mma16(x1v, bb, a1);
                }
#pragma unroll
                for (int reg = 0; reg < 4; ++reg) { Lg[(4 * q4 + reg) * 80 + 16 * wave + r16] = a0[reg]; Lg[(16 + 4 * q4 + reg) * 80 + 16 * wave + r16] = a1[reg]; }
            }
            __syncthreads();
            if (tid < 32) {
                const int row = t0 + tid; const LAS float* L = Lg + tid * 80;
                float gl[4]; int gs = 0;
#pragma unroll
                for (int j = 0; j < 4; ++j) gl[j] = L[64 + j] + Bs[64 + j];
#pragma unroll
                for (int j = 1; j < 4; ++j) if (gl[j] > gl[gs]) gs = j;
                float den = 0.f;
#pragma unroll
                for (int j = 0; j < 4; ++j) den += expf(gl[j] - gl[gs]);
                const float gw = 1.0f / den;
                float ev[16];
#pragma unroll
                for (int j = 0; j < 16; ++j) ev[j] = L[gs * 16 + j] + Bs[gs * 16 + j];
                int i0 = 0; float v0 = ev[0];
#pragma unroll
                for (int j = 1; j < 16; ++j) if (ev[j] > v0) { v0 = ev[j]; i0 = j; }
                int i1 = -1; float v1 = -INFINITY;
#pragma unroll
                for (int j = 0; j < 16; ++j) if (j != i0 && ev[j] > v1) { v1 = ev[j]; i1 = j; }
                const float e1 = expf(v1 - v0); const float w0 = gw / (1.0f + e1), w1 = gw * e1 / (1.0f + e1);
                const int ex0 = gs * 16 + i0, ex1 = gs * 16 + i1;
                const int k0 = (int)__hip_atomic_fetch_add(Lc + ex0, 1u, __ATOMIC_RELAXED, __HIP_MEMORY_SCOPE_WORKGROUP);
                const int k1 = (int)__hip_atomic_fetch_add(Lc + ex1, 1u, __ATOMIC_RELAXED, __HIP_MEMORY_SCOPE_WORKGROUP);
                LDS_WAIT();
#pragma unroll
                for (int q = 0; q < 2; ++q) { const int ex = tid + 32 * q; const unsigned c = Lc[ex]; if (c) Lb[ex] = __hip_atomic_fetch_add(ecnt + ex, c, RLX_AGENT); }
                LDS_WAIT();
                const int p0 = (int)Lb[ex0] + k0, p1 = (int)Lb[ex1] + k1;
                Lc[tid] = 0u; Lc[tid + 32] = 0u;
                int* rt = route + (size_t)row * 8;
                rt[0] = ex0; rt[1] = p0; rt[2] = ex1; rt[3] = p1; rt[4] = __builtin_bit_cast(int, w0); rt[5] = __builtin_bit_cast(int, w1);
                rowtok[ex0 * 8192 + p0] = row; rowtok[ex1 * 8192 + p1] = row;
            }
            __syncthreads();
        }
    }
    SEAM(8);

    LAS int* ecl = (LAS int*)(lds + MISC_OFF + 1024);
    LAS int* bstart = (LAS int*)(lds + MISC_OFF + 1536);
    LAS int* ptab = (LAS int*)(lds + MISC_OFF + 2048);
    LAS int* npass_p = (LAS int*)(lds + MISC_OFF + 2560);
    if (hi > 9 && lo <= 12) {
        if (tid == 0) { int nb = 0, np = 0;
            for (int e = 0; e < NEXP; ++e) { const int cnt = (int)__hip_atomic_load(ecnt + e, RLX_AGENT); ecl[e] = cnt; bstart[e] = nb; nb += cnt; }
            for (int e = 0; e < NEXP; ++e) for (int q = 0; q * moe::MT < ecl[e]; ++q) ptab[np++] = e | (q << 8);
            npass_p[0] = np;
#ifdef DBG_LEAK_MT
            { int pp = 0; for (int e = 0; e < NEXP; ++e) pp += (ecl[e] + DBG_LEAK_MT - 1) / DBG_LEAK_MT; if (lo <= 10 && hi > 10) { const unsigned long long t0 = __builtin_amdgcn_s_memrealtime(); while (__builtin_amdgcn_s_memrealtime() - t0 < (unsigned long long)(DBG_LEAK_MT == 1 ? 10000 : pp * 200)) __builtin_amdgcn_s_sleep(8); } }
#endif
            }
        __syncthreads();
    }
    const int vwg = (G & 7) == 0 ? (bid & 7) * (G >> 3) + (bid >> 3) : bid;

    if (IN(10)) {
        gu32* pcnt = ctl + CW_PCNT;
        gu32* qhead = ctl + CW_QHEAD;
        LAS int* qslot = (LAS int*)(lds + MISC_OFF + 4096);
        const int P = npass_p[0];
        const int myx = (int)(xb_xcc_id() & 7u);
        auto fetch = [&](int qfirst) -> int {
            for (int t = 0; t < 8; ++t) { const int q = (qfirst + t) & 7; const int npx = (P - q + 7) >> 3; if (npx <= 0) continue;
                if ((int)__hip_atomic_load(qhead + 64 * q, RLX_AGENT) >= 32 * npx) continue;
                const int i = (int)__hip_atomic_fetch_add(qhead + 64 * q, 1u, RLX_AGENT); if (i < 32 * npx) return (q << 20) | i; }
            return -1; };
        if (tid == 0) qslot[0] = fetch(myx);
        __syncthreads();
        for (int it = 0;; ++it) {
            const int code = qslot[it & 1];
            if (code < 0) break;
            if (tid == 0) qslot[(it + 1) & 1] = fetch(myx);
            const int q = code >> 20, i = code & 0xfffff, npx = (P - q + 7) >> 3;
            const bool second = i >= 16 * npx; const int i2 = second ? i - 16 * npx : i;
            const int pass = q + 8 * (i2 >> 4), pe = ptab[pass], j = i2 & 15, e = pe & 255, p0 = (pe >> 8) * moe2::MT;
            const int Me = ecl[e], rb = bstart[e];
            const int mrows = (Me - p0) < moe2::MT ? (Me - p0) : moe2::MT;
            if (!second) {
                const int* rt = rowtok + e * 8192;
                auto rowfn = [=](int R) -> unsigned { int rr = p0 + R; rr = rr < Me ? rr : Me - 1; return (unsigned)rt[rr] * (unsigned)(D * 2); };
                moe2::tile<1>(lds, (const unsigned char*)Hb, rowfn, w_eg + (size_t)e * D * EDIM + j * 64, w_eu + (size_t)e * D * EDIM + j * 64, EDIM,
                              (mrows + 15) >> 4, mrows, HB + (size_t)(rb + p0) * EDIM + j * 64, EDIM, tid, pcnt + pass);
            } else {
                if (wave >= 4) {
                    unsigned sp = 0;
                    while ((unsigned)__builtin_amdgcn_readfirstlane(__hip_atomic_load(pcnt + pass, RLX_AGENT)) < 64u) {
                        __builtin_amdgcn_s_sleep(2);
                        if ((++sp & 255u) == 0u) { if (__hip_atomic_load(ctl + CW_TMO, RLX_AGENT) != 0u) break; if (sp > (1u << 20)) { if (lane == 0) __hip_atomic_store(ctl + CW_TMO, 0x5A5u, RLX_AGENT); break; } } }
                    __builtin_amdgcn_fence(__ATOMIC_ACQUIRE, "agent");
                    asm volatile("s_waitcnt vmcnt(0)" ::: "memory");
                }
                auto rowfn = [=](int R) -> unsigned { int rr = p0 + R; rr = rr < Me ? rr : Me - 1; return (unsigned)(rb + rr) * (unsigned)(EDIM * 2); };
                moe2::tile<2>(lds, (const unsigned char*)HB, rowfn, w_ed + (size_t)e * EDIM * D + j * 128, nullptr, D,
                              (mrows + 15) >> 4, mrows, YB + (size_t)(rb + p0) * D + j * 128, D, tid);
            }
        }
        __syncthreads();
    }
    SEAM(11);

    if (IN(12)) {
        const int gw = bid * NWAVES + wave, NGW = G * NWAVES;
        for (int row = gw; row < T; row += NGW) {
            const int b = row >> 12; const int* rt = route + (size_t)row * 8;
            const int r0 = bstart[rt[0]] + rt[1], r1 = bstart[rt[2]] + rt[3];
            const float w0 = __builtin_bit_cast(float, rt[4]), w1 = __builtin_bit_cast(float, rt[5]);
            const GAS v2u* xr = (const GAS v2u*)(X1 + (size_t)row * D) + lane;
            const GAS v2u* y0 = (const GAS v2u*)(YB + (size_t)r0 * D) + lane; const GAS v2u* y1 = (const GAS v2u*)(YB + (size_t)r1 * D) + lane;
            f32x4 v[8]; float ss = 0.f;
#pragma unroll
            for (int j = 0; j < 8; ++j) { const int k = 4 * lane + 256 * j;
                const f32x4 g2 = *(const GAS f32x4*)(mod + b * 12288 + 5 * 2048 + k);
                const v2u a = y0[64 * j], bq = y1[64 * j];
                f32x4 f; f.x = w0 * bf2f(a.x & 0xffffu) + w1 * bf2f(bq.x & 0xffffu); f.y = w0 * bf2f(a.x >> 16) + w1 * bf2f(bq.x >> 16);
                f.z = w0 * bf2f(a.y & 0xffffu) + w1 * bf2f(bq.y & 0xffffu); f.w = w0 * bf2f(a.y >> 16) + w1 * bf2f(bq.y >> 16);
#ifdef DBG_SKIP_MOE
                { const v2u xb = xr[64 * j]; v[j] = (f32x4){bf2f(xb.x & 0xffffu), bf2f(xb.x >> 16), bf2f(xb.y & 0xffffu), bf2f(xb.y >> 16)}; }
#else
                { const v2u xb = xr[64 * j]; v[j] = (f32x4){bf2f(xb.x & 0xffffu), bf2f(xb.x >> 16), bf2f(xb.y & 0xffffu), bf2f(xb.y >> 16)} + g2 * f; }
#endif
                ss += (v[j].x * v[j].x + v[j].y * v[j].y) + (v[j].z * v[j].z + v[j].w * v[j].w); }
            const float r = 1.0f / sqrtf(wave_sum(ss) * (1.0f / D) + EPS);
            GAS f32x4* o = (GAS f32x4*)(args.out + (size_t)row * D) + lane;
#pragma unroll
            for (int j = 0; j < 8; ++j) { const f32x4 g = *(const GAS f32x4*)(final_gain + 4 * lane + 256 * j); o[64 * j] = v[j] * r * g; }
        }
    }
#undef IN
#undef SEAM
}


#ifdef DBG_TAP
__global__ void tap_kernel(unsigned char* ws, float* out, int mode) {
    const bf16* Hb = (const bf16*)(ws + WS_H); const bf16* P = (const bf16*)(ws + WS_P);
    const bf16* Vta = (const bf16*)(ws + WS_VTA); const bf16* Vtr = (const bf16*)(ws + WS_VTR); const bf16* Krt = (const bf16*)(ws + WS_KRT);
    const float* SC = (const float*)(ws + WS_SC); const bf16* ST = (const bf16*)(ws + WS_ST);
    const bf16* ATT = (const bf16*)(ws + WS_ATTN); const bf16* RET = (const bf16*)(ws + WS_RET); const bf16* MG = (const bf16*)(ws + WS_MERGED);
    const bf16* X1 = (const bf16*)(ws + WS_X1); const float* mod = (const float*)(ws + WS_MOD);
    for (size_t i = (size_t)blockIdx.x * blockDim.x + threadIdx.x; i < (size_t)T * D; i += (size_t)gridDim.x * blockDim.x) {
        const int row = (int)(i >> 11), c = (int)(i & 2047), b = row >> 12, s = row & 4095; float v = 0.f;
        if (mode == 0) v = mod[(i % 24576)];
        if (mode == 1) v = bf2f(Hb[i]);
        if (mode == 2) { v = bf2f(P[(size_t)row * NPROJ + c]) + bf2f(P[(size_t)row * NPROJ + C_QR + c]) + bf2f(P[(size_t)row * NPROJ + C_KR + c]) + bf2f(P[(size_t)row * NPROJ + C_GR + c]) + bf2f(P[(size_t)row * NPROJ + C_GA + c]) + bf2f(P[(size_t)row * NPROJ + C_GT + c])
                 + bf2f(P[(size_t)row * NPROJ + C_KA + (c & 255)]) + bf2f(Vtr[(size_t)(b * 2048 + c) * 4096 + s]) + bf2f(Krt[(size_t)(b * 2048 + c) * 4096 + s]) + bf2f(Vta[(size_t)(b * 256 + (c & 255)) * 4096 + s]); }
        if (mode == 3) { v = bf2f(ATT[i]); for (int j = 0; j < 4; ++j) v += SC[i * 4 + j] * 0.01f; }
        if (mode == 4) { for (int j = 0; j < 2; ++j) v += bf2f(ST[i * 2 + j]); }
        if (mode == 5) v = bf2f(RET[i]);
        if (mode == 6) v = bf2f(MG[i]);
        if (mode == 7) v = bf2f(X1[i]);
        out[i] = v;
    }
}
#endif

#ifdef DBG_STREAM
__global__ void __launch_bounds__(512, 2) probe_stream(const float* w_eg, const float* w_eu, float* dump, const bf16* hb) {
    const int tid = threadIdx.x, lane = tid & 63, wave = tid >> 6, bid = blockIdx.x, G = gridDim.x;
    f32x4 s = {0.f, 0.f, 0.f, 0.f};
    for (int L = bid; L < 1024; L += G) {
        const int lx = L & 7, li = (L >> 3) & 31, r = L >> 8; const int e = 8 * lx + 2 * r + (li >> 4), j = li & 15;
        const int mat = wave & 1, kq = wave >> 1, kg = lane >> 4, cq = lane & 15;
        const float* base = (mat ? w_eu : w_eg) + (size_t)e * D * EDIM + j * 64 + (size_t)(16 * kq + 4 * kg) * EDIM + 4 * cq;
#if DBG_STREAM == 2
        { extern __shared__ __attribute__((aligned(16))) unsigned char plds[];
          auto rowfn = [=](int R) -> unsigned { return (unsigned)(((e * 131 + R * 7 + j) & 8191)) * 4096u; };
          moe2::tile<1, DBG_NOMMA, DBG_NOLOAD>((LAS unsigned char*)plds, (const unsigned char*)hb, rowfn, w_eg + (size_t)e * D * EDIM + j * 64, w_eu + (size_t)e * D * EDIM + j * 64, EDIM, 17, 272, (bf16*)dump + (size_t)bid * 320 * 1024, 1024, tid); }
#endif
#if DBG_STREAM == 1
        for (int kt = 0; kt < 32; kt += DBG_DEPTH) {
            f32x4 v[DBG_DEPTH][4];
#pragma unroll
            for (int t = 0; t < DBG_DEPTH; ++t)
#pragma unroll
                for (int q = 0; q < 4; ++q) v[t][q] = __builtin_nontemporal_load((const GAS f32x4*)(base + (size_t)((kt + t) * 64 + q) * EDIM));
#pragma unroll
            for (int t = 0; t < DBG_DEPTH; ++t)
#pragma unroll
                for (int q = 0; q < 4; ++q) s += v[t][q];
        }
#endif
    }
    if (s.x + s.y + s.z + s.w == 12345.678f) dump[tid] = s.x;
}
#endif
constexpr int NPHASES = 13;
#ifndef MK_ONE_LAUNCH
#define MK_ONE_LAUNCH 0
#endif
extern "C" void kernel_launch(void* const* d_in, const int* in_sizes, int n_in, void* d_out, int out_size, void* d_ws, size_t ws_size, hipStream_t stream) {
    static int grid = 0;
    if (grid == 0) {
        if (n_in != 21 || out_size != T * D || ws_size < WS_END) { fprintf(stderr, "kernel_launch: unexpected shapes (n_in %d out %d ws %zu)\n", n_in, out_size, ws_size); grid = -1; return; }
        int dev = 0, cus = 0, per_cu = 0;
        if (hipGetDevice(&dev) != hipSuccess || hipDeviceGetAttribute(&cus, hipDeviceAttributeMultiprocessorCount, dev) != hipSuccess) { grid = -1; return; }
        if (hipFuncSetAttribute((const void*)fwd_kernel, hipFuncAttributeMaxDynamicSharedMemorySize, LDS_BYTES) != hipSuccess) { fprintf(stderr, "kernel_launch: hipFuncSetAttribute failed\n"); grid = -1; return; }
        if (hipOccupancyMaxActiveBlocksPerMultiprocessor(&per_cu, (const void*)fwd_kernel, NTHR, LDS_BYTES) != hipSuccess || per_cu < 1) { fprintf(stderr, "kernel_launch: occupancy query says %d\n", per_cu); }
        (void)hipGetLastError();
        grid = cus;
    }
    if (grid < 0) return;
    if (hipMemsetAsync((char*)d_ws + WS_CTL, 0, CTL_ZERO_BYTES, stream) != hipSuccess) return;
    Args a{};
    for (int i = 0; i < 21; ++i) a.in[i] = d_in[i];
    a.out = (float*)d_out; a.ws = (unsigned char*)d_ws;
#if MK_ONE_LAUNCH
#ifdef DBG_REP
    a.ph_lo = 0; a.ph_hi = DBG_REP_HI + 1; a.bar_region = 0; hipLaunchKernelGGL(fwd_kernel, dim3(grid), dim3(NTHR), LDS_BYTES, stream, a);
    (void)hipMemsetAsync((char*)d_ws + WS_CTL + (size_t)CW_PCNT * 4, 0, 65536, stream);
#ifdef DBG_VARIANT
    a.pad = DBG_VARIANT;
#endif
    a.ph_lo = DBG_REP; a.ph_hi = DBG_REP_HI + 1; a.bar_region = 1; hipLaunchKernelGGL(fwd_kernel, dim3(grid), dim3(NTHR), LDS_BYTES, stream, a);
    a.pad = 0;
    if (DBG_REP_HI + 1 < NPHASES) { a.ph_lo = DBG_REP_HI + 1; a.ph_hi = NPHASES; a.bar_region = 2; hipLaunchKernelGGL(fwd_kernel, dim3(grid), dim3(NTHR), LDS_BYTES, stream, a); }
#else
    a.ph_lo = 0; a.ph_hi = NPHASES;
    hipLaunchKernelGGL(fwd_kernel, dim3(grid), dim3(NTHR), LDS_BYTES, stream, a);
#ifdef DBG_STREAM
    { static bool once = false; if (!once) { once = true; (void)hipFuncSetAttribute((const void*)probe_stream, hipFuncAttributeMaxDynamicSharedMemorySize, LDS_BYTES); }
      hipLaunchKernelGGL(probe_stream, dim3(grid), dim3(512), (DBG_STREAM == 2 ? LDS_BYTES : 0), stream, (const float*)d_in[18], (const float*)d_in[19], (float*)((char*)d_ws + WS_END), (const bf16*)((char*)d_ws + WS_H)); }
#endif
#endif
#else
#ifdef DBG_TAP
    for (int p = 0; p <= DBG_TAP; ++p) { a.ph_lo = p; a.ph_hi = p + 1; hipLaunchKernelGGL(fwd_kernel, dim3(grid), dim3(NTHR), LDS_BYTES, stream, a); }
    hipLaunchKernelGGL(tap_kernel, dim3(2048), dim3(256), 0, stream, (unsigned char*)d_ws, (float*)d_out, (int)DBG_TAPMODE);
#else
    for (int p = 0; p < NPHASES; ++p) { a.ph_lo = p; a.ph_hi = p + 1; hipLaunchKernelGGL(fwd_kernel, dim3(grid), dim3(NTHR), LDS_BYTES, stream, a); }
#endif
#endif
}
```

```cpp
#define MK_ONE_LAUNCH 1
#include <hip/hip_runtime.h>
#include <cstdio>
#include <cstdint>
#include <cmath>
namespace pg8 {
#define PG8_LAS __attribute__((address_space(3)))
typedef unsigned short bf16_t;
typedef short bf16x8 __attribute__((ext_vector_type(8)));
typedef float f32x4 __attribute__((ext_vector_type(4)));
typedef unsigned u32x4 __attribute__((ext_vector_type(4)));
constexpr int BM = 256, BK = 64, HALF = 128, HTB = HALF * BK * 2  , STAGE_BYTES = 8 * HTB, NXCD = 8, WGM = 8;

__host__ __device__ __forceinline__ int lds_byte(int r, int c) { const int st = (r >> 4) * 2 + (c >> 5), rr = r & 15, cc = c & 31, ob = rr * 64 + cc * 2; return st * 1024 + (ob ^ (((ob >> 9) & 1) << 5)); }
__host__ __device__ __forceinline__ void stage_rc(int b, int& R, int& C) { const int st = b / 1024, sb = b % 1024, swz = sb ^ (((sb >> 9) & 1) << 5); R = (st >> 1) * 16 + swz / 64; C = (st & 1) * 32 + (swz % 64) / 2; }
__host__ __device__ __forceinline__ int perm32(int rho) { const int n = rho >> 4, i = rho & 15; return 8 * (i >> 2) + 4 * n + (i & 3); }

struct Unit { int pm, pn; };
struct Gemm { const bf16_t* A; const bf16_t* Bt; int M, N, K; };

struct StaticOrder {
    int nM, nN, nwg, G, c, wgm;
    __host__ __device__ void init(int M, int N, int G_, int c_, int wgm_ = WGM) { nM = M / BM; nN = N / BM; nwg = nM * nN; G = G_; c = c_; wgm = wgm_; }
    __host__ __device__ bool next(int i, Unit& u) const {
        const long L = (long)i * G + c; if (L >= nwg) return false;
        int wgid = (int)L; { const int q = nwg / NXCD, r = nwg % NXCD, xcd = wgid % NXCD, off = wgid / NXCD; wgid = (xcd < r ? xcd * (q + 1) : r * (q + 1) + (xcd - r) * q) + off; }
        const int nig = wgm * nN, gid = wgid / nig, fm = gid * wgm, gsz = (nM - fm) < wgm ? (nM - fm) : wgm;
        u.pm = fm + ((wgid % nig) % gsz); u.pn = (wgid % nig) / gsz; return true;
    }
    __device__ __forceinline__ void a_ready(const Unit&) const {}
    __device__ __forceinline__ void done(const Unit&) const {}
};

typedef float cvt_f32x2_t __attribute__((ext_vector_type(2))); typedef __bf16 cvt_bf16x2_t __attribute__((ext_vector_type(2)));
__device__ __forceinline__ unsigned cvt_pk_bf16(float lo, float hi) { cvt_f32x2_t v = {lo, hi}; cvt_bf16x2_t b = __builtin_convertvector(v, cvt_bf16x2_t); return __builtin_bit_cast(unsigned, b); }
template <class Epi, class Sched, bool ALIGN_EPI = false, bool SP2 = false>
__device__ __forceinline__ void gemm_phase(PG8_LAS unsigned char* lds, const Gemm g, const Sched& S, const Epi& E) {
    const int tid = threadIdx.x, wid = __builtin_amdgcn_readfirstlane(tid >> 6), lane = tid & 63, wr = wid >> 2, wc = wid & 3, fr = lane & 15, fq = lane >> 4;
    const int K = g.K, nt = K / BK;
    unsigned voffA[2], voffB[2];
#pragma unroll
    for (int i = 0; i < 2; ++i) { int R, C; stage_rc(tid * 16 + i * 8192, R, C); const int Rb = Epi::PERM ? ((R & ~31) + perm32(R & 31)) : R;
        voffA[i] = (unsigned)(R * K + C) * 2u; voffB[i] = (unsigned)(Rb * K + C) * 2u; }
    const size_t kstep = (size_t)(BK * 2);
    const size_t hstep = (size_t)HALF * K * 2;
    const size_t tstep = 2 * hstep;
    const unsigned ldsw = (unsigned)wid * 1024u;
    const int aoff = lds_byte(wr * 64 + fr, fq * 8), boff = lds_byte(wc * 32 + fr, fq * 8);
#define PG8_SA(b, h) (((b) * 2 + (h)) * HTB)
#define PG8_SB(b, h) ((4 + (b) * 2 + (h)) * HTB)
#define PG8_STAGE(bufoff, gbase, voff) do { _Pragma("unroll") for (int _i = 0; _i < 2; ++_i) \
        __builtin_amdgcn_global_load_lds((const unsigned*)((const char*)(gbase) + (voff)[_i]), (PG8_LAS unsigned*)(lds + (bufoff) + ldsw + _i * 8192), 16, 0, 0); } while (0)
#define PG8_LDA(dst, b, h) do { _Pragma("unroll") for (int m = 0; m < 4; ++m) _Pragma("unroll") for (int k = 0; k < 2; ++k) dst[m][k] = *(const PG8_LAS bf16x8*)(lds + PG8_SA(b, h) + aoff + m * 2048 + k * 1024); } while (0)
#define PG8_LDB(dst, b, h) do { _Pragma("unroll") for (int n = 0; n < 2; ++n) _Pragma("unroll") for (int k = 0; k < 2; ++k) dst[n][k] = *(const PG8_LAS bf16x8*)(lds + PG8_SB(b, h) + boff + n * 2048 + k * 1024); } while (0)
#define PG8_MMA(ai, bj, At, Bt) do { __builtin_amdgcn_s_setprio(1); _Pragma("unroll") for (int m = 0; m < 4; ++m) _Pragma("unroll") for (int n = 0; n < 2; ++n) _Pragma("unroll") for (int k = 0; k < 2; ++k) \
        acc[ai][bj][m][n] = __builtin_amdgcn_mfma_f32_16x16x32_bf16(Bt[n][k], At[m][k], acc[ai][bj][m][n], 0, 0, 0); __builtin_amdgcn_s_setprio(0); } while (0)
#define PG8_WAIT_V(n) asm volatile("s_waitcnt vmcnt(" #n ")" ::: "memory")
#define PG8_WAIT_L(n) asm volatile("s_waitcnt lgkmcnt(" #n ")" ::: "memory")
#define PG8_BAR __builtin_amdgcn_s_barrier()
#define PG8_SCHED __builtin_amdgcn_sched_barrier(0)
    Unit cur, nxt; int ui = 0;
    if (!S.next(0, cur)) return;
    f32x4 acc[2][2][4][2];
#pragma unroll
    for (int a = 0; a < 2; ++a)
#pragma unroll
        for (int b = 0; b < 2; ++b)
#pragma unroll
            for (int m = 0; m < 4; ++m)
#pragma unroll
                for (int n = 0; n < 2; ++n) acc[a][b][m][n] = (f32x4){0.f, 0.f, 0.f, 0.f};
    bf16x8 At[4][2], B0[2][2], B1[2][2];
    const char* cA = (const char*)g.A + (size_t)cur.pm * tstep; const char* cB = (const char*)g.Bt + (size_t)cur.pn * tstep;
    S.a_ready(cur);
    if constexpr (SP2) {
        PG8_STAGE(PG8_SB(0, 0), cB, voffB); PG8_STAGE(PG8_SB(0, 1), cB + hstep, voffB); PG8_STAGE(PG8_SA(0, 0), cA, voffA); PG8_STAGE(PG8_SA(0, 1), cA + hstep, voffA);
        if (wr == 1) PG8_BAR;
        PG8_WAIT_V(2); PG8_BAR;
        PG8_STAGE(PG8_SB(1, 0), cB + kstep, voffB); PG8_STAGE(PG8_SA(1, 0), cA + kstep, voffA); PG8_STAGE(PG8_SB(1, 1), cB + hstep + kstep, voffB);
        PG8_WAIT_V(6); PG8_BAR;
    } else {
        PG8_STAGE(PG8_SB(0, 0), cB, voffB); PG8_STAGE(PG8_SA(0, 0), cA, voffA); PG8_STAGE(PG8_SB(0, 1), cB + hstep, voffB); PG8_STAGE(PG8_SA(0, 1), cA + hstep, voffA);
        if (wr == 1) PG8_BAR;
        PG8_WAIT_V(4); PG8_BAR;
        PG8_STAGE(PG8_SB(1, 0), cB + kstep, voffB); PG8_STAGE(PG8_SA(1, 0), cA + kstep, voffA); PG8_STAGE(PG8_SB(1, 1), cB + hstep + kstep, voffB);
        PG8_WAIT_V(6); PG8_BAR;
    }
    for (;;) {
        const bool has_next = S.next(ui + 1, nxt);
        const char* nA = has_next ? (const char*)g.A + (size_t)nxt.pm * tstep : cA; const char* nB = has_next ? (const char*)g.Bt + (size_t)nxt.pn * tstep : cB;
        for (int t = 0; t < nt; t += 2) {
            const bool last = (t == nt - 2);
            const char* a1 = cA + (size_t)(t + 1) * kstep;
            const char* a2 = last ? nA : cA + (size_t)(t + 2) * kstep; const char* b2 = last ? nB : cB + (size_t)(t + 2) * kstep;
            const char* a3 = a2 + kstep; const char* b3 = b2 + kstep;
            if (last && has_next) S.a_ready(nxt);
            if constexpr (SP2) {
            PG8_LDB(B0, 0, 0); PG8_LDB(B1, 0, 1); PG8_SCHED; PG8_LDA(At, 0, 0); PG8_STAGE(PG8_SA(1, 1), a1 + hstep, voffA);
            PG8_WAIT_V(8); PG8_WAIT_L(0); PG8_BAR; PG8_MMA(0, 0, At, B0); PG8_MMA(0, 1, At, B1); PG8_BAR; PG8_SCHED;
            PG8_LDA(At, 0, 1); PG8_STAGE(PG8_SB(0, 0), b2, voffB); PG8_STAGE(PG8_SB(0, 1), b2 + hstep, voffB); PG8_STAGE(PG8_SA(0, 0), a2, voffA);
            PG8_WAIT_V(8); PG8_WAIT_L(0); PG8_BAR; PG8_MMA(1, 0, At, B0); PG8_MMA(1, 1, At, B1); PG8_BAR; PG8_SCHED;
            PG8_LDB(B0, 1, 0); PG8_LDB(B1, 1, 1); PG8_SCHED; PG8_LDA(At, 1, 0); PG8_STAGE(PG8_SA(0, 1), a2 + hstep, voffA);
            PG8_WAIT_V(8); PG8_WAIT_L(0); PG8_BAR; PG8_MMA(0, 0, At, B0); PG8_MMA(0, 1, At, B1); PG8_BAR; PG8_SCHED;
            PG8_LDA(At, 1, 1); PG8_STAGE(PG8_SB(1, 0), b3, voffB); PG8_STAGE(PG8_SB(1, 1), b3 + hstep, voffB); PG8_STAGE(PG8_SA(1, 0), a3, voffA);
            PG8_WAIT_V(8); PG8_WAIT_L(0); PG8_BAR; PG8_MMA(1, 0, At, B0); PG8_MMA(1, 1, At, B1); PG8_BAR; PG8_SCHED;
            } else {
            PG8_LDB(B0, 0, 0); PG8_SCHED; PG8_LDA(At, 0, 0); PG8_STAGE(PG8_SA(1, 1), a1 + hstep, voffA);
            PG8_WAIT_L(8); PG8_BAR; PG8_WAIT_L(0); PG8_MMA(0, 0, At, B0); PG8_BAR; PG8_SCHED;
            PG8_LDB(B1, 0, 1); PG8_STAGE(PG8_SB(0, 0), b2, voffB);
            PG8_BAR; PG8_WAIT_L(0); PG8_MMA(0, 1, At, B1); PG8_BAR;
            PG8_LDA(At, 0, 1); PG8_STAGE(PG8_SA(0, 0), a2, voffA);
            PG8_BAR; PG8_WAIT_L(0); PG8_MMA(1, 0, At, B0); PG8_BAR; PG8_SCHED;
            PG8_STAGE(PG8_SB(0, 1), b2 + hstep, voffB);
            PG8_WAIT_V(6); PG8_BAR; PG8_MMA(1, 1, At, B1); PG8_BAR;
            PG8_LDB(B0, 1, 0); PG8_SCHED; PG8_LDA(At, 1, 0); PG8_STAGE(PG8_SA(0, 1), a2 + hstep, voffA);
            PG8_WAIT_L(8); PG8_BAR; PG8_WAIT_L(0); PG8_MMA(0, 0, At, B0); PG8_BAR; PG8_SCHED;
            PG8_LDB(B1, 1, 1); PG8_STAGE(PG8_SB(1, 0), b3, voffB);
            PG8_BAR; PG8_WAIT_L(0); PG8_MMA(0, 1, At, B1); PG8_BAR;
            PG8_LDA(At, 1, 1); PG8_STAGE(PG8_SA(1, 0), a3, voffA);
            PG8_BAR; PG8_WAIT_L(0); PG8_MMA(1, 0, At, B0); PG8_BAR; PG8_SCHED;
            PG8_STAGE(PG8_SB(1, 1), b3 + hstep, voffB);
            PG8_WAIT_V(6); PG8_BAR; PG8_MMA(1, 1, At, B1); PG8_BAR;
            }
        }
        if constexpr (ALIGN_EPI) { if (wr == 0) PG8_BAR; }
        if constexpr (!Epi::AFTER_DRAIN) { E(acc, cur, wr, wc, fr, fq); S.done(cur); }
        if (!has_next) break;
#pragma unroll
        for (int a = 0; a < 2; ++a)
#pragma unroll
            for (int b = 0; b < 2; ++b)
#pragma unroll
                for (int m = 0; m < 4; ++m)
#pragma unroll
                    for (int n = 0; n < 2; ++n) acc[a][b][m][n] = (f32x4){0.f, 0.f, 0.f, 0.f};
        cur = nxt; cA = nA; cB = nB; ++ui;
        if constexpr (ALIGN_EPI) { if (wr == 1) PG8_BAR; }
    }
    PG8_WAIT_V(0);
    if constexpr (!ALIGN_EPI) { if (wr == 0) PG8_BAR; }
    PG8_BAR;
    if constexpr (Epi::AFTER_DRAIN) { E.fused(acc, cur, wr, wc, fr, fq, lds, wid, lane); S.done(cur); }
#undef PG8_SA
#undef PG8_SB
#undef PG8_STAGE
#undef PG8_LDA
#undef PG8_LDB
#undef PG8_MMA
#undef PG8_WAIT_V
#undef PG8_WAIT_L
#undef PG8_BAR
#undef PG8_SCHED
}
}

#ifndef WGM_PROJ
#define WGM_PROJ 2
#endif
#ifndef WGM_SQ
#define WGM_SQ 4
#endif
#ifndef GK_ALIGN
#define GK_ALIGN true
#endif
#ifndef GK_ALIGN1
#define GK_ALIGN1 true
#endif
#ifndef GK_SP2
#define GK_SP2 true
#endif
constexpr int NWAVES = 8, NTHR = 512;
constexpr int BATCH = 2, SEQ = 4096, T = BATCH * SEQ, D = 2048;
constexpr int NPROJ = 14848;
constexpr int C_QA = 0, C_KA = 2048, C_VA = 2304, C_QR = 2560, C_KR = 4608, C_VR = 6656, C_GR = 8704, C_GA = 10752, C_GT = 12800;
constexpr int NEXP = 64, EDIM = 1024;
constexpr float EPS = 1e-6f;
constexpr float LOG2E = 1.4426950408889634f;
constexpr float QA_SCALE = 0.125f * LOG2E;

constexpr size_t MiB = 1u << 20;
constexpr size_t WS_CTL = 0, CTL_ZERO_BYTES = 1 * MiB;
constexpr size_t WS_MOD = 1 * MiB;
constexpr size_t WS_ROPE = 2 * MiB;
constexpr size_t WS_WIN = 10 * MiB;
constexpr size_t WS_WBA = 68 * MiB, WS_WBR = 76 * MiB, WS_WOUT = 84 * MiB;
constexpr size_t WS_ROUTE = 92 * MiB;
constexpr size_t WS_WRT = 94 * MiB;
constexpr size_t WS_H = 96 * MiB;
constexpr size_t WS_X1 = 128 * MiB;
constexpr size_t WS_P = 192 * MiB;
constexpr size_t WS_VTA = 424 * MiB;
constexpr size_t WS_VTR = 428 * MiB;
constexpr size_t WS_KRT = 460 * MiB;
constexpr size_t WS_SC = 492 * MiB;
constexpr size_t WS_ST = 620 * MiB;
constexpr size_t WS_ATTN = 684 * MiB;
constexpr size_t WS_RET = 716 * MiB;
constexpr size_t WS_M1 = 748 * MiB;
constexpr size_t WS_MERGED = 812 * MiB;
constexpr size_t WS_XG = 192 * MiB;
constexpr size_t WS_HB = 320 * MiB;
constexpr size_t WS_Y = 384 * MiB;
constexpr size_t WS_RTOK = 848 * MiB;
constexpr size_t WS_END = 850 * MiB;

constexpr int CW_TMO = 0, CW_BAR = 4096, CW_CNT = 16384, CW_PCNT = 20480, CW_QHEAD = 24576;

constexpr int RING_BYTES = 131072;
constexpr int MISC_OFF = 155648;
constexpr int MISC_BYTES = 8192;
constexpr int LDS_BYTES = MISC_OFF + MISC_BYTES;

#define GAS __attribute__((address_space(1)))
#define LAS __attribute__((address_space(3)))
typedef unsigned short bf16;
typedef unsigned v4u __attribute__((ext_vector_type(4)));
typedef unsigned v2u __attribute__((ext_vector_type(2)));
typedef float f32x4 __attribute__((ext_vector_type(4)));
typedef short bf16x8 __attribute__((ext_vector_type(8)));
typedef GAS unsigned gu32;
#define RLX_AGENT __ATOMIC_RELAXED, __HIP_MEMORY_SCOPE_AGENT
#define LDS_WAIT() asm volatile("s_waitcnt lgkmcnt(0)" ::: "memory")
#define VM_WAIT() asm volatile("s_waitcnt vmcnt(0)" ::: "memory")
__device__ __forceinline__ unsigned pk2(float lo, float hi) { return pg8::cvt_pk_bf16(lo, hi); }
__device__ __forceinline__ unsigned f2bf(float f) { return pg8::cvt_pk_bf16(f, f) & 0xffffu; }
__device__ __forceinline__ float bf2f(unsigned b) { return __builtin_bit_cast(float, b << 16); }
__device__ __forceinline__ float wave_sum(float v) {
#pragma unroll
    for (int o = 1; o < 64; o <<= 1) v += __shfl_xor(v, o);
    return v;
}
#define DPP_F(v, ctrl) __builtin_bit_cast(float, __builtin_amdgcn_update_dpp(0, __builtin_bit_cast(int, (v)), (ctrl), 0xF, 0xF, true))
__device__ __forceinline__ float sum16(float v) { v += DPP_F(v, 0xB1); v += DPP_F(v, 0x4E); v += DPP_F(v, 0x141); v += DPP_F(v, 0x140); return v; }
__device__ __forceinline__ float max16(float v) { v = fmaxf(v, DPP_F(v, 0xB1)); v = fmaxf(v, DPP_F(v, 0x4E)); v = fmaxf(v, DPP_F(v, 0x141)); v = fmaxf(v, DPP_F(v, 0x140)); return v; }
__device__ __forceinline__ float sigmoidf_(float x) { return __builtin_amdgcn_rcpf(1.0f + __builtin_amdgcn_exp2f(-1.4426950408889634f * x)); }
__device__ __forceinline__ float siluf_(float x) { return x * sigmoidf_(x); }

#define XB_TMO      128
#define XB_XCNT(j)  (256  + 64 * (j))
#define XB_XSUB(j)  (1280 + 64 * (j))
#define XB_XGEN(j)  (2304 + 64 * (j))
#define XB_TOP      3328
#define XB_TOPGEN   3392
#define XCD_BAR_WORDS 3456
#define XB_SPIN_CAP (1u << 18)

__device__ __forceinline__ unsigned xb_ld(unsigned* p)              { return __hip_atomic_load(p, __ATOMIC_RELAXED, __HIP_MEMORY_SCOPE_AGENT); }
__device__ __forceinline__ unsigned xb_add(unsigned* p, unsigned v) { return __hip_atomic_fetch_add(p, v, __ATOMIC_RELAXED, __HIP_MEMORY_SCOPE_AGENT); }
__device__ __forceinline__ unsigned xb_xcc_id() { return (unsigned)__builtin_amdgcn_s_getreg((3 << 11) | 20) & 0xFu; }
#define XB_SPIN(cond, bar) do { unsigned _sp = 0; while (cond) { __builtin_amdgcn_s_sleep(1); \
    if ((++_sp & 255u) == 0u) { if (xb_ld(&(bar)[XB_TMO])) break; if (_sp > XB_SPIN_CAP) { atomicAdd(&(bar)[XB_TMO], 1u); break; } } } } while (0)

struct XcdBarrier {
    unsigned* bar; unsigned x;
    volatile LAS unsigned* st;
};

__device__ __forceinline__ XcdBarrier xcd_barrier_post(unsigned* bar, volatile LAS unsigned* st) {
    XcdBarrier b; b.bar = bar; b.x = xb_xcc_id(); b.st = st;
    if (threadIdx.x == 0) (void)xb_add(&bar[XB_XCNT(b.x)], 1u);
    return b;
}
__device__ __forceinline__ void xcd_barrier_complete(unsigned* bar, unsigned x, unsigned& nloc, unsigned& nx) {
    const unsigned G = gridDim.x * gridDim.y * gridDim.z;
    unsigned sum, cnt, mine, sp = 0u;
    for (;;) {
        sum = 0u; cnt = 0u; mine = 0u;
#pragma unroll
        for (unsigned j = 0; j < 16; ++j) { const unsigned c = xb_ld(&bar[XB_XCNT(j)]); sum += c; cnt += (c > 0u) ? 1u : 0u; mine = (j == x) ? c : mine; }
        if (sum == G) break;
        __builtin_amdgcn_s_sleep(1);
        if ((++sp & 255u) == 0u) { if (xb_ld(&bar[XB_TMO])) break; if (sp > XB_SPIN_CAP) { atomicAdd(&bar[XB_TMO], 1u); break; } }
    }
    nloc = mine > 0u ? mine : 1u; nx = cnt > 0u ? cnt : 1u;
}

__device__ __forceinline__ void xcd_barrier(const XcdBarrier& b) {
    asm volatile("s_waitcnt vmcnt(0)" ::: "memory");
    __syncthreads();
    if (threadIdx.x == 0) {
        unsigned* bar = b.bar;
        __builtin_amdgcn_s_waitcnt(0);
        unsigned nloc = b.st[0], nx = b.st[1];
        if (nloc == 0u) { xcd_barrier_complete(bar, b.x, nloc, nx); b.st[0] = nloc; b.st[1] = nx; }
        const unsigned old = xb_add(&bar[XB_XSUB(b.x)], 1u);
        const unsigned gen = old / nloc;
        if (old + 1u == (gen + 1u) * nloc) {
            __builtin_amdgcn_fence(__ATOMIC_RELEASE, "agent");
            asm volatile("s_waitcnt vmcnt(0)" ::: "memory");
            const unsigned og = xb_add(&bar[XB_TOP], 1u);
            const unsigned tg = og / nx;
            if (og + 1u == (tg + 1u) * nx) xb_add(&bar[XB_TOPGEN], 1u);
            else XB_SPIN(xb_ld(&bar[XB_TOPGEN]) == tg, bar);
            __builtin_amdgcn_fence(__ATOMIC_ACQUIRE, "agent");
            xb_add(&bar[XB_XGEN(b.x)], 1u);
            asm volatile("s_waitcnt vmcnt(0)" ::: "memory");
        } else {
            XB_SPIN(xb_ld(&bar[XB_XGEN(b.x)]) == gen, bar);
            __builtin_amdgcn_fence(__ATOMIC_ACQUIRE, "agent");
            asm volatile("s_waitcnt vmcnt(0)" ::: "memory");
        }
    }
    __syncthreads();
}


struct Args { const void* in[21]; float* out; unsigned char* ws; int ph_lo, ph_hi, bar_region, pad; };

__device__ __forceinline__ f32x4 mma16(bf16x8 a, bf16x8 b, f32x4 c) { return __builtin_amdgcn_mfma_f32_16x16x32_bf16(a, b, c, 0, 0, 0); }
__device__ __forceinline__ bf16x8 ldg8(const bf16* p) { return *(const GAS bf16x8*)p; }

namespace pg8 {
__device__ __forceinline__ void tstore4(bf16* colp_even_tok  , f32x4 v, int odd) {
    const unsigned w01 = cvt_pk_bf16(v[0], v[1]), w23 = cvt_pk_bf16(v[2], v[3]);
    const unsigned snd = odd ? w01 : w23;
    const unsigned rcv = (unsigned)__builtin_amdgcn_update_dpp(0, (int)snd, 0xB1, 0xF, 0xF, true);
    const unsigned own = odd ? w23 : w01;
    const unsigned a = odd ? rcv : own, b = odd ? own : rcv;
    const unsigned p0 = (a & 0xffffu) | (b << 16), p1 = (a >> 16) | (b & 0xffff0000u);
    bf16* cp = colp_even_tok + (size_t)(odd ? 2 : 0) * 4096;
    *(unsigned*)cp = p0; *(unsigned*)(cp + 4096) = p1;
}
struct EpiProj {
    static constexpr bool PERM = true, AFTER_DRAIN = false;
    bf16* P; bf16* Vta; bf16* Vtr; bf16* Krt; const float* cosT; const float* sinT;
    __device__ __forceinline__ void operator()(const f32x4 (&acc)[2][2][4][2], const Unit& u, int wr, int wc, int fr, int fq) const {
        const int pn = u.pn;
        const int row0 = u.pm * BM + wr * 64 + fr;
        const int cl = wc * 32 + 8 * fq;
        if (pn == 9 || (pn >= 26 && pn < 34)) {
            bf16* base; int chan0, nchan;
            if (pn == 9) { base = Vta; chan0 = 0; nchan = 256; } else { base = Vtr; chan0 = (pn - 26) * 256; nchan = 2048; }
#pragma unroll
            for (int ai = 0; ai < 2; ++ai)
#pragma unroll
                for (int m = 0; m < 4; ++m) {
                    const int row = row0 + ai * HALF + m * 16; const int b = row >> 12, s = row & 4095;
                    bf16* colp = base + ((size_t)(b * nchan + chan0 + cl) * 4096 + (s & ~1));
#pragma unroll
                    for (int bj = 0; bj < 2; ++bj)
#pragma unroll
                        for (int n = 0; n < 2; ++n) tstore4(colp + (size_t)(bj * HALF + 4 * n) * 4096, acc[ai][bj][m][n], fr & 1);
                }
            return;
        }
        const bool rot = (pn >= 10 && pn < 26);
        const bool isk = (pn >= 18 && pn < 26);
        float lg2 = 0.f;
        if (isk) { const int h = pn - 18; lg2 = log1pf(-exp2f(-5.0f - (float)h)) * LOG2E; }
#pragma unroll
        for (int ai = 0; ai < 2; ++ai)
#pragma unroll
            for (int m = 0; m < 4; ++m) {
                const int row = row0 + ai * HALF + m * 16;
                f32x4 v[2][2];
#pragma unroll
                for (int bj = 0; bj < 2; ++bj)
#pragma unroll
                    for (int n = 0; n < 2; ++n) v[bj][n] = acc[ai][bj][m][n];
                if (rot) {
                    const float* cp = cosT + (size_t)row * 128 + cl; const float* sp = sinT + (size_t)row * 128 + cl;
#pragma unroll
                    for (int n = 0; n < 2; ++n) {
                        const f32x4 c = *(const f32x4*)(cp + 4 * n), s = *(const f32x4*)(sp + 4 * n);
                        const f32x4 t1 = v[0][n], t2 = v[1][n];
                        v[0][n] = t1 * c - t2 * s; v[1][n] = t1 * s + t2 * c;
                    }
                    if (isk) {
#pragma unroll
                        for (int n = 0; n < 2; ++n) { v[0][n] = v[0][n] * 0.0625f; v[1][n] = v[1][n] * 0.0625f; }
                    }
                } else if (pn < 8) {
#pragma unroll
                    for (int bj = 0; bj < 2; ++bj)
#pragma unroll
                        for (int n = 0; n < 2; ++n) v[bj][n] = v[bj][n] * QA_SCALE;
                } else if (pn >= 34 && pn < 42) {
#pragma unroll
                    for (int bj = 0; bj < 2; ++bj)
#pragma unroll
                        for (int n = 0; n < 2; ++n)
#pragma unroll
                            for (int i = 0; i < 4; ++i) v[bj][n][i] = siluf_(v[bj][n][i]);
                } else if (pn >= 42) {
#pragma unroll
                    for (int bj = 0; bj < 2; ++bj)
#pragma unroll
                        for (int n = 0; n < 2; ++n)
#pragma unroll
                            for (int i = 0; i < 4; ++i) v[bj][n][i] = sigmoidf_(v[bj][n][i]);
                }
                bf16* rowp = P + (size_t)row * NPROJ + pn * BM + cl;
#pragma unroll
                for (int bj = 0; bj < 2; ++bj) {
                    u32x4 w; w.x = cvt_pk_bf16(v[bj][0][0], v[bj][0][1]); w.y = cvt_pk_bf16(v[bj][0][2], v[bj][0][3]); w.z = cvt_pk_bf16(v[bj][1][0], v[bj][1][1]); w.w = cvt_pk_bf16(v[bj][1][2], v[bj][1][3]);
                    __builtin_nontemporal_store(w, (u32x4*)(rowp + bj * HALF));
                }
                if (isk) {
                    const int b = row >> 12, s = row & 4095;
                    const float dk = exp2f((float)(127 - (s & 127)) * lg2);
                    bf16* colp = Krt + ((size_t)(b * 2048 + (pn - 18) * 256 + cl) * 4096 + (s & ~1));
#pragma unroll
                    for (int bj = 0; bj < 2; ++bj)
#pragma unroll
                        for (int n = 0; n < 2; ++n) tstore4(colp + (size_t)(bj * HALF + 4 * n) * 4096, v[bj][n] * dk, fr & 1);
                }
            }
    }
};
struct EpiBranchA {
    static constexpr bool PERM = true, AFTER_DRAIN = false;
    const bf16* P; bf16* M1;
    __device__ __forceinline__ void operator()(const f32x4 (&acc)[2][2][4][2], const Unit& u, int wr, int wc, int fr, int fq) const {
        const int row0 = u.pm * BM + wr * 64 + fr, col0 = u.pn * BM + wc * 32 + 8 * fq;
#pragma unroll
        for (int ai = 0; ai < 2; ++ai)
#pragma unroll
            for (int m = 0; m < 4; ++m) { const int row = row0 + ai * HALF + m * 16;
#pragma unroll
                for (int bj = 0; bj < 2; ++bj) { const int col = col0 + bj * HALF;
                    const u32x4 g = *(const u32x4*)(P + (size_t)row * NPROJ + C_GA + col);
                    f32x4 o0, o1;
                    o0[0] = bf2f(g.x & 0xffffu) * acc[ai][bj][m][0][0]; o0[1] = bf2f(g.x >> 16) * acc[ai][bj][m][0][1]; o0[2] = bf2f(g.y & 0xffffu) * acc[ai][bj][m][0][2]; o0[3] = bf2f(g.y >> 16) * acc[ai][bj][m][0][3];
                    o1[0] = bf2f(g.z & 0xffffu) * acc[ai][bj][m][1][0]; o1[1] = bf2f(g.z >> 16) * acc[ai][bj][m][1][1]; o1[2] = bf2f(g.w & 0xffffu) * acc[ai][bj][m][1][2]; o1[3] = bf2f(g.w >> 16) * acc[ai][bj][m][1][3];
                    u32x4 w; w.x = cvt_pk_bf16(o0[0], o0[1]); w.y = cvt_pk_bf16(o0[2], o0[3]); w.z = cvt_pk_bf16(o1[0], o1[1]); w.w = cvt_pk_bf16(o1[2], o1[3]);
                    *(u32x4*)(M1 + (size_t)row * D + col) = w; } }
    }
};
struct EpiBranchR {
    static constexpr bool PERM = true, AFTER_DRAIN = false;
    const bf16* P; const bf16* M1; bf16* MG;
    __device__ __forceinline__ void operator()(const f32x4 (&acc)[2][2][4][2], const Unit& u, int wr, int wc, int fr, int fq) const {
        const int row0 = u.pm * BM + wr * 64 + fr, col0 = u.pn * BM + wc * 32 + 8 * fq;
#pragma unroll
        for (int ai = 0; ai < 2; ++ai)
#pragma unroll
            for (int m = 0; m < 4; ++m) { const int row = row0 + ai * HALF + m * 16;
#pragma unroll
                for (int bj = 0; bj < 2; ++bj) { const int col = col0 + bj * HALF;
                    const u32x4 g = *(const u32x4*)(P + (size_t)row * NPROJ + C_GT + col);
                    const u32x4 mb = *(const u32x4*)(M1 + (size_t)row * D + col);
                    const f32x4 a0 = {bf2f(mb.x & 0xffffu), bf2f(mb.x >> 16), bf2f(mb.y & 0xffffu), bf2f(mb.y >> 16)}, a1 = {bf2f(mb.z & 0xffffu), bf2f(mb.z >> 16), bf2f(mb.w & 0xffffu), bf2f(mb.w >> 16)};
                    f32x4 o0, o1;
                    o0[0] = a0[0] + bf2f(g.x & 0xffffu) * acc[ai][bj][m][0][0]; o0[1] = a0[1] + bf2f(g.x >> 16) * acc[ai][bj][m][0][1]; o0[2] = a0[2] + bf2f(g.y & 0xffffu) * acc[ai][bj][m][0][2]; o0[3] = a0[3] + bf2f(g.y >> 16) * acc[ai][bj][m][0][3];
                    o1[0] = a1[0] + bf2f(g.z & 0xffffu) * acc[ai][bj][m][1][0]; o1[1] = a1[1] + bf2f(g.z >> 16) * acc[ai][bj][m][1][1]; o1[2] = a1[2] + bf2f(g.w & 0xffffu) * acc[ai][bj][m][1][2]; o1[3] = a1[3] + bf2f(g.w >> 16) * acc[ai][bj][m][1][3];
                    u32x4 w; w.x = cvt_pk_bf16(o0[0], o0[1]); w.y = cvt_pk_bf16(o0[2], o0[3]); w.z = cvt_pk_bf16(o1[0], o1[1]); w.w = cvt_pk_bf16(o1[2], o1[3]);
                    *(u32x4*)(MG + (size_t)row * D + col) = w; } }
    }
};
struct EpiOut {
    static constexpr bool PERM = true, AFTER_DRAIN = false;
    const float* x; const float* gate1; bf16* X1;
    __device__ __forceinline__ void operator()(const f32x4 (&acc)[2][2][4][2], const Unit& u, int wr, int wc, int fr, int fq) const {
        const int row0 = u.pm * BM + wr * 64 + fr, col0 = u.pn * BM + wc * 32 + 8 * fq;
        const int b = (u.pm * BM) >> 12;
        f32x4 gv[2][2];
#pragma unroll
        for (int bj = 0; bj < 2; ++bj)
#pragma unroll
            for (int n = 0; n < 2; ++n) gv[bj][n] = *(const f32x4*)(gate1 + (size_t)b * 12288 + col0 + bj * HALF + 4 * n);
#pragma unroll
        for (int ai = 0; ai < 2; ++ai)
#pragma unroll
            for (int m = 0; m < 4; ++m) { const size_t off = (size_t)(row0 + ai * HALF + m * 16) * D + col0;
#pragma unroll
                for (int bj = 0; bj < 2; ++bj) { const f32x4 x0 = *(const f32x4*)(x + off + bj * HALF), x1v = *(const f32x4*)(x + off + bj * HALF + 4);
                    const f32x4 o0 = x0 + gv[bj][0] * acc[ai][bj][m][0], o1 = x1v + gv[bj][1] * acc[ai][bj][m][1];
                    u32x4 w; w.x = cvt_pk_bf16(o0[0], o0[1]); w.y = cvt_pk_bf16(o0[2], o0[3]); w.z = cvt_pk_bf16(o1[0], o1[1]); w.w = cvt_pk_bf16(o1[2], o1[3]);
                    *(u32x4*)(X1 + off + bj * HALF) = w; } }
    }
};
struct EpiFfn1 {
    static constexpr bool PERM = true, AFTER_DRAIN = false;
    bf16* HB;
    __device__ __forceinline__ void operator()(const f32x4 (&acc)[2][2][4][2], const Unit& u, int wr, int wc, int fr, int fq) const {
        const int row0 = u.pm * BM + wr * 64 + fr, col0 = (u.pn & 7) * 128 + wc * 32 + 8 * fq;
#pragma unroll
        for (int ai = 0; ai < 2; ++ai)
#pragma unroll
            for (int m = 0; m < 4; ++m) { const int row = row0 + ai * HALF + m * 16;
                float h[8];
#pragma unroll
                for (int n = 0; n < 2; ++n)
#pragma unroll
                    for (int i = 0; i < 4; ++i) h[4 * n + i] = siluf_(acc[ai][0][m][n][i]) * acc[ai][1][m][n][i];
                u32x4 w; w.x = cvt_pk_bf16(h[0], h[1]); w.y = cvt_pk_bf16(h[2], h[3]); w.z = cvt_pk_bf16(h[4], h[5]); w.w = cvt_pk_bf16(h[6], h[7]);
                *(u32x4*)(HB + (size_t)row * EDIM + col0) = w; }
    }
};
struct EpiFfn2 {
    static constexpr bool PERM = true, AFTER_DRAIN = false;
    bf16* Y;
    __device__ __forceinline__ void operator()(const f32x4 (&acc)[2][2][4][2], const Unit& u, int wr, int wc, int fr, int fq) const {
        const int row0 = u.pm * BM + wr * 64 + fr, col0 = (u.pn & 7) * BM + wc * 32 + 8 * fq;
#pragma unroll
        for (int ai = 0; ai < 2; ++ai)
#pragma unroll
            for (int m = 0; m < 4; ++m) { const int row = row0 + ai * HALF + m * 16;
#pragma unroll
                for (int bj = 0; bj < 2; ++bj) {
                    u32x4 w; w.x = cvt_pk_bf16(acc[ai][bj][m][0][0], acc[ai][bj][m][0][1]); w.y = cvt_pk_bf16(acc[ai][bj][m][0][2], acc[ai][bj][m][0][3]);
                    w.z = cvt_pk_bf16(acc[ai][bj][m][1][0], acc[ai][bj][m][1][1]); w.w = cvt_pk_bf16(acc[ai][bj][m][1][2], acc[ai][bj][m][1][3]);
                    *(u32x4*)(Y + (size_t)row * D + col0 + bj * HALF) = w; } }
    }
};
struct MoeOrder {
    const LAS int* blk_e; int nblk, NT, G, c;
    __device__ __forceinline__ bool next(int i, Unit& u) const {
        const int L = i * G + c; if (L >= nblk * NT) return false;
        const int blk = L / NT, j = L - blk * NT; u.pm = blk; u.pn = blk_e[blk] * NT + j; return true;
    }
    __device__ __forceinline__ void a_ready(const Unit&) const {}
    __device__ __forceinline__ void done(const Unit&) const {}
};
}


namespace moe {
constexpr int MT = 320, NIB = MT / 64, BK = 64, A_STAGE = MT * BK * 2, B_STAGE = 128 * BK * 2;
constexpr int LDS_A = 0, LDS_B = 3 * A_STAGE;
typedef float f32x2 __attribute__((ext_vector_type(2)));
template <int KIND, bool NOMMA = false, bool NOLOAD = false>
__device__ __forceinline__ void tile(LAS unsigned char* lds, const unsigned char* Abase, const unsigned (&arow)[5], const float* W0, const float* W1, int ldw,
                                     int nblk16, int mrows, bf16* Out, int ldo, int tid) {
    constexpr int NK = (KIND == 1) ? 32 : 16;
    const int lane = tid & 63, wave = __builtin_amdgcn_readfirstlane(tid >> 6), wm = wave & 3, wn = wave >> 2, fr = lane & 15, fq = lane >> 4;
    const int fo = pg8::lds_byte(fr, fq * 8);
    const float* bbase; unsigned bvoff; int n0, kc;
    if (KIND == 1) { const int mat = wave & 1, kq = wave >> 1, kg = lane >> 4, cq = lane & 15;
        bbase = (mat ? W1 : W0) + (size_t)(16 * kq) * ldw; bvoff = (unsigned)((4 * kg * ldw + 4 * cq) * 4);
        n0 = 64 * ((4 * cq) >> 5) + 32 * mat + ((4 * cq) & 31); kc = 16 * kq + 4 * kg; }
    else { const int kg = lane >> 5, cq = lane & 31;
        bbase = W0 + (size_t)(8 * wave) * ldw; bvoff = (unsigned)((4 * kg * ldw + 4 * cq) * 4); n0 = 4 * cq; kc = 8 * wave + 4 * kg; }
    int bw[4];
#pragma unroll
    for (int c = 0; c < 4; ++c) bw[c] = pg8::lds_byte(n0 + c, kc);
    const unsigned ldsw = (unsigned)wave * 1024u;
    const __amdgpu_buffer_rsrc_t brsrc = __builtin_amdgcn_make_buffer_rsrc((void*)bbase, (short)0, 0x7ffffff0, 0x00020000);
    const __amdgpu_buffer_rsrc_t arsrc = __builtin_amdgcn_make_buffer_rsrc((void*)Abase, (short)0, 0x7ffffff0, 0x00020000);
    f32x4 acc[NIB][4];
#pragma unroll
    for (int a = 0; a < NIB; ++a)
#pragma unroll
        for (int b = 0; b < 4; ++b) acc[a][b] = (f32x4){0.f, 0.f, 0.f, 0.f};
    f32x4 breg[4][4];
#define MOE_DMA1(kt, st, p) do { if (!NOLOAD) __builtin_amdgcn_raw_ptr_buffer_load_lds(arsrc, (LAS unsigned*)(lds + LDS_A + (st) * A_STAGE + ((p) >> 1) * 16384 + ((p) & 1) * 8192 + ldsw), 16, arow[p], (unsigned)(kt) * (unsigned)(BK * 2), 0, 0); } while (0)
#define MOE_DMA_A(kt, st) do { MOE_DMA1(kt, st, 0); MOE_DMA1(kt, st, 1); MOE_DMA1(kt, st, 2); MOE_DMA1(kt, st, 3); MOE_DMA1(kt, st, 4); } while (0)
#define MOE_LD1(kt, set, j) do { if (NOLOAD) breg[set][j] = (f32x4){1.f, 2.f, 3.f, 4.f}; else breg[set][j] = __builtin_bit_cast(f32x4, __builtin_amdgcn_raw_buffer_load_b128(brsrc, bvoff, (unsigned)(((kt) * BK + (j)) * ldw * 4), 2)); } while (0)
#define MOE_LD_B(kt, set) do { MOE_LD1(kt, set, 0); MOE_LD1(kt, set, 1); MOE_LD1(kt, set, 2); MOE_LD1(kt, set, 3); } while (0)
#define MOE_CVT_B(set, st) do { _Pragma("unroll") for (int _c = 0; _c < 4; ++_c) { v2u _o; _o.x = pg8::cvt_pk_bf16(breg[set][0][_c], breg[set][1][_c]); _o.y = pg8::cvt_pk_bf16(breg[set][2][_c], breg[set][3][_c]); \
        *(LAS v2u*)(lds + LDS_B + (st) * B_STAGE + bw[_c]) = _o; } } while (0)
#define MOE_FR(st, sa, ks) do { if (!NOMMA) { _Pragma("unroll") for (int _nb = 0; _nb < 4; ++_nb) bfr[_nb] = *(const LAS bf16x8*)(lds + LDS_B + (st) * B_STAGE + (4 * wn + _nb) * 2048 + (ks) * 1024 + fo); \
        _Pragma("unroll") for (int _ib = 0; _ib < NIB; ++_ib) afr[_ib] = *(const LAS bf16x8*)(lds + LDS_A + (sa) * A_STAGE + (wm + 4 * _ib) * 2048 + (ks) * 1024 + fo); } } while (0)
#define MOE_BLK(ib) do { if (!NOMMA) { _Pragma("unroll") for (int _nb = 0; _nb < 4; ++_nb) acc[ib][_nb] = __builtin_amdgcn_mfma_f32_16x16x32_bf16(bfr[_nb], afr[ib], acc[ib][_nb], 0, 0, 0); } } while (0)
#define MOE_STEP(kt, u, DO_LD, DO_DMA, DO_NEXT, WAITIMM) do { bf16x8 bfr[4], afr[NIB]; \
        if (DO_NEXT) MOE_CVT_B(((u) + 1) & 3, ((u) + 1) & 1); \
        MOE_FR((u) & 1, sa0, 0); \
        MOE_BLK(0); if (DO_DMA) MOE_DMA1((kt) + 2, sa2, 0); \
        MOE_BLK(1); if (DO_DMA) MOE_DMA1((kt) + 2, sa2, 1); \
        MOE_BLK(2); if (DO_DMA) MOE_DMA1((kt) + 2, sa2, 2); \
        MOE_BLK(3); if (DO_DMA) MOE_DMA1((kt) + 2, sa2, 3); \
        MOE_BLK(4); if (DO_DMA) MOE_DMA1((kt) + 2, sa2, 4); \
        MOE_FR((u) & 1, sa0, 1); \
        MOE_BLK(0); if (DO_LD) MOE_LD1((kt) + 4, (u), 0); \
        MOE_BLK(1); if (DO_LD) MOE_LD1((kt) + 4, (u), 1); \
        MOE_BLK(2); if (DO_LD) MOE_LD1((kt) + 4, (u), 2); \
        MOE_BLK(3); if (DO_LD) MOE_LD1((kt) + 4, (u), 3); \
        MOE_BLK(4); \
        __builtin_amdgcn_s_waitcnt(WAITIMM); \
        asm volatile("" ::: "memory"); __builtin_amdgcn_s_barrier(); asm volatile("" ::: "memory"); \
        { const int _t = sa0; sa0 = sa1; sa1 = sa2; sa2 = _t; } } while (0)
    int sa0 = 0, sa1 = 1, sa2 = 2;
    MOE_DMA_A(0, 0); MOE_DMA_A(1, 1); MOE_LD_B(0, 0); MOE_LD_B(1, 1); MOE_LD_B(2, 2); MOE_LD_B(3, 3);
    __builtin_amdgcn_s_waitcnt(0x0F74);
    MOE_CVT_B(0, 0);
    __builtin_amdgcn_s_waitcnt(0x0074);
    asm volatile("" ::: "memory"); __builtin_amdgcn_s_barrier(); asm volatile("" ::: "memory");
#pragma unroll 1
    for (int kt = 0; kt < NK - 4; kt += 4) { MOE_STEP(kt, 0, true, true, true, 0x007D); MOE_STEP(kt + 1, 1, true, true, true, 0x007D); MOE_STEP(kt + 2, 2, true, true, true, 0x007D); MOE_STEP(kt + 3, 3, true, true, true, 0x007D); }
    MOE_STEP(NK - 4, 0, false, true, true, 0x0079);
    MOE_STEP(NK - 3, 1, false, true, true, 0x0075);
    MOE_STEP(NK - 2, 2, false, false, true, 0x0070);
    MOE_STEP(NK - 1, 3, false, false, false, 0x0070);
#undef MOE_DMA1
#undef MOE_DMA_A
#undef MOE_LD1
#undef MOE_LD_B
#undef MOE_CVT_B
#undef MOE_BLK
#undef MOE_FR
#undef MOE_STEP
#pragma unroll
    for (int ib = 0; ib < NIB; ++ib) {
        const int row = 16 * (wm + 4 * ib) + fr;
        if (!NOMMA && row < mrows) {
            bf16* op = Out + (size_t)row * ldo;
            if (KIND == 1) {
#pragma unroll
                for (int nb = 0; nb < 2; ++nb) { float h[4];
#pragma unroll
                    for (int i = 0; i < 4; ++i) h[i] = siluf_(acc[ib][nb][i]) * acc[ib][nb + 2][i];
                    v2u w; w.x = pg8::cvt_pk_bf16(h[0], h[1]); w.y = pg8::cvt_pk_bf16(h[2], h[3]);
                    *(GAS v2u*)(op + 32 * wn + 16 * nb + 4 * fq) = w; }
            } else {
#pragma unroll
                for (int nb = 0; nb < 4; ++nb) { v2u w; w.x = pg8::cvt_pk_bf16(acc[ib][nb][0], acc[ib][nb][1]); w.y = pg8::cvt_pk_bf16(acc[ib][nb][2], acc[ib][nb][3]);
                    *(GAS v2u*)(op + 64 * wn + 16 * nb + 4 * fq) = w; }
            }
        }
    }
}
}


#ifndef M2_AUX
#define M2_AUX 2
#endif
#ifndef MOE_NS
#define MOE_NS moe3
#define MOE_AWAVE_END 6
#endif
namespace moe2 {
constexpr int MT = 320, BK = 64, A_STAGE = MT * BK * 2, B_STAGE = 128 * BK * 2;
constexpr int LDS_A = 0, LDS_B = 3 * A_STAGE;
template <int KIND, bool NOMMA = false, bool NOLOAD = false, int LMODE = 0, class RowFn>
__device__ __forceinline__ void tile(LAS unsigned char* lds, const unsigned char* Abase, const RowFn& arowfn, const float* W0, const float* W1, int ldw,
                                     int nblk16, int mrows, bf16* Out, int ldo, int tid, gu32* done_cnt = nullptr) {
    constexpr int NK = (KIND == 1) ? 32 : 16;
    const int lane = tid & 63, wave = __builtin_amdgcn_readfirstlane(tid >> 6);
    if (wave >= 4) {
        const int lw = wave - 4, ltid = tid - 256;
        unsigned arow[10];
#pragma unroll
        for (int q = 0; q < 10; ++q) { int R, C; pg8::stage_rc(ltid * 16 + (q & 3) * 4096, R, C); arow[q] = arowfn((q >> 2) * 128 + R) + (unsigned)(C * 2); }
        const float* bbase; unsigned bvoff; int n0, kc;
        if (KIND == 1) { const int mat = lw & 1, kh = lw >> 1, kg = lane >> 4, cq = lane & 15;
            bbase = (mat ? W1 : W0) + (size_t)(32 * kh) * ldw; bvoff = (unsigned)((8 * kg * ldw + 4 * cq) * 4);
            n0 = 64 * ((4 * cq) >> 5) + 32 * mat + ((4 * cq) & 31); kc = 32 * kh + 8 * kg; }
        else { const int kg = lane >> 5, cq = lane & 31;
            bbase = W0 + (size_t)(16 * lw) * ldw; bvoff = (unsigned)((8 * kg * ldw + 4 * cq) * 4); n0 = 4 * cq; kc = 16 * lw + 8 * kg; }
        int bw[4];
#pragma unroll
        for (int c = 0; c < 4; ++c) bw[c] = pg8::lds_byte(n0 + ((c + (n0 >> 2)) & 3), kc);
        const unsigned ldsw = (unsigned)lw * 1024u;
        const __amdgpu_buffer_rsrc_t brsrc = __builtin_amdgcn_make_buffer_rsrc((void*)bbase, (short)0, 0x7ffffff0, 0x00020000);
        const __amdgpu_buffer_rsrc_t arsrc = __builtin_amdgcn_make_buffer_rsrc((void*)Abase, (short)0, 0x7ffffff0, 0x00020000);
        f32x4 breg[4][8];
#define M2_DMA1(kt, st, q) if (!NOLOAD && LMODE != 1) __builtin_amdgcn_raw_ptr_buffer_load_lds(arsrc, (LAS unsigned*)(lds + LDS_A + (st) * A_STAGE + ((q) >> 2) * 16384 + ((q) & 3) * 4096 + ldsw), 16, arow[q], (unsigned)(kt) * (unsigned)(BK * 2), 0, 0)
#define M2_DMA_A(kt, st) do { M2_DMA1(kt, st, 0); M2_DMA1(kt, st, 1); M2_DMA1(kt, st, 2); M2_DMA1(kt, st, 3); M2_DMA1(kt, st, 4); M2_DMA1(kt, st, 5); M2_DMA1(kt, st, 6); M2_DMA1(kt, st, 7); M2_DMA1(kt, st, 8); M2_DMA1(kt, st, 9); } while (0)
#define M2_LD_B(kt, set) do { _Pragma("unroll") for (int _j = 0; _j < 8; ++_j) { if (NOLOAD || LMODE == 2) breg[set][_j] = (f32x4){1.f, 2.f, 3.f, 4.f}; else breg[set][_j] = __builtin_bit_cast(f32x4, __builtin_amdgcn_raw_buffer_load_b128(brsrc, bvoff, (unsigned)(((kt) * BK + _j) * ldw * 4), M2_AUX)); } } while (0)
#define M2_CVT_B(set, st) do { _Pragma("unroll") for (int _c = 0; _c < 4; ++_c) { v4u _o; _o.x = pg8::cvt_pk_bf16(breg[set][0][_c], breg[set][1][_c]); _o.y = pg8::cvt_pk_bf16(breg[set][2][_c], breg[set][3][_c]); \
        _o.z = pg8::cvt_pk_bf16(breg[set][4][_c], breg[set][5][_c]); _o.w = pg8::cvt_pk_bf16(breg[set][6][_c], breg[set][7][_c]); *(LAS v4u*)(lds + LDS_B + (st) * B_STAGE + bw[_c]) = _o; } } while (0)
#define M2_LSTEP(kt, u, DO_LD, DO_DMA, DO_NEXT, WAITIMM) do { \
        if (DO_NEXT) M2_CVT_B(((u) + 1) & 3, ((u) + 1) & 1); \
        if (DO_DMA) M2_DMA_A((kt) + 2, sa2); \
        if (DO_LD) M2_LD_B((kt) + 4, (u)); \
        __builtin_amdgcn_s_waitcnt(WAITIMM); \
        asm volatile("" ::: "memory"); __builtin_amdgcn_s_barrier(); asm volatile("" ::: "memory"); \
        { const int _t = sa0; sa0 = sa1; sa1 = sa2; sa2 = _t; } } while (0)
        int sa0 = 0, sa1 = 1, sa2 = 2;
        M2_DMA_A(0, 0); M2_DMA_A(1, 1); M2_LD_B(0, 0); M2_LD_B(1, 1); M2_LD_B(2, 2); M2_LD_B(3, 3);
        __builtin_amdgcn_s_waitcnt(0x0F78);
        M2_CVT_B(0, 0);
        __builtin_amdgcn_s_waitcnt(0x0078);
        asm volatile("" ::: "memory"); __builtin_amdgcn_s_barrier(); asm volatile("" ::: "memory");
#pragma unroll 1
        for (int kt = 0; kt < NK - 4; kt += 4) { M2_LSTEP(kt, 0, true, true, true, 0x407A); M2_LSTEP(kt + 1, 1, true, true, true, 0x407A); M2_LSTEP(kt + 2, 2, true, true, true, 0x407A); M2_LSTEP(kt + 3, 3, true, true, true, 0x407A); }
        M2_LSTEP(NK - 4, 0, false, true, true, 0x4072);
        M2_LSTEP(NK - 3, 1, false, true, true, 0x007A);
        M2_LSTEP(NK - 2, 2, false, false, true, 0x0070);
        M2_LSTEP(NK - 1, 3, false, false, false, 0x0070);
#undef M2_DMA1
#undef M2_DMA_A
#undef M2_LD_B
#undef M2_CVT_B
#undef M2_LSTEP
    } else {
        const int wm = wave & 1, wn = wave >> 1, fr = lane & 15, fq = lane >> 4;
        const int fo = pg8::lds_byte(fr, fq * 8);
        f32x4 acc[10][4];
#pragma unroll
        for (int a = 0; a < 10; ++a)
#pragma unroll
            for (int b = 0; b < 4; ++b) acc[a][b] = (f32x4){0.f, 0.f, 0.f, 0.f};
        int sa0 = 0, sa1 = 1, sa2 = 2;
        __builtin_amdgcn_s_barrier(); asm volatile("" ::: "memory");
#pragma unroll 1
        for (int kt = 0; kt < NK; ++kt) {
            const LAS unsigned char* Ab = lds + LDS_A + sa0 * A_STAGE + fo; const LAS unsigned char* Bb = lds + LDS_B + (kt & 1) * B_STAGE + (4 * wn) * 2048 + fo;
#pragma unroll
            for (int ks = 0; ks < 2; ++ks) { bf16x8 bfr[4], afr[5];
#pragma unroll
                for (int nb = 0; nb < 4; ++nb) bfr[nb] = *(const LAS bf16x8*)(Bb + nb * 2048 + ks * 1024);
#pragma unroll
                for (int hb = 0; hb < 2; ++hb) {
#pragma unroll
                    for (int i5 = 0; i5 < 5; ++i5) afr[i5] = *(const LAS bf16x8*)(Ab + (wm + 2 * (5 * hb + i5)) * 2048 + ks * 1024);
#pragma unroll
                    for (int i5 = 0; i5 < 5; ++i5)
#pragma unroll
                        for (int nb = 0; nb < 4; ++nb) if (!NOMMA) acc[5 * hb + i5][nb] = __builtin_amdgcn_mfma_f32_16x16x32_bf16(bfr[nb], afr[i5], acc[5 * hb + i5][nb], 0, 0, 0);
                } }
            __builtin_amdgcn_s_waitcnt(0xC07F);
            asm volatile("" ::: "memory"); __builtin_amdgcn_s_barrier(); asm volatile("" ::: "memory");
            { const int t = sa0; sa0 = sa1; sa1 = sa2; sa2 = t; }
        }
#define M2_UNROT(dst, src) do { float _t[4]; _Pragma("unroll") for (int _c = 0; _c < 4; ++_c) _t[_c] = (fq & 1) ? src[(_c + 1) & 3] : src[_c]; \
        _Pragma("unroll") for (int _c = 0; _c < 4; ++_c) dst[_c] = (fq & 2) ? _t[(_c + 2) & 3] : _t[_c]; } while (0)
#pragma unroll
        for (int ib = 0; ib < 10; ++ib) {
            const int row = 16 * (wm + 2 * ib) + fr;
            if (row < mrows) {
                bf16* op = Out + (size_t)row * ldo;
                if (KIND == 1) {
#pragma unroll
                    for (int nb = 0; nb < 2; ++nb) { float hr[4], h[4];
#pragma unroll
                        for (int i = 0; i < 4; ++i) hr[i] = siluf_(acc[ib][nb][i]) * acc[ib][nb + 2][i];
                        M2_UNROT(h, hr);
                        const unsigned long long w = (unsigned long long)pg8::cvt_pk_bf16(h[0], h[1]) | ((unsigned long long)pg8::cvt_pk_bf16(h[2], h[3]) << 32);
                        __hip_atomic_store((GAS unsigned long long*)(op + 32 * wn + 16 * nb + 4 * fq), w, RLX_AGENT); }
                } else {
#pragma unroll
                    for (int nb = 0; nb < 4; ++nb) { float ar[4], a[4];
#pragma unroll
                        for (int i = 0; i < 4; ++i) ar[i] = acc[ib][nb][i];
                        M2_UNROT(a, ar);
                        v2u w; w.x = pg8::cvt_pk_bf16(a[0], a[1]); w.y = pg8::cvt_pk_bf16(a[2], a[3]);
                        __builtin_nontemporal_store(w, (GAS v2u*)(op + 64 * wn + 16 * nb + 4 * fq)); }
                }
            }
        }
        if (KIND == 1 && done_cnt) {
            asm volatile("s_waitcnt vmcnt(0)" ::: "memory");
            if (lane == 0) __hip_atomic_fetch_add(done_cnt, 1u, RLX_AGENT);
        }
    }
}
}

namespace moe3 {
constexpr int MT = 320, BK = 64, A_STAGE = MT * BK * 2, B_STAGE = 128 * BK * 2;
constexpr int LDS_A = 0, LDS_B = 3 * A_STAGE;
template <int KIND, bool NOMMA = false, class RowFn>
__device__ __forceinline__ void tile(LAS unsigned char* lds, const unsigned char* Abase, const RowFn& arowfn, const float* W0, const float* W1, int ldw,
                                     int nblk16, int mrows, bf16* Out, int ldo, int tid, gu32* done_cnt = nullptr) {
    constexpr int NK = (KIND == 1) ? 32 : 16;
    const int lane = tid & 63, wave = __builtin_amdgcn_readfirstlane(tid >> 6);
    if (wave >= 6) {
        const int bw = wave - 6;
        const float* bbase; unsigned bvoff; int n0, kc0;
        if (KIND == 1) { const int kg = lane >> 4, cq = lane & 15;
            bbase = bw ? W1 : W0; bvoff = (unsigned)((16 * kg * ldw + 4 * cq) * 4);
            n0 = 64 * ((4 * cq) >> 5) + 32 * bw + ((4 * cq) & 31); kc0 = 16 * kg; }
        else { const int kg = lane >> 5, cq = lane & 31;
            bbase = W0 + (size_t)(32 * bw) * ldw; bvoff = (unsigned)((16 * kg * ldw + 4 * cq) * 4); n0 = 4 * cq; kc0 = 32 * bw + 16 * kg; }
        int bwo[2][4];
#pragma unroll
        for (int hh = 0; hh < 2; ++hh)
#pragma unroll
            for (int c = 0; c < 4; ++c) bwo[hh][c] = pg8::lds_byte(n0 + ((c + (n0 >> 2)) & 3), kc0 + 8 * hh);
        const __amdgpu_buffer_rsrc_t brsrc = __builtin_amdgcn_make_buffer_rsrc((void*)bbase, (short)0, 0x7ffffff0, 0x00020000);
        f32x4 breg[3][16];
#define M3_LD_B(kt, set) do { _Pragma("unroll") for (int _j = 0; _j < 16; ++_j) breg[set][_j] = __builtin_bit_cast(f32x4, __builtin_amdgcn_raw_buffer_load_b128(brsrc, bvoff, (unsigned)(((kt) * BK + _j) * ldw * 4), M2_AUX)); } while (0)
#define M3_CVT_B(set, st) do { _Pragma("unroll") for (int _hh = 0; _hh < 2; ++_hh) _Pragma("unroll") for (int _c = 0; _c < 4; ++_c) { v4u _o; \
        _o.x = pg8::cvt_pk_bf16(breg[set][8 * _hh + 0][_c], breg[set][8 * _hh + 1][_c]); _o.y = pg8::cvt_pk_bf16(breg[set][8 * _hh + 2][_c], breg[set][8 * _hh + 3][_c]); \
        _o.z = pg8::cvt_pk_bf16(breg[set][8 * _hh + 4][_c], breg[set][8 * _hh + 5][_c]); _o.w = pg8::cvt_pk_bf16(breg[set][8 * _hh + 6][_c], breg[set][8 * _hh + 7][_c]); \
        *(LAS v4u*)(lds + LDS_B + (st) * B_STAGE + bwo[_hh][_c]) = _o; } } while (0)
#define M3_BSTEP(kt, c, DO_LD, DO_CVT, WAITIMM) do { \
        __builtin_amdgcn_s_waitcnt(WAITIMM); \
        if (DO_CVT) M3_CVT_B(((c) + 1) % 3, ((kt) + 1) & 1); \
        if (DO_LD) M3_LD_B((kt) + 3, (c)); \
        __builtin_amdgcn_s_waitcnt(0xC07F); \
        asm volatile("" ::: "memory"); __builtin_amdgcn_s_barrier(); asm volatile("" ::: "memory"); } while (0)
        M3_LD_B(0, 0); M3_LD_B(1, 1); M3_LD_B(2, 2);
        __builtin_amdgcn_s_waitcnt(0x8F70);
        M3_CVT_B(0, 0);
        __builtin_amdgcn_s_waitcnt(0xC07F);
        asm volatile("" ::: "memory"); __builtin_amdgcn_s_barrier(); asm volatile("" ::: "memory");
        constexpr int NMAIN = ((NK - 3) / 3) * 3;
#pragma unroll 1
        for (int kt = 0; kt < NMAIN; kt += 3) { M3_BSTEP(kt, 0, true, true, 0x4F70); M3_BSTEP(kt + 1, 1, true, true, 0x4F70); M3_BSTEP(kt + 2, 2, true, true, 0x4F70); }
        if (KIND == 1) {
            M3_BSTEP(27, 0, true, true, 0x4F70); M3_BSTEP(28, 1, true, true, 0x4F70);
            M3_BSTEP(29, 2, false, true, 0x4F70); M3_BSTEP(30, 0, false, true, 0x0F70); M3_BSTEP(31, 1, false, false, 0x0F70);
        } else {
            M3_BSTEP(12, 0, true, true, 0x4F70);
            M3_BSTEP(13, 1, false, true, 0x4F70); M3_BSTEP(14, 2, false, true, 0x0F70); M3_BSTEP(15, 0, false, false, 0x0F70);
        }
#undef M3_LD_B
#undef M3_CVT_B
#undef M3_BSTEP
    } else if (wave >= 4) {
        const int aw = wave - 4;
        unsigned arow[20];
#pragma unroll
        for (int q = 0; q < 20; ++q) { const int g = 2 * q + aw, h = g >> 4, sub = g & 15; int R, C; pg8::stage_rc(sub * 1024 + lane * 16, R, C);
            arow[q] = arowfn(h * 128 + R) + (unsigned)(C * 2); }
        const __amdgpu_buffer_rsrc_t arsrc = __builtin_amdgcn_make_buffer_rsrc((void*)Abase, (short)0, 0x7ffffff0, 0x00020000);
#define M3_DMA_A(kt, st) do { _Pragma("unroll") for (int _q = 0; _q < 20; ++_q) \
        __builtin_amdgcn_raw_ptr_buffer_load_lds(arsrc, (LAS unsigned*)(lds + LDS_A + (st) * A_STAGE + (2 * _q + aw < 16 ? 0 : (2 * _q + aw < 32 ? 16384 : 32768)) + ((2 * _q + aw) & 15) * 1024), 16, arow[_q], (unsigned)(kt) * (unsigned)(BK * 2), 0, 0); } while (0)
        int sa0 = 0, sa1 = 1, sa2 = 2;
        M3_DMA_A(0, 0); M3_DMA_A(1, 1);
        __builtin_amdgcn_s_waitcnt(0x0F70);
        asm volatile("" ::: "memory"); __builtin_amdgcn_s_barrier(); asm volatile("" ::: "memory");
#pragma unroll 1
        for (int kt = 0; kt < NK - 2; ++kt) {
            M3_DMA_A(kt + 2, sa2);
            __builtin_amdgcn_s_waitcnt(0x4F74);
            asm volatile("" ::: "memory"); __builtin_amdgcn_s_barrier(); asm volatile("" ::: "memory");
            { const int t = sa0; sa0 = sa1; sa1 = sa2; sa2 = t; }
        }
        __builtin_amdgcn_s_waitcnt(0x0F70);
        asm volatile("" ::: "memory"); __builtin_amdgcn_s_barrier(); asm volatile("" ::: "memory");
        asm volatile("" ::: "memory"); __builtin_amdgcn_s_barrier(); asm volatile("" ::: "memory");
#undef M3_DMA_A
    } else {
        const int wm = wave & 1, wn = wave >> 1, fr = lane & 15, fq = lane >> 4;
        const int fo = pg8::lds_byte(fr, fq * 8);
        f32x4 acc[10][4];
#pragma unroll
        for (int a = 0; a < 10; ++a)
#pragma unroll
            for (int b = 0; b < 4; ++b) acc[a][b] = (f32x4){0.f, 0.f, 0.f, 0.f};
        int sa0 = 0, sa1 = 1, sa2 = 2;
        __builtin_amdgcn_s_barrier(); asm volatile("" ::: "memory");
#pragma unroll 1
        for (int kt = 0; kt < NK; ++kt) {
            const LAS unsigned char* Ab = lds + LDS_A + sa0 * A_STAGE + fo; const LAS unsigned char* Bb = lds + LDS_B + (kt & 1) * B_STAGE + (4 * wn) * 2048 + fo;
#pragma unroll
            for (int ks = 0; ks < 2; ++ks) { bf16x8 bfr[4], afr[5];
#pragma unroll
                for (int nb = 0; nb < 4; ++nb) bfr[nb] = *(const LAS bf16x8*)(Bb + nb * 2048 + ks * 1024);
#pragma unroll
                for (int hb = 0; hb < 2; ++hb) {
#pragma unroll
                    for (int i5 = 0; i5 < 5; ++i5) afr[i5] = *(const LAS bf16x8*)(Ab + (wm + 2 * (5 * hb + i5)) * 2048 + ks * 1024);
#pragma unroll
                    for (int i5 = 0; i5 < 5; ++i5)
#pragma unroll
                        for (int nb = 0; nb < 4; ++nb) if (!NOMMA) acc[5 * hb + i5][nb] = __builtin_amdgcn_mfma_f32_16x16x32_bf16(bfr[nb], afr[i5], acc[5 * hb + i5][nb], 0, 0, 0);
                } }
            __builtin_amdgcn_s_waitcnt(0xC07F);
            asm volatile("" ::: "memory"); __builtin_amdgcn_s_barrier(); asm volatile("" ::: "memory");
            { const int t = sa0; sa0 = sa1; sa1 = sa2; sa2 = t; }
        }
#define M2_UNROT(dst, src) do { float _t[4]; _Pragma("unroll") for (int _c = 0; _c < 4; ++_c) _t[_c] = (fq & 1) ? src[(_c + 1) & 3] : src[_c]; \
        _Pragma("unroll") for (int _c = 0; _c < 4; ++_c) dst[_c] = (fq & 2) ? _t[(_c + 2) & 3] : _t[_c]; } while (0)
#pragma unroll
        for (int ib = 0; ib < 10; ++ib) {
            const int row = 16 * (wm + 2 * ib) + fr;
            if (row < mrows) {
                bf16* op = Out + (size_t)row * ldo;
                if (KIND == 1) {
#pragma unroll
                    for (int nb = 0; nb < 2; ++nb) { float hr[4], h[4];
#pragma unroll
                        for (int i = 0; i < 4; ++i) hr[i] = siluf_(acc[ib][nb][i]) * acc[ib][nb + 2][i];
                        M2_UNROT(h, hr);
                        const unsigned long long w = (unsigned long long)pg8::cvt_pk_bf16(h[0], h[1]) | ((unsigned long long)pg8::cvt_pk_bf16(h[2], h[3]) << 32);
                        __hip_atomic_store((GAS unsigned long long*)(op + 32 * wn + 16 * nb + 4 * fq), w, RLX_AGENT); }
                } else {
#pragma unroll
                    for (int nb = 0; nb < 4; ++nb) { float ar[4], a[4];
#pragma unroll
                        for (int i = 0; i < 4; ++i) ar[i] = acc[ib][nb][i];
                        M2_UNROT(a, ar);
                        v2u w; w.x = pg8::cvt_pk_bf16(a[0], a[1]); w.y = pg8::cvt_pk_bf16(a[2], a[3]);
                        __builtin_nontemporal_store(w, (GAS v2u*)(op + 64 * wn + 16 * nb + 4 * fq)); }
                }
            }
        }
        if (KIND == 1 && done_cnt) {
            asm volatile("s_waitcnt vmcnt(0)" ::: "memory");
            if (lane == 0) __hip_atomic_fetch_add(done_cnt, 1u, RLX_AGENT);
        }
    }
}
}

__device__ __forceinline__ void transpose_item(const float* W, int K, int N, int k0, int n0, bf16* dst  , LAS float* scr, int lane) {
    const int kq = lane >> 4, nq = lane & 15;
#pragma unroll 8
    for (int i = 0; i < 16; ++i) { const int kk = 4 * i + kq; const f32x4 v = *(const GAS f32x4*)(W + (size_t)(k0 + kk) * N + n0 + 4 * nq);
        LAS float* d = scr + kk * 65 + 4 * nq; d[0] = v.x; d[1] = v.y; d[2] = v.z; d[3] = v.w; }
    LDS_WAIT();
    const int c = lane & 7, nb = lane >> 3;
#pragma unroll
    for (int j = 0; j < 8; ++j) { const int n = nb + 8 * j; const LAS float* s = scr + (8 * c) * 65 + n;
        v4u o; o.x = pk2(s[0 * 65], s[1 * 65]); o.y = pk2(s[2 * 65], s[3 * 65]); o.z = pk2(s[4 * 65], s[5 * 65]); o.w = pk2(s[6 * 65], s[7 * 65]);
        *(GAS v4u*)(dst + (size_t)n * K + k0 + 8 * c) = o; }
    LDS_WAIT();
}
__device__ __forceinline__ void ada_item(const float* w_ada, const float* b_ada, float* mod, const LAS float* sc, LAS float* red, int n0, int tid) {
    const int cg = tid & 7, rg = tid >> 3;
    f32x4 a0 = {0.f, 0.f, 0.f, 0.f}, a1 = {0.f, 0.f, 0.f, 0.f};
#pragma unroll 4
    for (int k = rg; k < D; k += 64) { const f32x4 w = *(const GAS f32x4*)(w_ada + (size_t)k * 12288 + n0 + 4 * cg); a0 += w * sc[k]; a1 += w * sc[D + k]; }
#pragma unroll
    for (int i = 0; i < 4; ++i) { red[tid * 8 + i] = a0[i]; red[tid * 8 + 4 + i] = a1[i]; }
    __syncthreads();
    if (tid < 64) { const int b = tid >> 5, col = tid & 31, cgi = col >> 2, ci = col & 3; float s = 0.f;
        for (int r = 0; r < 64; ++r) s += red[(r * 8 + cgi) * 8 + b * 4 + ci];
        mod[b * 12288 + n0 + col] = s + b_ada[n0 + col]; }
    __syncthreads();
}

__global__ void __launch_bounds__(NTHR, 2) fwd_kernel(Args args) {
    extern __shared__ __attribute__((aligned(16))) unsigned char lds_raw[];
    LAS unsigned char* lds = (LAS unsigned char*)lds_raw;
    volatile LAS unsigned* MISC = (volatile LAS unsigned*)(lds + MISC_OFF);
    const int tid = threadIdx.x, lane = tid & 63, wave = __builtin_amdgcn_readfirstlane(tid >> 6);
    const int G = gridDim.x, bid = blockIdx.x;
    unsigned char* ws = args.ws;
    gu32* ctl = (gu32*)(ws + WS_CTL);
    const int lo = args.ph_lo, hi = args.ph_hi;

    const float* x = (const float*)args.in[0];
    const float* cvec = (const float*)args.in[1];
    const int* positions = (const int*)args.in[2];
    const float* norm1_gain = (const float*)args.in[3];
    const float* norm2_gain = (const float*)args.in[4];
    const float* final_gain = (const float*)args.in[5];
    const float* w_ada = (const float*)args.in[6];
    const float* b_ada = (const float*)args.in[7];
    const float* w_in = (const float*)args.in[8];
    const float* attn_sinks = (const float*)args.in[9];
    const float* ret_gain = (const float*)args.in[10];
    const float* w_ba = (const float*)args.in[11];
    const float* w_br = (const float*)args.in[12];
    const float* w_out = (const float*)args.in[13];
    const float* w_rg = (const float*)args.in[14];
    const float* b_rg = (const float*)args.in[15];
    const float* w_re = (const float*)args.in[16];
    const float* b_re = (const float*)args.in[17];
    const float* w_eg = (const float*)args.in[18];
    const float* w_eu = (const float*)args.in[19];
    const float* w_ed = (const float*)args.in[20];

    float* mod = (float*)(ws + WS_MOD);
    float* cosT = (float*)(ws + WS_ROPE); float* sinT = cosT + (size_t)T * 128;
    bf16* Win_t = (bf16*)(ws + WS_WIN); bf16* Wba_t = (bf16*)(ws + WS_WBA); bf16* Wbr_t = (bf16*)(ws + WS_WBR); bf16* Wout_t = (bf16*)(ws + WS_WOUT);
    bf16* Wrt = (bf16*)(ws + WS_WRT);
    bf16* Hb = (bf16*)(ws + WS_H);
    bf16* X1 = (bf16*)(ws + WS_X1);
    bf16* P = (bf16*)(ws + WS_P);
    bf16* Vta = (bf16*)(ws + WS_VTA); bf16* Vtr = (bf16*)(ws + WS_VTR); bf16* Krt = (bf16*)(ws + WS_KRT);
    bf16* SC = (bf16*)(ws + WS_SC); bf16* ST = (bf16*)(ws + WS_ST);
    bf16* ATT = (bf16*)(ws + WS_ATTN); bf16* RET = (bf16*)(ws + WS_RET);
    bf16* M1 = (bf16*)(ws + WS_M1); bf16* MG = (bf16*)(ws + WS_MERGED);
    bf16* HB = (bf16*)(ws + WS_HB); bf16* YB = (bf16*)(ws + WS_Y);
    int* rowtok = (int*)(ws + WS_RTOK);
    int* route = (int*)(ws + WS_ROUTE);
    gu32* ecnt = ctl + CW_CNT;

    for (int u = tid; u < MISC_BYTES / 4; u += NTHR) ((LAS unsigned*)(lds + MISC_OFF))[u] = 0u;
    __syncthreads();
    XcdBarrier bar = xcd_barrier_post((unsigned*)(ctl + CW_BAR) + args.bar_region * XCD_BAR_WORDS, MISC + 8);

#define IN(k) (lo <= (k) && (k) < hi)
#define SEAM(k) do { if (IN(k) && IN((k) + 1)) xcd_barrier(bar); } while (0)

    if (IN(0)) {
        {
            LAS float* sc = (LAS float*)lds;
            LAS float* red = (LAS float*)(lds + 16384);
            if (bid < 128) { for (int i = tid; i < 2 * D; i += NTHR) sc[i] = siluf_(cvec[i]); __syncthreads(); }
            for (int it = bid; it < 128; it += G) ada_item(w_ada, b_ada, mod, sc, red, it * 32, tid);
            __syncthreads();
        }
        for (int i = bid * NTHR + tid; i < T * 128; i += G * NTHR) {
            const int tok = i >> 7, f = i & 127;
            const double inv = exp2(-(double)f * (13.287712379549449 / 128.0));
            double rv = (double)positions[tok] * inv * 0.15915494309189535;
            rv -= floor(rv);
            const float rf = (float)rv;
            cosT[i] = __builtin_amdgcn_cosf(rf); sinT[i] = __builtin_amdgcn_sinf(rf);
        }
        for (int i = bid * NTHR + tid; i < 80 * D; i += G * NTHR) {
            const int n = i >> 11, k = i & 2047; float v = 0.f;
            if (n < 64) v = w_re[(size_t)k * 64 + n]; else if (n < 68) v = w_rg[(size_t)k * 4 + (n - 64)];
            Wrt[i] = (bf16)f2bf(v);
        }
        {
            LAS float* scr = (LAS float*)(lds + wave * 16640);
            const int gw = bid * NWAVES + wave, NGW = G * NWAVES;
            constexpr int NB = NPROJ / 64, NIT = 32 * NB;
            for (int it = gw; it < NIT; it += NGW) { const int kb = it / NB, n0 = (it % NB) * 64; transpose_item(w_in, D, NPROJ, kb * 64, n0, Win_t + (size_t)n0 * D, scr, lane); }
        }
    }
    SEAM(0);

    if (IN(1)) {
        const int gw = bid * NWAVES + wave, NGW = G * NWAVES;
        int curb = -1; f32x4 ca[8], cs[8];
        f32x4 v[8], vn[8];
        int row = gw;
        if (row < T) {
            const GAS f32x4* xr = (const GAS f32x4*)(x + (size_t)row * D) + lane;
#pragma unroll
            for (int j = 0; j < 8; ++j) v[j] = xr[64 * j];
        }
        for (; row < T; row += NGW) {
            const int b = row >> 12, nrow = row + NGW;
            if (nrow < T) {
                const GAS f32x4* xr = (const GAS f32x4*)(x + (size_t)nrow * D) + lane;
#pragma unroll
                for (int j = 0; j < 8; ++j) vn[j] = xr[64 * j];
            }
            if (b != curb) { curb = b;
#pragma unroll
                for (int j = 0; j < 8; ++j) { const int k = 4 * lane + 256 * j;
                    const f32x4 g = *(const GAS f32x4*)(norm1_gain + k), scl = *(const GAS f32x4*)(mod + b * 12288 + 2048 + k);
                    ca[j] = g * (scl + 1.0f); cs[j] = *(const GAS f32x4*)(mod + b * 12288 + k); } }
            float ss = 0.f;
#pragma unroll
            for (int j = 0; j < 8; ++j) ss += (v[j].x * v[j].x + v[j].y * v[j].y) + (v[j].z * v[j].z + v[j].w * v[j].w);
            const float r = 1.0f / sqrtf(wave_sum(ss) * (1.0f / D) + EPS);
            GAS v2u* o8 = (GAS v2u*)(Hb + (size_t)row * D) + lane;
#pragma unroll
            for (int j = 0; j < 8; ++j) { const f32x4 hv = v[j] * r * ca[j] + cs[j];
                v2u o; o.x = pk2(hv.x, hv.y); o.y = pk2(hv.z, hv.w); o8[64 * j] = o; }
#pragma unroll
            for (int j = 0; j < 8; ++j) v[j] = vn[j];
        }
    }
    SEAM(1);

    if (IN(2)) {
        pg8::Gemm g{Hb, Win_t, T, NPROJ, D}; pg8::StaticOrder S; S.init(T, NPROJ, G, bid, WGM_PROJ);
        pg8::EpiProj E{P, Vta, Vtr, Krt, cosT, sinT};
        pg8::gemm_phase<pg8::EpiProj, pg8::StaticOrder, GK_ALIGN, GK_SP2>(lds, g, S, E);
        {
            const int nun = (T / 256) * (NPROJ / 256), rem = nun % G;
            const int nidle = rem ? G - rem : G, ii = rem ? bid - rem : bid;
            if (ii >= 0) {
                LAS float* sc = (LAS float*)lds; LAS float* red = (LAS float*)(lds + 16384);
                for (int i = tid; i < 2 * D; i += NTHR) sc[i] = siluf_(cvec[i]);
                __syncthreads();
                for (int it = ii; it < 256; it += nidle) ada_item(w_ada, b_ada, mod, sc, red, 4096 + it * 32, tid);
                __syncthreads();
                LAS float* scr = (LAS float*)(lds + wave * 16640);
                for (int it = ii * NWAVES + wave; it < 3 * 1024; it += nidle * NWAVES) { const int w = it >> 10, r = it & 1023, kb = r >> 5, n0 = (r & 31) * 64;
                    const float* src = w == 0 ? w_ba : (w == 1 ? w_br : w_out); bf16* dst = w == 0 ? Wba_t : (w == 1 ? Wbr_t : Wout_t);
                    transpose_item(src, D, D, kb * 64, n0, dst + (size_t)n0 * D, scr, lane); }
            }
        }
    }
    SEAM(2);

    if (IN(3)) {
        const int r16 = lane & 15, q4 = lane >> 4;
        const int vw3 = (G & 7) == 0 ? (bid & 7) * (G >> 3) + (bid >> 3) : bid;
        for (int unit = vw3; unit < 256 + 512; unit += G) {
#ifdef DBG_VARIANT
            if (args.pad == 3 && unit < 256) continue;
            if (args.pad == 4 && unit >= 256) continue;
#endif
            if (unit < 256) {
                const int b = unit >> 7, kvh = (unit >> 5) & 3, nb = unit & 31, head = kvh * 8 + wave;
                const float sink2 = attn_sinks[head] * LOG2E;
                const int tq0 = nb * 128, ks = (nb - 1) * 128;
                const bf16* Qb = P + (size_t)(b * SEQ + tq0) * NPROJ + C_QA + head * 64;
                const bf16* Kb = P + (size_t)(b * SEQ) * NPROJ + C_KA + kvh * 64;
                const bf16* Vb = Vta + (size_t)(b * 256 + kvh * 64) * 4096;
                LAS bf16* Kl = (LAS bf16*)lds;
                LAS bf16* Vl = (LAS bf16*)(lds + 36864);
                LAS bf16* Pl = (LAS bf16*)(lds + 70656 + wave * 5376);
#pragma unroll
                for (int j = 0; j < 4; ++j) { const int p = tid + 512 * j, row = p >> 3, ch = p & 7; int tk = ks + row; tk = tk < 0 ? 0 : tk;
                    *(LAS v4u*)(Kl + row * 72 + ch * 8) = *(const GAS v4u*)(Kb + (size_t)tk * NPROJ + ch * 8); }
#pragma unroll
                for (int j = 0; j < 4; ++j) { const int p = tid + 512 * j, row = p >> 5, ch = p & 31; int tk0 = ks + 8 * ch; tk0 = tk0 < 0 ? 8 * ch : tk0;
                    *(LAS v4u*)(Vl + row * 264 + ch * 8) = *(const GAS v4u*)(Vb + (size_t)row * 4096 + tk0); }
                bf16x8 qall[8][2];
#pragma unroll
                for (int t = 0; t < 8; ++t)
#pragma unroll
                    for (int s = 0; s < 2; ++s) qall[t][s] = ldg8(Qb + (size_t)(16 * t + r16) * NPROJ + 32 * s + 8 * q4);
                *(LAS v4u*)(Pl + r16 * 168 + 144 + 8 * (q4 & 1)) = (v4u){0u, 0u, 0u, 0u};
                __syncthreads();
                const int e16 = 4 * q4;
#pragma unroll
                for (int t = 0; t < 8; ++t) {
                    f32x4 sc[9];
#pragma unroll
                    for (int n = 0; n < 9; ++n) {
                        f32x4 a = {0.f, 0.f, 0.f, 0.f};
                        if (!(nb == 0 && t + n < 8)) {
#pragma unroll
                            for (int s = 0; s < 2; ++s) a = mma16(*(const LAS bf16x8*)(Kl + (16 * (t + n) + r16) * 72 + 32 * s + 8 * q4), qall[t][s], a);
                        }
                        sc[n] = a;
                    }
                    float m = -INFINITY;
#pragma unroll
                    for (int n = 0; n < 9; ++n)
#pragma unroll
                        for (int reg = 0; reg < 4; ++reg) { bool ok = !(nb == 0 && t + n < 8);
                            if (n == 0) ok = ok && (e16 + reg > r16); if (n == 8) ok = ok && (e16 + reg <= r16);
                            sc[n][reg] = ok ? sc[n][reg] : -INFINITY; m = fmaxf(m, sc[n][reg]); }
                    m = fmaxf(m, __shfl_xor(m, 16)); m = fmaxf(m, __shfl_xor(m, 32)); m = fmaxf(m, sink2);
                    float sum = 0.f;
#pragma unroll
                    for (int n = 0; n < 9; ++n) {
#pragma unroll
                        for (int reg = 0; reg < 4; ++reg) { const float pv = __builtin_amdgcn_exp2f(sc[n][reg] - m); sc[n][reg] = pv; sum += pv; }
                        v2u w; w.x = pg8::cvt_pk_bf16(sc[n][0], sc[n][1]); w.y = pg8::cvt_pk_bf16(sc[n][2], sc[n][3]);
                        *(LAS v2u*)(Pl + r16 * 168 + 16 * n + e16) = w; }
                    sum += __shfl_xor(sum, 16); sum += __shfl_xor(sum, 32);
                    const float inv = 1.0f / (sum + __builtin_amdgcn_exp2f(sink2 - m));
                    LDS_WAIT();
                    f32x4 o[4];
#pragma unroll
                    for (int nd = 0; nd < 4; ++nd) o[nd] = (f32x4){0.f, 0.f, 0.f, 0.f};
#pragma unroll
                    for (int s = 0; s < 5; ++s) {
                        const bf16x8 pa = *(const LAS bf16x8*)(Pl + r16 * 168 + 32 * s + 8 * q4);
                        const int n = 2 * s + (q4 >> 1); const int kb = (t + n) < 16 ? (t + n) : 15;
#pragma unroll
                        for (int nd = 0; nd < 4; ++nd) o[nd] = mma16(*(const LAS bf16x8*)(Vl + (16 * nd + r16) * 264 + 16 * kb + 8 * (q4 & 1)), pa, o[nd]);
                    }
#pragma unroll
                    for (int nd = 0; nd < 4; ++nd) { v2u w; w.x = pg8::cvt_pk_bf16(o[nd][0] * inv, o[nd][1] * inv); w.y = pg8::cvt_pk_bf16(o[nd][2] * inv, o[nd][3] * inv);
                        *(GAS v2u*)(ATT + (size_t)(b * SEQ + tq0 + 16 * t + r16) * D + head * 64 + 16 * nd + 4 * q4) = w; }
                    LDS_WAIT();
                }
                __syncthreads();
            } else {
                const int u = unit - 256, bh = u >> 5, c = u & 31, b = bh >> 3, h = bh & 7;
                const bf16* Ag = Vtr + (size_t)(b * 2048 + h * 256) * 4096 + c * 128;
                const bf16* Bg = Krt + (size_t)(b * 2048 + h * 256) * 4096 + c * 128;
                LAS bf16* Al = (LAS bf16*)lds;
                LAS bf16* Bl = (LAS bf16*)(lds + 69632);
#pragma unroll
                for (int j = 0; j < 8; ++j) { const int p = tid + 512 * j, row = p >> 4, ch = p & 15;
                    *(LAS v4u*)(Al + row * 136 + ch * 8) = *(const GAS v4u*)(Ag + (size_t)row * 4096 + ch * 8);
                    *(LAS v4u*)(Bl + row * 136 + ch * 8) = *(const GAS v4u*)(Bg + (size_t)row * 4096 + ch * 8); }
                __syncthreads();
#pragma unroll 1
                for (int nh = 0; nh < 2; ++nh) {
                    f32x4 acc[2][8];
#pragma unroll
                    for (int m = 0; m < 2; ++m)
#pragma unroll
                        for (int n = 0; n < 8; ++n) acc[m][n] = (f32x4){0.f, 0.f, 0.f, 0.f};
#pragma unroll
                    for (int s = 0; s < 4; ++s) {
                        bf16x8 a[2];
#pragma unroll
                        for (int m = 0; m < 2; ++m) a[m] = *(const LAS bf16x8*)(Al + (32 * wave + 16 * m + r16) * 136 + 32 * s + 8 * q4);
#pragma unroll
                        for (int n = 0; n < 8; ++n) { const bf16x8 bb = *(const LAS bf16x8*)(Bl + (128 * nh + 16 * n + r16) * 136 + 32 * s + 8 * q4);
                            acc[0][n] = mma16(bb, a[0], acc[0][n]); acc[1][n] = mma16(bb, a[1], acc[1][n]); }
                    }
                    bf16* out = SC + (size_t)u * 65536;
#pragma unroll
                    for (int m = 0; m < 2; ++m)
#pragma unroll
                        for (int n = 0; n < 8; ++n) { v2u w; w.x = pk2(acc[m][n][0], acc[m][n][1]); w.y = pk2(acc[m][n][2], acc[m][n][3]);
                            *(GAS v2u*)(out + (size_t)(32 * wave + 16 * m + r16) * 256 + 128 * nh + 16 * n + 4 * q4) = w; }
                }
                __syncthreads();
            }
        }
    }
    SEAM(3);

    if (IN(4)) {
        for (int i = bid * NTHR + tid; i < 16 * 16384; i += G * NTHR) {
            const int bh = i >> 14, e4 = i & 16383, h = bh & 7;
            const float dc = expf(128.0f * log1pf(-exp2f(-5.0f - (float)h)));
            f32x4 st = {0.f, 0.f, 0.f, 0.f};
            for (int c = 0; c < 32; ++c) {
                const size_t off = (size_t)(bh * 32 + c) * 65536 + 4 * e4;
                v2u o; o.x = pk2(st.x, st.y); o.y = pk2(st.z, st.w); *(GAS v2u*)(ST + off) = o;
                const v2u sb = *(const GAS v2u*)(SC + off);
                const f32x4 s = {bf2f(sb.x & 0xffffu), bf2f(sb.x >> 16), bf2f(sb.y & 0xffffu), bf2f(sb.y >> 16)};
                st = st * dc + s;
            }
        }
    }
    SEAM(4);

    if (IN(5)) {
        const int r16 = lane & 15, q4 = lane >> 4;
        for (int u = bid; u < 512; u += G) {
            const int bh = u >> 5, c = u & 31, b = bh >> 3, h = bh & 7;
            const float lg2 = log1pf(-exp2f(-5.0f - (float)h)) * LOG2E;
            const int tok0 = b * SEQ + c * 128;
            const bf16* Qg = P + (size_t)tok0 * NPROJ + C_QR + h * 256;
            const bf16* Kg = P + (size_t)tok0 * NPROJ + C_KR + h * 256;
            const bf16* Vg = Vtr + (size_t)(b * 2048 + h * 256 + 32 * wave) * 4096 + c * 128;
            const bf16* Sg = ST + (size_t)u * 65536 + (size_t)(32 * wave) * 256;
            LAS bf16* Kl = (LAS bf16*)lds;
            LAS bf16* Il = (LAS bf16*)lds;
            LAS bf16* Ql = (LAS bf16*)(lds + 67584);
            LAS float* red = (LAS float*)(lds + 135168);
#pragma unroll
            for (int j = 0; j < 8; ++j) { const int p = tid + 512 * j, row = p >> 5, ch = p & 31;
                *(LAS v4u*)(Kl + row * 264 + ch * 8) = *(const GAS v4u*)(Kg + (size_t)row * NPROJ + ch * 8);
                *(LAS v4u*)(Ql + row * 264 + ch * 8) = *(const GAS v4u*)(Qg + (size_t)row * NPROJ + ch * 8); }
            __syncthreads();
            f32x4 sc[8];
            {
                bf16x8 qa[8];
#pragma unroll
                for (int s = 0; s < 8; ++s) qa[s] = *(const LAS bf16x8*)(Ql + (16 * wave + r16) * 264 + 32 * s + 8 * q4);
#pragma unroll
                for (int n = 0; n < 8; ++n) {
                    f32x4 a = {0.f, 0.f, 0.f, 0.f};
                    if (n <= wave) {
#pragma unroll
                        for (int s = 0; s < 8; ++s) a = mma16(*(const LAS bf16x8*)(Kl + (16 * n + r16) * 264 + 32 * s + 8 * q4), qa[s], a);
                    }
#pragma unroll
                    for (int reg = 0; reg < 4; ++reg) { const int df = (16 * wave + r16) - (16 * n + 4 * q4 + reg); a[reg] = df >= 0 ? a[reg] * __builtin_amdgcn_exp2f((float)df * lg2) : 0.f; }
                    sc[n] = a;
                }
            }
            bf16x8 sfr[4][2], vfr[3][2];
#pragma unroll
            for (int s = 0; s < 3; ++s)
#pragma unroll
                for (int n2 = 0; n2 < 2; ++n2) sfr[s][n2] = ldg8(Sg + (size_t)(16 * n2 + r16) * 256 + 32 * s + 8 * q4);
            __syncthreads();
#pragma unroll
            for (int n = 0; n < 8; ++n) { v2u w; w.x = pk2(sc[n][0], sc[n][1]); w.y = pk2(sc[n][2], sc[n][3]); *(LAS v2u*)(Il + (16 * wave + r16) * 136 + 16 * n + 4 * q4) = w; }
            __syncthreads();
            f32x4 O1[8][2];
#pragma unroll
            for (int qb = 0; qb < 8; ++qb)
#pragma unroll
                for (int n2 = 0; n2 < 2; ++n2) O1[qb][n2] = (f32x4){0.f, 0.f, 0.f, 0.f};
#pragma unroll
            for (int s = 0; s < 8; ++s) {
                if (s + 3 < 8) {
#pragma unroll
                    for (int n2 = 0; n2 < 2; ++n2) sfr[(s + 3) & 3][n2] = ldg8(Sg + (size_t)(16 * n2 + r16) * 256 + 32 * (s + 3) + 8 * q4); }
                if (s >= 6) {
#pragma unroll
                    for (int n2 = 0; n2 < 2; ++n2) vfr[s - 6][n2] = ldg8(Vg + (size_t)(16 * n2 + r16) * 4096 + 32 * (s - 6) + 8 * q4); }
                bf16x8 sf[2]; sf[0] = sfr[s & 3][0]; sf[1] = sfr[s & 3][1];
#pragma unroll
                for (int qb = 0; qb < 8; ++qb) { const bf16x8 qf = *(const LAS bf16x8*)(Ql + (16 * qb + r16) * 264 + 32 * s + 8 * q4);
                    O1[qb][0] = mma16(sf[0], qf, O1[qb][0]); O1[qb][1] = mma16(sf[1], qf, O1[qb][1]); }
            }
#pragma unroll
            for (int qb = 0; qb < 8; ++qb) { const float dq = __builtin_amdgcn_exp2f((float)(16 * qb + r16 + 1) * lg2);
#pragma unroll
                for (int n2 = 0; n2 < 2; ++n2) O1[qb][n2] = O1[qb][n2] * dq; }
#pragma unroll
            for (int s = 0; s < 4; ++s) {
                if (s + 2 < 4) {
#pragma unroll
                    for (int n2 = 0; n2 < 2; ++n2) vfr[(s + 2) % 3][n2] = ldg8(Vg + (size_t)(16 * n2 + r16) * 4096 + 32 * (s + 2) + 8 * q4); }
                bf16x8 vf[2]; vf[0] = vfr[s % 3][0]; vf[1] = vfr[s % 3][1];
#pragma unroll
                for (int qb = 0; qb < 8; ++qb) if (2 * s <= qb) { const bf16x8 pf = *(const LAS bf16x8*)(Il + (16 * qb + r16) * 136 + 32 * s + 8 * q4);
                    O1[qb][0] = mma16(vf[0], pf, O1[qb][0]); O1[qb][1] = mma16(vf[1], pf, O1[qb][1]); }
            }
#pragma unroll
            for (int qb = 0; qb < 8; ++qb) { float ss = 0.f;
#pragma unroll
                for (int n2 = 0; n2 < 2; ++n2)
#pragma unroll
                    for (int reg = 0; reg < 4; ++reg) { const float v = O1[qb][n2][reg]; ss += v * v; }
                ss += __shfl_xor(ss, 16); ss += __shfl_xor(ss, 32);
                if (q4 == 0) red[(16 * qb + r16) * 8 + wave] = ss; }
            __syncthreads();
#pragma unroll
            for (int qb = 0; qb < 8; ++qb) { const int q = 16 * qb + r16; float tot = 0.f;
#pragma unroll
                for (int w2 = 0; w2 < 8; ++w2) tot += red[q * 8 + w2];
                const float rs = 1.0f / sqrtf(tot * (1.0f / 256.0f) + EPS);
                const size_t tok = (size_t)(tok0 + q);
#pragma unroll
                for (int n2 = 0; n2 < 2; ++n2) { const int ch = h * 256 + 32 * wave + 16 * n2 + 4 * q4;
                    const f32x4 gn = *(const GAS f32x4*)(ret_gain + ch); const v2u sg = *(const GAS v2u*)(P + tok * NPROJ + C_GR + ch);
                    const float o0 = O1[qb][n2][0] * rs * gn[0] * bf2f(sg.x & 0xffffu), o1 = O1[qb][n2][1] * rs * gn[1] * bf2f(sg.x >> 16);
                    const float o2 = O1[qb][n2][2] * rs * gn[2] * bf2f(sg.y & 0xffffu), o3 = O1[qb][n2][3] * rs * gn[3] * bf2f(sg.y >> 16);
                    v2u w; w.x = pk2(o0, o1); w.y = pk2(o2, o3); *(GAS v2u*)(RET + tok * D + ch) = w; } }
            __syncthreads();
        }
    }
    SEAM(5);

    if (IN(6)) {
        { pg8::Gemm g{ATT, Wba_t, T, D, D}; pg8::StaticOrder S; S.init(T, D, G, bid, WGM_SQ); pg8::EpiBranchA E{P, M1};
          pg8::gemm_phase<pg8::EpiBranchA, pg8::StaticOrder, GK_ALIGN1, GK_SP2>(lds, g, S, E); }
        VM_WAIT(); __syncthreads();
        { pg8::Gemm g{RET, Wbr_t, T, D, D}; pg8::StaticOrder S; S.init(T, D, G, bid, WGM_SQ); pg8::EpiBranchR E{P, M1, MG};
          pg8::gemm_phase<pg8::EpiBranchR, pg8::StaticOrder, GK_ALIGN1, GK_SP2>(lds, g, S, E); }
    }
    SEAM(6);

    if (IN(7)) {
        pg8::Gemm g{MG, Wout_t, T, D, D}; pg8::StaticOrder S; S.init(T, D, G, bid, WGM_SQ); pg8::EpiOut E{x, mod + 2 * 2048, X1};
        pg8::gemm_phase<pg8::EpiOut, pg8::StaticOrder, GK_ALIGN1, GK_SP2>(lds, g, S, E);
    }
    SEAM(7);

    if (IN(8)) {
        const int r16 = lane & 15, q4 = lane >> 4;
        constexpr int AP = 2056;
        LAS bf16* Al = (LAS bf16*)lds;
        LAS float* Lg = (LAS float*)(lds + 135168);
        LAS float* Bs = (LAS float*)(lds + MISC_OFF + 3072);
        LAS unsigned* Lc = (LAS unsigned*)(lds + MISC_OFF + 3584);
        LAS unsigned* Lb = (LAS unsigned*)(lds + MISC_OFF + 3840);
        if (tid < 64) { Bs[tid] = b_re[tid]; Lc[tid] = 0u; } else if (tid < 68) Bs[tid] = b_rg[tid - 64];
        for (int t0 = bid * 32; t0 < T; t0 += G * 32) {
            f32x4 ca[8], cs[8];
            { const int b0 = t0 >> 12;
#pragma unroll
              for (int j = 0; j < 8; ++j) { const int k = 4 * lane + 256 * j;
                  const f32x4 g = *(const GAS f32x4*)(norm2_gain + k), scl = *(const GAS f32x4*)(mod + b0 * 12288 + 4 * 2048 + k);
                  ca[j] = g * (scl + 1.0f); cs[j] = *(const GAS f32x4*)(mod + b0 * 12288 + 3 * 2048 + k); } }
            for (int rr = 0; rr < 4; ++rr) {
                const int lrow = 4 * wave + rr, row = t0 + lrow;
                const GAS v2u* xr = (const GAS v2u*)(X1 + (size_t)row * D) + lane;
                f32x4 v[8]; float ss = 0.f;
#pragma unroll
                for (int j = 0; j < 8; ++j) { const v2u xb = xr[64 * j]; v[j] = (f32x4){bf2f(xb.x & 0xffffu), bf2f(xb.x >> 16), bf2f(xb.y & 0xffffu), bf2f(xb.y >> 16)};
                    ss += (v[j].x * v[j].x + v[j].y * v[j].y) + (v[j].z * v[j].z + v[j].w * v[j].w); }
                const float r = 1.0f / sqrtf(wave_sum(ss) * (1.0f / D) + EPS);
                GAS v2u* o8 = (GAS v2u*)(Hb + (size_t)row * D) + lane;
#pragma unroll
                for (int j = 0; j < 8; ++j) { const int k = 4 * lane + 256 * j;
                    const f32x4 hv = v[j] * r * ca[j] + cs[j];
                    v2u o; o.x = pk2(hv.x, hv.y); o.y = pk2(hv.z, hv.w); o8[64 * j] = o;
                    *(LAS v2u*)(Al + lrow * AP + k) = o; }
            }
            __syncthreads();
            if (wave < 5) {
                f32x4 a0 = {0.f, 0.f, 0.f, 0.f}, a1 = {0.f, 0.f, 0.f, 0.f};
                const bf16* Bb = Wrt + (size_t)(16 * wave + r16) * D + 8 * q4;
#pragma unroll 4
                for (int s = 0; s < 64; ++s) {
                    const bf16x8 bb = ldg8(Bb + 32 * s);
                    const bf16x8 x0 = *(const LAS bf16x8*)(Al + r16 * AP + 32 * s + 8 * q4), x1v = *(const LAS bf16x8*)(Al + (16 + r16) * AP + 32 * s + 8 * q4);
                    a0 = mma16(x0, bb, a0); a1 = mma16(x1v, bb, a1);
                }
#pragma unroll
                for (int reg = 0; reg < 4; ++reg) { Lg[(4 * q4 + reg) * 80 + 16 * wave + r16] = a0[reg]; Lg[(16 + 4 * q4 + reg) * 80 + 16 * wave + r16] = a1[reg]; }
            }
            __syncthreads();
            if (tid < 32) {
                const int row = t0 + tid; const LAS float* L = Lg + tid * 80;
                float gl[4]; int gs = 0;
#pragma unroll
                for (int j = 0; j < 4; ++j) gl[j] = L[64 + j] + Bs[64 + j];
#pragma unroll
                for (int j = 1; j < 4; ++j) if (gl[j] > gl[gs]) gs = j;
                float den = 0.f;
#pragma unroll
                for (int j = 0; j < 4; ++j) den += expf(gl[j] - gl[gs]);
                const float gw = 1.0f / den;
                float ev[16];
#pragma unroll
                for (int j = 0; j < 16; ++j) ev[j] = L[gs * 16 + j] + Bs[gs * 16 + j];
                int i0 = 0; float v0 = ev[0];
#pragma unroll
                for (int j = 1; j < 16; ++j) if (ev[j] > v0) { v0 = ev[j]; i0 = j; }
                int i1 = -1; float v1 = -INFINITY;
#pragma unroll
                for (int j = 0; j < 16; ++j) if (j != i0 && ev[j] > v1) { v1 = ev[j]; i1 = j; }
                const float e1 = expf(v1 - v0); const float w0 = gw / (1.0f + e1), w1 = gw * e1 / (1.0f + e1);
                const int ex0 = gs * 16 + i0, ex1 = gs * 16 + i1;
                const int k0 = (int)__hip_atomic_fetch_add(Lc + ex0, 1u, __ATOMIC_RELAXED, __HIP_MEMORY_SCOPE_WORKGROUP);
                const int k1 = (int)__hip_atomic_fetch_add(Lc + ex1, 1u, __ATOMIC_RELAXED, __HIP_MEMORY_SCOPE_WORKGROUP);
                LDS_WAIT();
#pragma unroll
                for (int q = 0; q < 2; ++q) { const int ex = tid + 32 * q; const unsigned c = Lc[ex]; if (c) Lb[ex] = __hip_atomic_fetch_add(ecnt + ex, c, RLX_AGENT); }
                LDS_WAIT();
                const int p0 = (int)Lb[ex0] + k0, p1 = (int)Lb[ex1] + k1;
                Lc[tid] = 0u; Lc[tid + 32] = 0u;
                int* rt = route + (size_t)row * 8;
                rt[0] = ex0; rt[1] = p0; rt[2] = ex1; rt[3] = p1; rt[4] = __builtin_bit_cast(int, w0); rt[5] = __builtin_bit_cast(int, w1);
                rowtok[ex0 * 8192 + p0] = row; rowtok[ex1 * 8192 + p1] = row;
            }
            __syncthreads();
        }
    }
    SEAM(8);

    LAS int* ecl = (LAS int*)(lds + MISC_OFF + 1024);
    LAS int* bstart = (LAS int*)(lds + MISC_OFF + 1536);
    LAS int* ptab = (LAS int*)(lds + MISC_OFF + 2048);
    LAS int* npass_p = (LAS int*)(lds + MISC_OFF + 2560);
    if (hi > 9 && lo <= 12) {
        if (tid == 0) { int nb = 0, np = 0;
            for (int e = 0; e < NEXP; ++e) { const int cnt = (int)__hip_atomic_load(ecnt + e, RLX_AGENT); ecl[e] = cnt; bstart[e] = nb; nb += cnt; }
            for (int e = 0; e < NEXP; ++e) for (int q = 0; q * moe::MT < ecl[e]; ++q) ptab[np++] = e | (q << 8);
            npass_p[0] = np;
#ifdef DBG_LEAK_MT
            { int pp = 0; for (int e = 0; e < NEXP; ++e) pp += (ecl[e] + DBG_LEAK_MT - 1) / DBG_LEAK_MT; if (lo <= 10 && hi > 10) { const unsigned long long t0 = __builtin_amdgcn_s_memrealtime(); while (__builtin_amdgcn_s_memrealtime() - t0 < (unsigned long long)(DBG_LEAK_MT == 1 ? 10000 : pp * 200)) __builtin_amdgcn_s_sleep(8); } }
#endif
            }
        __syncthreads();
    }
    const int vwg = (G & 7) == 0 ? (bid & 7) * (G >> 3) + (bid >> 3) : bid;

    if (IN(10)) {
        gu32* pcnt = ctl + CW_PCNT;
        gu32* qhead = ctl + CW_QHEAD;
        LAS int* qslot = (LAS int*)(lds + MISC_OFF + 4096);
        const int P = npass_p[0];
        const int myx = (int)(xb_xcc_id() & 7u);
        auto fetch = [&](int qfirst) -> int {
            for (int t = 0; t < 8; ++t) { const int q = (qfirst + t) & 7; const int npx = (P - q + 7) >> 3; if (npx <= 0) continue;
                if ((int)__hip_atomic_load(qhead + 64 * q, RLX_AGENT) >= 32 * npx) continue;
                const int i = (int)__hip_atomic_fetch_add(qhead + 64 * q, 1u, RLX_AGENT); if (i < 32 * npx) return (q << 20) | i; }
            return -1; };
        if (tid == 0) qslot[0] = fetch(myx);
        __syncthreads();
        for (int it = 0;; ++it) {
            const int code = qslot[it & 1];
            if (code < 0) break;
            if (tid == 0) qslot[(it + 1) & 1] = fetch(myx);
            const int q = code >> 20, i = code & 0xfffff, npx = (P - q + 7) >> 3;
            const bool second = i >= 16 * npx; const int i2 = second ? i - 16 * npx : i;
            const int pass = q + 8 * (i2 >> 4), pe = ptab[pass], j = i2 & 15, e = pe & 255, p0 = (pe >> 8) * moe2::MT;
            const int Me = ecl[e], rb = bstart[e];
            const int mrows = (Me - p0) < moe2::MT ? (Me - p0) : moe2::MT;
            if (!second) {
                const int* rt = rowtok + e * 8192;
                auto rowfn = [=](int R) -> unsigned { int rr = p0 + R; rr = rr < Me ? rr : Me - 1; return (unsigned)rt[rr] * (unsigned)(D * 2); };
                MOE_NS::tile<1>(lds, (const unsigned char*)Hb, rowfn, w_eg + (size_t)e * D * EDIM + j * 64, w_eu + (size_t)e * D * EDIM + j * 64, EDIM,
                              (mrows + 15) >> 4, mrows, HB + (size_t)(rb + p0) * EDIM + j * 64, EDIM, tid, pcnt + pass);
            } else {
                if (wave >= 4 && wave < MOE_AWAVE_END) {
                    unsigned sp = 0;
                    while ((unsigned)__builtin_amdgcn_readfirstlane(__hip_atomic_load(pcnt + pass, RLX_AGENT)) < 64u) {
                        __builtin_amdgcn_s_sleep(2);
                        if ((++sp & 255u) == 0u) { if (__hip_atomic_load(ctl + CW_TMO, RLX_AGENT) != 0u) break; if (sp > (1u << 20)) { if (lane == 0) __hip_atomic_store(ctl + CW_TMO, 0x5A5u, RLX_AGENT); break; } } }
                    __builtin_amdgcn_fence(__ATOMIC_ACQUIRE, "agent");
                    asm volatile("s_waitcnt vmcnt(0)" ::: "memory");
                }
                auto rowfn = [=](int R) -> unsigned { int rr = p0 + R; rr = rr < Me ? rr : Me - 1; return (unsigned)(rb + rr) * (unsigned)(EDIM * 2); };
                MOE_NS::tile<2>(lds, (const unsigned char*)HB, rowfn, w_ed + (size_t)e * EDIM * D + j * 128, nullptr, D,
                              (mrows + 15) >> 4, mrows, YB + (size_t)(rb + p0) * D + j * 128, D, tid);
            }
        }
        __syncthreads();
    }
    SEAM(11);

    if (IN(12)) {
        const int gw = bid * NWAVES + wave, NGW = G * NWAVES;
        for (int row = gw; row < T; row += NGW) {
            const int b = row >> 12; const int* rt = route + (size_t)row * 8;
            const int r0 = bstart[rt[0]] + rt[1], r1 = bstart[rt[2]] + rt[3];
            const float w0 = __builtin_bit_cast(float, rt[4]), w1 = __builtin_bit_cast(float, rt[5]);
            const GAS v2u* xr = (const GAS v2u*)(X1 + (size_t)row * D) + lane;
            const GAS v2u* y0 = (const GAS v2u*)(YB + (size_t)r0 * D) + lane; const GAS v2u* y1 = (const GAS v2u*)(YB + (size_t)r1 * D) + lane;
            f32x4 v[8]; float ss = 0.f;
#pragma unroll
            for (int j = 0; j < 8; ++j) { const int k = 4 * lane + 256 * j;
                const f32x4 g2 = *(const GAS f32x4*)(mod + b * 12288 + 5 * 2048 + k);
                const v2u a = y0[64 * j], bq = y1[64 * j];
                f32x4 f; f.x = w0 * bf2f(a.x & 0xffffu) + w1 * bf2f(bq.x & 0xffffu); f.y = w0 * bf2f(a.x >> 16) + w1 * bf2f(bq.x >> 16);
                f.z = w0 * bf2f(a.y & 0xffffu) + w1 * bf2f(bq.y & 0xffffu); f.w = w0 * bf2f(a.y >> 16) + w1 * bf2f(bq.y >> 16);
#ifdef DBG_SKIP_MOE
                { const v2u xb = xr[64 * j]; v[j] = (f32x4){bf2f(xb.x & 0xffffu), bf2f(xb.x >> 16), bf2f(xb.y & 0xffffu), bf2f(xb.y >> 16)}; }
#else
                { const v2u xb = xr[64 * j]; v[j] = (f32x4){bf2f(xb.x & 0xffffu), bf2f(xb.x >> 16), bf2f(xb.y & 0xffffu), bf2f(xb.y >> 16)} + g2 * f; }
#endif
                ss += (v[j].x * v[j].x + v[j].y * v[j].y) + (v[j].z * v[j].z + v[j].w * v[j].w); }
            const float r = 1.0f / sqrtf(wave_sum(ss) * (1.0f / D) + EPS);
            GAS f32x4* o = (GAS f32x4*)(args.out + (size_t)row * D) + lane;
#pragma unroll
            for (int j = 0; j < 8; ++j) { const f32x4 g = *(const GAS f32x4*)(final_gain + 4 * lane + 256 * j); o[64 * j] = v[j] * r * g; }
        }
    }
#undef IN
#undef SEAM
}


#ifdef DBG_TAP
__global__ void tap_kernel(unsigned char* ws, float* out, int mode) {
    const bf16* Hb = (const bf16*)(ws + WS_H); const bf16* P = (const bf16*)(ws + WS_P);
    const bf16* Vta = (const bf16*)(ws + WS_VTA); const bf16* Vtr = (const bf16*)(ws + WS_VTR); const bf16* Krt = (const bf16*)(ws + WS_KRT);
    const float* SC = (const float*)(ws + WS_SC); const bf16* ST = (const bf16*)(ws + WS_ST);
    const bf16* ATT = (const bf16*)(ws + WS_ATTN); const bf16* RET = (const bf16*)(ws + WS_RET); const bf16* MG = (const bf16*)(ws + WS_MERGED);
    const bf16* X1 = (const bf16*)(ws + WS_X1); const float* mod = (const float*)(ws + WS_MOD);
    for (size_t i = (size_t)blockIdx.x * blockDim.x + threadIdx.x; i < (size_t)T * D; i += (size_t)gridDim.x * blockDim.x) {
        const int row = (int)(i >> 11), c = (int)(i & 2047), b = row >> 12, s = row & 4095; float v = 0.f;
        if (mode == 0) v = mod[(i % 24576)];
        if (mode == 1) v = bf2f(Hb[i]);
        if (mode == 2) { v = bf2f(P[(size_t)row * NPROJ + c]) + bf2f(P[(size_t)row * NPROJ + C_QR + c]) + bf2f(P[(size_t)row * NPROJ + C_KR + c]) + bf2f(P[(size_t)row * NPROJ + C_GR + c]) + bf2f(P[(size_t)row * NPROJ + C_GA + c]) + bf2f(P[(size_t)row * NPROJ + C_GT + c])
                 + bf2f(P[(size_t)row * NPROJ + C_KA + (c & 255)]) + bf2f(Vtr[(size_t)(b * 2048 + c) * 4096 + s]) + bf2f(Krt[(size_t)(b * 2048 + c) * 4096 + s]) + bf2f(Vta[(size_t)(b * 256 + (c & 255)) * 4096 + s]); }
        if (mode == 3) { v = bf2f(ATT[i]); for (int j = 0; j < 4; ++j) v += SC[i * 4 + j] * 0.01f; }
        if (mode == 4) { for (int j = 0; j < 2; ++j) v += bf2f(ST[i * 2 + j]); }
        if (mode == 5) v = bf2f(RET[i]);
        if (mode == 6) v = bf2f(MG[i]);
        if (mode == 7) v = bf2f(X1[i]);
        out[i] = v;
    }
}
#endif

#ifdef DBG_STREAM
__global__ void __launch_bounds__(512, 2) probe_stream(const float* w_eg, const float* w_eu, float* dump, const bf16* hb) {
    const int tid = threadIdx.x, lane = tid & 63, wave = tid >> 6, bid = blockIdx.x, G = gridDim.x;
    f32x4 s = {0.f, 0.f, 0.f, 0.f};
    for (int L = bid; L < 1024; L += G) {
        const int lx = L & 7, li = (L >> 3) & 31, r = L >> 8; const int e = 8 * lx + 2 * r + (li >> 4), j = li & 15;
        const int mat = wave & 1, kq = wave >> 1, kg = lane >> 4, cq = lane & 15;
        const float* base = (mat ? w_eu : w_eg) + (size_t)e * D * EDIM + j * 64 + (size_t)(16 * kq + 4 * kg) * EDIM + 4 * cq;
#if DBG_STREAM == 2
        { extern __shared__ __attribute__((aligned(16))) unsigned char plds[];
          auto rowfn = [=](int R) -> unsigned { return (unsigned)(((e * 131 + R * 7 + j) & 8191)) * 4096u; };
          moe2::tile<1, DBG_NOMMA, DBG_NOLOAD, DBG_LMODE>((LAS unsigned char*)plds, (const unsigned char*)hb, rowfn, w_eg + (size_t)e * D * EDIM + j * 64, w_eu + (size_t)e * D * EDIM + j * 64, EDIM, 17, 272, (bf16*)dump + (size_t)bid * 320 * 1024, 1024, tid); }
#endif
#if DBG_STREAM == 1
        for (int kt = 0; kt < 32; kt += DBG_DEPTH) {
            f32x4 v[DBG_DEPTH][4];
#pragma unroll
            for (int t = 0; t < DBG_DEPTH; ++t)
#pragma unroll
                for (int q = 0; q < 4; ++q) v[t][q] = __builtin_nontemporal_load((const GAS f32x4*)(base + (size_t)((kt + t) * 64 + q) * EDIM));
#pragma unroll
            for (int t = 0; t < DBG_DEPTH; ++t)
#pragma unroll
                for (int q = 0; q < 4; ++q) s += v[t][q];
        }
#endif
    }
    if (s.x + s.y + s.z + s.w == 12345.678f) dump[tid] = s.x;
}
#endif
constexpr int NPHASES = 13;
#ifndef MK_ONE_LAUNCH
#define MK_ONE_LAUNCH 0
#endif
extern "C" void kernel_launch(void* const* d_in, const int* in_sizes, int n_in, void* d_out, int out_size, void* d_ws, size_t ws_size, hipStream_t stream) {
    static int grid = 0;
    if (grid == 0) {
        if (n_in != 21 || out_size != T * D || ws_size < WS_END) { fprintf(stderr, "kernel_launch: unexpected shapes (n_in %d out %d ws %zu)\n", n_in, out_size, ws_size); grid = -1; return; }
        int dev = 0, cus = 0, per_cu = 0;
        if (hipGetDevice(&dev) != hipSuccess || hipDeviceGetAttribute(&cus, hipDeviceAttributeMultiprocessorCount, dev) != hipSuccess) { grid = -1; return; }
        if (hipFuncSetAttribute((const void*)fwd_kernel, hipFuncAttributeMaxDynamicSharedMemorySize, LDS_BYTES) != hipSuccess) { fprintf(stderr, "kernel_launch: hipFuncSetAttribute failed\n"); grid = -1; return; }
        if (hipOccupancyMaxActiveBlocksPerMultiprocessor(&per_cu, (const void*)fwd_kernel, NTHR, LDS_BYTES) != hipSuccess || per_cu < 1) { fprintf(stderr, "kernel_launch: occupancy query says %d\n", per_cu); }
        (void)hipGetLastError();
        grid = cus;
    }
    if (grid < 0) return;
    if (hipMemsetAsync((char*)d_ws + WS_CTL, 0, CTL_ZERO_BYTES, stream) != hipSuccess) return;
    Args a{};
    for (int i = 0; i < 21; ++i) a.in[i] = d_in[i];
    a.out = (float*)d_out; a.ws = (unsigned char*)d_ws;
#if MK_ONE_LAUNCH
#ifdef DBG_REP
    a.ph_lo = 0; a.ph_hi = DBG_REP_HI + 1; a.bar_region = 0; hipLaunchKernelGGL(fwd_kernel, dim3(grid), dim3(NTHR), LDS_BYTES, stream, a);
    (void)hipMemsetAsync((char*)d_ws + WS_CTL + (size_t)CW_PCNT * 4, 0, 65536, stream);
#ifdef DBG_VARIANT
    a.pad = DBG_VARIANT;
#endif
    a.ph_lo = DBG_REP; a.ph_hi = DBG_REP_HI + 1; a.bar_region = 1; hipLaunchKernelGGL(fwd_kernel, dim3(grid), dim3(NTHR), LDS_BYTES, stream, a);
    a.pad = 0;
    if (DBG_REP_HI + 1 < NPHASES) { a.ph_lo = DBG_REP_HI + 1; a.ph_hi = NPHASES; a.bar_region = 2; hipLaunchKernelGGL(fwd_kernel, dim3(grid), dim3(NTHR), LDS_BYTES, stream, a); }
#else
    a.ph_lo = 0; a.ph_hi = NPHASES;
    hipLaunchKernelGGL(fwd_kernel, dim3(grid), dim3(NTHR), LDS_BYTES, stream, a);
#ifdef DBG_STREAM
    { static bool once = false; if (!once) { once = true; (void)hipFuncSetAttribute((const void*)probe_stream, hipFuncAttributeMaxDynamicSharedMemorySize, LDS_BYTES); }
      hipLaunchKernelGGL(probe_stream, dim3(grid), dim3(512), (DBG_STREAM == 2 ? LDS_BYTES : 0), stream, (const float*)d_in[18], (const float*)d_in[19], (float*)((char*)d_ws + WS_END), (const bf16*)((char*)d_ws + WS_H)); }
#endif
#endif
#else
#ifdef DBG_TAP
    for (int p = 0; p <= DBG_TAP; ++p) { a.ph_lo = p; a.ph_hi = p + 1; hipLaunchKernelGGL(fwd_kernel, dim3(grid), dim3(NTHR), LDS_BYTES, stream, a); }
    hipLaunchKernelGGL(tap_kernel, dim3(2048), dim3(256), 0, stream, (unsigned char*)d_ws, (float*)d_out, (int)DBG_TAPMODE);
#else
    for (int p = 0; p < NPHASES; ++p) { a.ph_lo = p; a.ph_hi = p + 1; hipLaunchKernelGGL(fwd_kernel, dim3(grid), dim3(NTHR), LDS_BYTES, stream, a); }
#endif
#endif
}
```
